# Optimizing an MI355X kernel written in HIP

```python
import jax, jax.numpy as jnp
from jax import lax
import numpy as np

D_MODEL = 4096
BATCH = 1
SEQ = 8192
DEPTH = 1

PLE_DIM = 256
D_FF = 11008
EPS = 1e-6
MACARON_WEIGHT = 0.5
FOX_HEAD_DIM = 128
FOX_WIDTH = D_MODEL // 2
FOX_HEADS = FOX_WIDTH // FOX_HEAD_DIM
Q_BLOCK = 128
GLA_WIDTH = D_MODEL - FOX_WIDTH
GLA_HEADS = 4
GLA_HEAD_V = GLA_WIDTH // GLA_HEADS
GLA_KEY_WIDTH = GLA_WIDTH // 2
GLA_HEAD_K = GLA_KEY_WIDTH // GLA_HEADS
GLA_GATE_RANK = 16
GLA_TAU = 16.0
GLA_CHUNK = 64
IN_SPLIT_SIZES = (FOX_WIDTH, FOX_WIDTH, FOX_WIDTH, FOX_HEADS,
                  GLA_KEY_WIDTH, GLA_KEY_WIDTH, GLA_WIDTH, GLA_WIDTH, GLA_GATE_RANK)
W_IN_COLS = 3 * FOX_WIDTH + FOX_HEADS + 2 * GLA_KEY_WIDTH + 2 * GLA_WIDTH + GLA_GATE_RANK

kernel_name = "hymba_fox_gla_macaron_sandwich_ple"


def rms_norm(x, g):
    xf = x.astype(jnp.float32)
    y = xf * lax.rsqrt(jnp.mean(xf * xf, axis=-1, keepdims=True) + EPS)
    return (y * g.astype(jnp.float32)).astype(x.dtype)


def swiglu(x, w_gate, w_up, w_down):
    return (jax.nn.silu(x @ w_gate) * (x @ w_up)) @ w_down


def forgetting_attention(q, k, v, log_f):
    B, S, H, dh = q.shape
    n_blk = S // Q_BLOCK
    scale = dh ** -0.5
    qf = jnp.transpose(q, (0, 2, 1, 3)).astype(jnp.float32) * scale
    kf = jnp.transpose(k, (0, 2, 1, 3)).astype(jnp.float32)
    vf = jnp.transpose(v, (0, 2, 1, 3)).astype(jnp.float32)
    c = jnp.transpose(jnp.cumsum(log_f, axis=1), (0, 2, 1))
    k_pos = jnp.arange(S)

    def block(i):
        start = i * Q_BLOCK
        qb = lax.dynamic_slice_in_dim(qf, start, Q_BLOCK, axis=2)
        cb = lax.dynamic_slice_in_dim(c, start, Q_BLOCK, axis=2)
        s = jnp.einsum('bhqd,bhkd->bhqk', qb, kf) + cb[..., :, None] - c[:, :, None, :]
        q_pos = start + jnp.arange(Q_BLOCK)
        s = jnp.where(k_pos[None, :] <= q_pos[:, None], s, -jnp.inf)
        pr = jax.nn.softmax(s, axis=-1)
        return jnp.einsum('bhqk,bhkd->bhqd', pr, vf)

    o = lax.map(block, jnp.arange(n_blk))
    o = jnp.transpose(o, (1, 0, 3, 2, 4)).reshape(B, S, H, dh)
    return o.astype(q.dtype)


def gla_chunked(q, k, v, log_a):
    B, S, H, dk = q.shape
    dv = v.shape[-1]
    C = GLA_CHUNK
    n = S // C

    def chunks(t):
        return jnp.transpose(t.astype(jnp.float32).reshape(B, n, C, H, t.shape[-1]), (0, 3, 1, 2, 4))

    qc = chunks(q) * (dk ** -0.5)
    kc = chunks(k)
    vc = chunks(v)
    b = jnp.cumsum(chunks(log_a), axis=3)
    b_last = b[:, :, :, -1:, :]
    q_dec = qc * jnp.exp(b)
    k_inv = kc * jnp.exp(-b)
    k_to_end = kc * jnp.exp(b_last - b)
    causal = jnp.tril(jnp.ones((C, C), dtype=bool))
    A = jnp.where(causal, jnp.einsum('bhnqd,bhnkd->bhnqk', q_dec, k_inv), 0.0)
    o_intra = jnp.einsum('bhnqk,bhnke->bhnqe', A, vc)

    def step(state, inp):
        qd, kd, vv, dl = inp
        o = jnp.einsum('bhcd,bhde->bhce', qd, state)
        state = jnp.exp(dl)[..., None] * state + jnp.einsum('bhcd,bhce->bhde', kd, vv)
        return state, o

    xs = (jnp.transpose(q_dec, (2, 0, 1, 3, 4)),
          jnp.transpose(k_to_end, (2, 0, 1, 3, 4)),
          jnp.transpose(vc, (2, 0, 1, 3, 4)),
          jnp.transpose(b_last[:, :, :, 0, :], (2, 0, 1, 3)))
    state0 = jnp.zeros((B, H, dk, dv), jnp.float32)
    _, o_inter = lax.scan(step, state0, xs)
    o = o_intra + jnp.transpose(o_inter, (1, 2, 0, 3, 4))
    return jnp.transpose(o, (0, 2, 3, 1, 4)).reshape(B, S, H, dv)


def _w(key, shape, fan_in):
    return jax.random.normal(key, shape, jnp.float32) * (fan_in ** -0.5)


def _g(key, shape):
    return 1.0 + 0.02 * jax.random.normal(key, shape, jnp.float32)


def setup_inputs(seed: int = 0) -> dict:
    key = jax.random.key(seed)
    ks = jax.random.split(key, 23)
    L = DEPTH
    return {
        "x": jax.random.normal(ks[0], (BATCH, SEQ, D_MODEL), jnp.float32),
        "p": jax.random.normal(ks[1], (DEPTH, BATCH, SEQ, PLE_DIM), jnp.float32),
        "ffn1_norm_pre": _g(ks[2], (L, D_MODEL)),
        "ffn1_w_gate": _w(ks[3], (L, D_MODEL, D_FF), D_MODEL),
        "ffn1_w_up": _w(ks[4], (L, D_MODEL, D_FF), D_MODEL),
        "ffn1_w_down": _w(ks[5], (L, D_FF, D_MODEL), D_FF),
        "ffn1_norm_post": _g(ks[6], (L, D_MODEL)),
        "mix_norm_pre": _g(ks[7], (L, D_MODEL)),
        "w_in": _w(ks[8], (L, D_MODEL, W_IN_COLS), D_MODEL),
        "fox_b_f": 0.1 * jax.random.normal(ks[9], (L, FOX_HEADS), jnp.float32),
        "gla_w_gate": _w(ks[10], (L, GLA_GATE_RANK, GLA_KEY_WIDTH), GLA_GATE_RANK),
        "gla_b_gate": 0.1 * jax.random.normal(ks[11], (L, GLA_KEY_WIDTH), jnp.float32),
        "gla_norm_g": _g(ks[12], (L, GLA_HEAD_V)),
        "w_o": _w(ks[13], (L, D_MODEL, D_MODEL), D_MODEL),
        "mix_norm_post": _g(ks[14], (L, D_MODEL)),
        "ffn2_norm_pre": _g(ks[15], (L, D_MODEL)),
        "ffn2_w_gate": _w(ks[16], (L, D_MODEL, D_FF), D_MODEL),
        "ffn2_w_up": _w(ks[17], (L, D_MODEL, D_FF), D_MODEL),
        "ffn2_w_down": _w(ks[18], (L, D_FF, D_MODEL), D_FF),
        "ffn2_norm_post": _g(ks[19], (L, D_MODEL)),
        "ple_w_proj": _w(ks[20], (L, PLE_DIM, D_MODEL), PLE_DIM),
        "ple_norm": _g(ks[21], (L, D_MODEL)),
        "ple_w_gate": _w(ks[22], (L, D_MODEL, D_MODEL), D_MODEL),
    }


def reference(x, p, ffn1_norm_pre, ffn1_w_gate, ffn1_w_up, ffn1_w_down, ffn1_norm_post,
              mix_norm_pre, w_in, fox_b_f, gla_w_gate, gla_b_gate, gla_norm_g, w_o, mix_norm_post,
              ffn2_norm_pre, ffn2_w_gate, ffn2_w_up, ffn2_w_down, ffn2_norm_post,
              ple_w_proj, ple_norm, ple_w_gate):
    B, S, _ = x.shape
    offsets = np.cumsum(IN_SPLIT_SIZES)[:-1].tolist()
    h = x
    for i in range(DEPTH):
        f1 = swiglu(rms_norm(h, ffn1_norm_pre[i]), ffn1_w_gate[i], ffn1_w_up[i], ffn1_w_down[i])
        h = h + MACARON_WEIGHT * rms_norm(f1, ffn1_norm_post[i])

        a = rms_norm(h, mix_norm_pre[i])
        proj = a @ w_in[i]
        fq, fk, fv, ff, gq, gk, gv, gr, glr = jnp.split(proj, offsets, axis=-1)

        log_f = jax.nn.log_sigmoid((ff + fox_b_f[i]).astype(jnp.float32))
        o_fox = forgetting_attention(fq.reshape(B, S, FOX_HEADS, FOX_HEAD_DIM),
                                     fk.reshape(B, S, FOX_HEADS, FOX_HEAD_DIM),
                                     fv.reshape(B, S, FOX_HEADS, FOX_HEAD_DIM), log_f)

        log_a = jax.nn.log_sigmoid((glr @ gla_w_gate[i] + gla_b_gate[i]).astype(jnp.float32)) / GLA_TAU
        o_gla = gla_chunked(gq.reshape(B, S, GLA_HEADS, GLA_HEAD_K),
                            gk.reshape(B, S, GLA_HEADS, GLA_HEAD_K),
                            gv.reshape(B, S, GLA_HEADS, GLA_HEAD_V),
                            log_a.reshape(B, S, GLA_HEADS, GLA_HEAD_K))
        o_gla = rms_norm(o_gla, gla_norm_g[i]).astype(h.dtype) * jax.nn.silu(gr).reshape(B, S, GLA_HEADS, GLA_HEAD_V)

        mixed = jnp.concatenate([o_fox.reshape(B, S, FOX_WIDTH).astype(h.dtype),
                                 o_gla.reshape(B, S, GLA_WIDTH)], axis=-1)
        h = h + rms_norm(mixed @ w_o[i], mix_norm_post[i])

        f2 = swiglu(rms_norm(h, ffn2_norm_pre[i]), ffn2_w_gate[i], ffn2_w_up[i], ffn2_w_down[i])
        h = h + MACARON_WEIGHT * rms_norm(f2, ffn2_norm_post[i])

        e = rms_norm(p[i] @ ple_w_proj[i], ple_norm[i])
        h = h + e * jax.nn.sigmoid(h @ ple_w_gate[i])
    return h
```

```cpp
#include <hip/hip_runtime.h>
#include <cstdio>
#include <cstdint>
namespace pg8 {
#define PG8_LAS __attribute__((address_space(3)))
typedef unsigned short bf16_t;
typedef short bf16x8 __attribute__((ext_vector_type(8)));
typedef float f32x4 __attribute__((ext_vector_type(4)));
typedef unsigned u32x4 __attribute__((ext_vector_type(4)));
constexpr int BM = 256, BK = 64, HALF = 128, HTB = HALF * BK * 2  , STAGE_BYTES = 8 * HTB, NXCD = 8, WGM = 8;

__host__ __device__ __forceinline__ int lds_byte(int r, int c) { const int st = (r >> 4) * 2 + (c >> 5), rr = r & 15, cc = c & 31, ob = rr * 64 + cc * 2; return st * 1024 + (ob ^ (((ob >> 9) & 1) << 5)); }
__host__ __device__ __forceinline__ void stage_rc(int b, int& R, int& C) { const int st = b / 1024, sb = b % 1024, swz = sb ^ (((sb >> 9) & 1) << 5); R = (st >> 1) * 16 + swz / 64; C = (st & 1) * 32 + (swz % 64) / 2; }
__host__ __device__ __forceinline__ int perm32(int rho) { const int n = rho >> 4, i = rho & 15; return 8 * (i >> 2) + 4 * n + (i & 3); }

struct Unit { int pm, pn; };
struct Gemm { const bf16_t* A; const bf16_t* Bt; int M, N, K; };

struct StaticOrder {
    int nM, nN, nwg, G, c;
    __host__ __device__ void init(int M, int N, int G_, int c_) { nM = M / BM; nN = N / BM; nwg = nM * nN; G = G_; c = c_; }
    __host__ __device__ bool next(int i, Unit& u) const {
        const long L = (long)i * G + c; if (L >= nwg) return false;
        int wgid = (int)L; { const int q = nwg / NXCD, r = nwg % NXCD, xcd = wgid % NXCD, off = wgid / NXCD; wgid = (xcd < r ? xcd * (q + 1) : r * (q + 1) + (xcd - r) * q) + off; }
        const int nig = WGM * nN, gid = wgid / nig, fm = gid * WGM, gsz = (nM - fm) < WGM ? (nM - fm) : WGM;
        u.pm = fm + ((wgid % nig) % gsz); u.pn = (wgid % nig) / gsz; return true;
    }
    __device__ __forceinline__ void a_ready(const Unit&) const {}
    __device__ __forceinline__ void done(const Unit&) const {}
};

__device__ __forceinline__ unsigned cvt_pk_bf16(float lo, float hi) { unsigned r; asm volatile("v_cvt_pk_bf16_f32 %0, %1, %2" : "=v"(r) : "v"(lo), "v"(hi)); return r; }
typedef float f32x2 __attribute__((ext_vector_type(2)));

struct EpiF32 {
    static constexpr bool PERM = false, AFTER_DRAIN = false;
    float* C; int ldc;
    __device__ __forceinline__ void operator()(const f32x4 (&acc)[2][2][4][2], const Unit& u, int wr, int wc, int fr, int fq) const {
        const int row0 = u.pm * BM + wr * 64 + fr, col0 = u.pn * BM + wc * 32 + 4 * fq;
#pragma unroll
        for (int ai = 0; ai < 2; ++ai)
#pragma unroll
            for (int m = 0; m < 4; ++m) { float* rowp = C + (size_t)(row0 + ai * HALF + m * 16) * ldc + col0;
#pragma unroll
                for (int bj = 0; bj < 2; ++bj)
#pragma unroll
                    for (int n = 0; n < 2; ++n) *(f32x4*)(rowp + bj * HALF + n * 16) = acc[ai][bj][m][n]; }
    }
};
struct EpiBf16 {
    static constexpr bool PERM = true, AFTER_DRAIN = false;
    bf16_t* O; int ldc;
    __device__ __forceinline__ void operator()(const f32x4 (&acc)[2][2][4][2], const Unit& u, int wr, int wc, int fr, int fq) const {
        const int row0 = u.pm * BM + wr * 64 + fr, col0 = u.pn * BM + wc * 32 + 8 * fq;
#pragma unroll
        for (int ai = 0; ai < 2; ++ai)
#pragma unroll
            for (int m = 0; m < 4; ++m) { bf16_t* rowp = O + (size_t)(row0 + ai * HALF + m * 16) * ldc + col0;
#pragma unroll
                for (int bj = 0; bj < 2; ++bj) { const f32x4 v0 = acc[ai][bj][m][0], v1 = acc[ai][bj][m][1];
                    u32x4 w; w.x = cvt_pk_bf16(v0[0], v0[1]); w.y = cvt_pk_bf16(v0[2], v0[3]); w.z = cvt_pk_bf16(v1[0], v1[1]); w.w = cvt_pk_bf16(v1[2], v1[3]);
                    *(u32x4*)(rowp + bj * HALF) = w; } }
    }
};
__device__ __forceinline__ float silu_f(float g) { return g * __builtin_amdgcn_rcpf(1.0f + __builtin_amdgcn_exp2f(-1.4426950408889634f * g)); }
__device__ __forceinline__ float sigmoid_f(float g) { return __builtin_amdgcn_rcpf(1.0f + __builtin_amdgcn_exp2f(-1.4426950408889634f * g)); }
struct EpiSwiGLU {
    static constexpr bool PERM = true, AFTER_DRAIN = false;
    bf16_t* O; int ldc;
    __device__ __forceinline__ void operator()(const f32x4 (&acc)[2][2][4][2], const Unit& u, int wr, int wc, int fr, int fq) const {
        const int row0 = u.pm * BM + wr * 64 + fr, col0 = u.pn * HALF + wc * 32 + 8 * fq;
#pragma unroll
        for (int ai = 0; ai < 2; ++ai)
#pragma unroll
            for (int m = 0; m < 4; ++m) { bf16_t* rowp = O + (size_t)(row0 + ai * HALF + m * 16) * ldc + col0;
                const f32x4 g0 = acc[ai][0][m][0], g1 = acc[ai][0][m][1], u0 = acc[ai][1][m][0], u1 = acc[ai][1][m][1];
                u32x4 w; w.x = cvt_pk_bf16(silu_f(g0[0]) * u0[0], silu_f(g0[1]) * u0[1]); w.y = cvt_pk_bf16(silu_f(g0[2]) * u0[2], silu_f(g0[3]) * u0[3]);
                w.z = cvt_pk_bf16(silu_f(g1[0]) * u1[0], silu_f(g1[1]) * u1[1]); w.w = cvt_pk_bf16(silu_f(g1[2]) * u1[2], silu_f(g1[3]) * u1[3]);
                *(u32x4*)rowp = w; }
    }
};
struct EpiWin {
    static constexpr bool PERM = true, AFTER_DRAIN = false;
    bf16_t* R; int S;
    __device__ __forceinline__ void operator()(const f32x4 (&acc)[2][2][4][2], const Unit& u, int wr, int wc, int fr, int fq) const {
        const int row0 = u.pm * BM + wr * 64 + fr, pn = u.pn, cin = wc * 32 + 8 * fq;
        int ldc; size_t off0, off1;
        if (pn < 24) { ldc = 128; off0 = (size_t)(pn >> 3) * (16u << 20) + (size_t)(2 * (pn & 7)) * S * 128 + cin; off1 = off0 + (size_t)S * 128; }
        else { size_t tb; int c0;
            if (pn < 28) { tb = (size_t)48 << 20; ldc = 1024; c0 = (pn - 24) * 256; } else if (pn < 32) { tb = (size_t)56 << 20; ldc = 1024; c0 = (pn - 28) * 256; }
            else if (pn < 40) { tb = (size_t)64 << 20; ldc = 2048; c0 = (pn - 32) * 256; } else { tb = (size_t)80 << 20; ldc = 2048; c0 = (pn - 40) * 256; }
            off0 = tb + (size_t)(c0 + cin); off1 = off0 + HALF; }
#pragma unroll
        for (int ai = 0; ai < 2; ++ai)
#pragma unroll
            for (int m = 0; m < 4; ++m) { const size_t ro = (size_t)(row0 + ai * HALF + m * 16) * ldc;
#pragma unroll
                for (int bj = 0; bj < 2; ++bj) { const f32x4 v0 = acc[ai][bj][m][0], v1 = acc[ai][bj][m][1];
                    u32x4 w; w.x = cvt_pk_bf16(v0[0], v0[1]); w.y = cvt_pk_bf16(v0[2], v0[3]); w.z = cvt_pk_bf16(v1[0], v1[1]); w.w = cvt_pk_bf16(v1[2], v1[3]);
                    *(u32x4*)(R + ro + (bj ? off1 : off0)) = w; } }
    }
};
struct EpiPleGate {
    static constexpr bool PERM = false, AFTER_DRAIN = false;
    const float* H; const bf16_t* ERAW; const float* rstd_e; const float* g; float* out; int ldc;
    __device__ __forceinline__ void operator()(const f32x4 (&acc)[2][2][4][2], const Unit& u, int wr, int wc, int fr, int fq) const {
        const int row0 = u.pm * BM + wr * 64 + fr, col0 = u.pn * BM + wc * 32 + 4 * fq;
        f32x4 gv[2][2];
#pragma unroll
        for (int bj = 0; bj < 2; ++bj)
#pragma unroll
            for (int n = 0; n < 2; ++n) gv[bj][n] = *(const f32x4*)(g + col0 + bj * HALF + n * 16);
#pragma unroll
        for (int ai = 0; ai < 2; ++ai)
#pragma unroll
            for (int m = 0; m < 4; ++m) { const int row = row0 + ai * HALF + m * 16; const size_t ro = (size_t)row * ldc + col0; const float rs = rstd_e[row];
#pragma unroll
                for (int bj = 0; bj < 2; ++bj)
#pragma unroll
                    for (int n = 0; n < 2; ++n) { const size_t o = ro + bj * HALF + n * 16; const f32x4 a = acc[ai][bj][m][n];
                        const f32x4 hv = *(const f32x4*)(H + o); const unsigned long long ew = *(const unsigned long long*)(ERAW + o);
                        const f32x4 ev = {__builtin_bit_cast(float, (unsigned)ew << 16), __builtin_bit_cast(float, (unsigned)ew & 0xffff0000u), __builtin_bit_cast(float, (unsigned)(ew >> 32) << 16), __builtin_bit_cast(float, (unsigned)(ew >> 32) & 0xffff0000u)}; f32x4 r;
#pragma unroll
                        for (int j = 0; j < 4; ++j) r[j] = hv[j] + ev[j] * rs * gv[bj][n][j] * sigmoid_f(a[j]);
                        *(f32x4*)(out + o) = r; }
                asm volatile("" ::: "memory"); }
    }
};
template <class Epi, class Sched, bool ALIGN_EPI = false, bool SP2 = false>
__device__ __forceinline__ void gemm_phase(PG8_LAS unsigned char* lds, const Gemm g, const Sched& S, const Epi& E) {
    int tid_ = threadIdx.x; asm volatile("" : "+v"(tid_));
    const int tid = tid_, wid = __builtin_amdgcn_readfirstlane(tid >> 6), lane = tid & 63, wr = wid >> 2, wc = wid & 3, fr = lane & 15, fq = lane >> 4;
    const int K = g.K, nt = K / BK;
    unsigned voffA[2], voffB[2];
#pragma unroll
    for (int i = 0; i < 2; ++i) { int R, C; stage_rc(tid * 16 + i * 8192, R, C); const int Rb = Epi::PERM ? ((R & ~31) + perm32(R & 31)) : R;
        voffA[i] = (unsigned)(R * K + C) * 2u; voffB[i] = (unsigned)(Rb * K + C) * 2u; }
    const size_t kstep = (size_t)(BK * 2);
    const size_t hstep = (size_t)HALF * K * 2;
    const size_t tstep = 2 * hstep;
    const unsigned ldsw = (unsigned)wid * 1024u;
    const int aoff = lds_byte(wr * 64 + fr, fq * 8), boff = lds_byte(wc * 32 + fr, fq * 8);
#define PG8_SA(b, h) (((b) * 2 + (h)) * HTB)
#define PG8_SB(b, h) ((4 + (b) * 2 + (h)) * HTB)
#define PG8_STAGE(bufoff, gbase, voff) do { _Pragma("unroll") for (int _i = 0; _i < 2; ++_i) \
        __builtin_amdgcn_global_load_lds((const unsigned*)((const char*)(gbase) + (voff)[_i]), (PG8_LAS unsigned*)(lds + (bufoff) + ldsw + _i * 8192), 16, 0, 0); } while (0)
#define PG8_LDA(dst, b, h) do { _Pragma("unroll") for (int m = 0; m < 4; ++m) _Pragma("unroll") for (int k = 0; k < 2; ++k) dst[m][k] = *(const PG8_LAS bf16x8*)(lds + PG8_SA(b, h) + aoff + m * 2048 + k * 1024); } while (0)
#define PG8_LDB(dst, b, h) do { _Pragma("unroll") for (int n = 0; n < 2; ++n) _Pragma("unroll") for (int k = 0; k < 2; ++k) dst[n][k] = *(const PG8_LAS bf16x8*)(lds + PG8_SB(b, h) + boff + n * 2048 + k * 1024); } while (0)
#define PG8_MMA(ai, bj, At, Bt) do { __builtin_amdgcn_s_setprio(1); _Pragma("unroll") for (int m = 0; m < 4; ++m) _Pragma("unroll") for (int n = 0; n < 2; ++n) _Pragma("unroll") for (int k = 0; k < 2; ++k) \
        acc[ai][bj][m][n] = __builtin_amdgcn_mfma_f32_16x16x32_bf16(Bt[n][k], At[m][k], acc[ai][bj][m][n], 0, 0, 0); __builtin_amdgcn_s_setprio(0); } while (0)
#define PG8_WAIT_V(n) asm volatile("s_waitcnt vmcnt(" #n ")" ::: "memory")
#define PG8_WAIT_L(n) asm volatile("s_waitcnt lgkmcnt(" #n ")" ::: "memory")
#define PG8_BAR __builtin_amdgcn_s_barrier()
#define PG8_SCHED __builtin_amdgcn_sched_barrier(0)
    Unit cur, nxt; int ui = 0;
    if (!S.next(0, cur)) return;
    f32x4 acc[2][2][4][2];
#pragma unroll
    for (int a = 0; a < 2; ++a)
#pragma unroll
        for (int b = 0; b < 2; ++b)
#pragma unroll
            for (int m = 0; m < 4; ++m)
#pragma unroll
                for (int n = 0; n < 2; ++n) acc[a][b][m][n] = (f32x4){0.f, 0.f, 0.f, 0.f};
    bf16x8 At[4][2], B0[2][2], B1[2][2];
    const char* cA = (const char*)g.A + (size_t)cur.pm * tstep; const char* cB = (const char*)g.Bt + (size_t)cur.pn * tstep;
    S.a_ready(cur);
    if constexpr (SP2) {
        PG8_STAGE(PG8_SB(0, 0), cB, voffB); PG8_STAGE(PG8_SB(0, 1), cB + hstep, voffB); PG8_STAGE(PG8_SA(0, 0), cA, voffA); PG8_STAGE(PG8_SA(0, 1), cA + hstep, voffA);
        if (wr == 1) PG8_BAR;
        PG8_WAIT_V(2); PG8_BAR;
        PG8_STAGE(PG8_SB(1, 0), cB + kstep, voffB); PG8_STAGE(PG8_SA(1, 0), cA + kstep, voffA); PG8_STAGE(PG8_SB(1, 1), cB + hstep + kstep, voffB);
        PG8_WAIT_V(6); PG8_BAR;
    } else {
        PG8_STAGE(PG8_SB(0, 0), cB, voffB); PG8_STAGE(PG8_SA(0, 0), cA, voffA); PG8_STAGE(PG8_SB(0, 1), cB + hstep, voffB); PG8_STAGE(PG8_SA(0, 1), cA + hstep, voffA);
        if (wr == 1) PG8_BAR;
        PG8_WAIT_V(4); PG8_BAR;
        PG8_STAGE(PG8_SB(1, 0), cB + kstep, voffB); PG8_STAGE(PG8_SA(1, 0), cA + kstep, voffA); PG8_STAGE(PG8_SB(1, 1), cB + hstep + kstep, voffB);
        PG8_WAIT_V(6); PG8_BAR;
    }
    for (;;) {
        const bool has_next = S.next(ui + 1, nxt);
        const char* nA = has_next ? (const char*)g.A + (size_t)nxt.pm * tstep : cA; const char* nB = has_next ? (const char*)g.Bt + (size_t)nxt.pn * tstep : cB;
        for (int t = 0; t < nt; t += 2) {
            const bool last = (t == nt - 2);
            const char* a1 = cA + (size_t)(t + 1) * kstep;
            const char* a2 = last ? nA : cA + (size_t)(t + 2) * kstep; const char* b2 = last ? nB : cB + (size_t)(t + 2) * kstep;
            const char* a3 = a2 + kstep; const char* b3 = b2 + kstep;
            if (last && has_next) S.a_ready(nxt);
            if constexpr (SP2) {
            PG8_LDB(B0, 0, 0); PG8_LDB(B1, 0, 1); PG8_SCHED; PG8_LDA(At, 0, 0); PG8_STAGE(PG8_SA(1, 1), a1 + hstep, voffA);
            PG8_WAIT_V(8); PG8_WAIT_L(0); PG8_BAR; PG8_MMA(0, 0, At, B0); PG8_MMA(0, 1, At, B1); PG8_BAR; PG8_SCHED;
            PG8_LDA(At, 0, 1); PG8_STAGE(PG8_SB(0, 0), b2, voffB); PG8_STAGE(PG8_SB(0, 1), b2 + hstep, voffB); PG8_STAGE(PG8_SA(0, 0), a2, voffA);
            PG8_WAIT_V(8); PG8_WAIT_L(0); PG8_BAR; PG8_MMA(1, 0, At, B0); PG8_MMA(1, 1, At, B1); PG8_BAR; PG8_SCHED;
            PG8_LDB(B0, 1, 0); PG8_LDB(B1, 1, 1); PG8_SCHED; PG8_LDA(At, 1, 0); PG8_STAGE(PG8_SA(0, 1), a2 + hstep, voffA);
            PG8_WAIT_V(8); PG8_WAIT_L(0); PG8_BAR; PG8_MMA(0, 0, At, B0); PG8_MMA(0, 1, At, B1); PG8_BAR; PG8_SCHED;
            PG8_LDA(At, 1, 1); PG8_STAGE(PG8_SB(1, 0), b3, voffB); PG8_STAGE(PG8_SB(1, 1), b3 + hstep, voffB); PG8_STAGE(PG8_SA(1, 0), a3, voffA);
            PG8_WAIT_V(8); PG8_WAIT_L(0); PG8_BAR; PG8_MMA(1, 0, At, B0); PG8_MMA(1, 1, At, B1); PG8_BAR; PG8_SCHED;
            } else {
            PG8_LDB(B0, 0, 0); PG8_SCHED; PG8_LDA(At, 0, 0); PG8_STAGE(PG8_SA(1, 1), a1 + hstep, voffA);
            PG8_WAIT_L(8); PG8_BAR; PG8_WAIT_L(0); PG8_MMA(0, 0, At, B0); PG8_BAR; PG8_SCHED;
            PG8_LDB(B1, 0, 1); PG8_STAGE(PG8_SB(0, 0), b2, voffB);
            PG8_BAR; PG8_WAIT_L(0); PG8_MMA(0, 1, At, B1); PG8_BAR;
            PG8_LDA(At, 0, 1); PG8_STAGE(PG8_SA(0, 0), a2, voffA);
            PG8_BAR; PG8_WAIT_L(0); PG8_MMA(1, 0, At, B0); PG8_BAR; PG8_SCHED;
            PG8_STAGE(PG8_SB(0, 1), b2 + hstep, voffB);
            PG8_WAIT_V(6); PG8_BAR; PG8_MMA(1, 1, At, B1); PG8_BAR;
            PG8_LDB(B0, 1, 0); PG8_SCHED; PG8_LDA(At, 1, 0); PG8_STAGE(PG8_SA(0, 1), a2 + hstep, voffA);
            PG8_WAIT_L(8); PG8_BAR; PG8_WAIT_L(0); PG8_MMA(0, 0, At, B0); PG8_BAR; PG8_SCHED;
            PG8_LDB(B1, 1, 1); PG8_STAGE(PG8_SB(1, 0), b3, voffB);
            PG8_BAR; PG8_WAIT_L(0); PG8_MMA(0, 1, At, B1); PG8_BAR;
            PG8_LDA(At, 1, 1); PG8_STAGE(PG8_SA(1, 0), a3, voffA);
            PG8_BAR; PG8_WAIT_L(0); PG8_MMA(1, 0, At, B0); PG8_BAR; PG8_SCHED;
            PG8_STAGE(PG8_SB(1, 1), b3 + hstep, voffB);
            PG8_WAIT_V(6); PG8_BAR; PG8_MMA(1, 1, At, B1); PG8_BAR;
            }
        }
        if constexpr (ALIGN_EPI) { if (wr == 0) PG8_BAR; }
        if constexpr (!Epi::AFTER_DRAIN) { E(acc, cur, wr, wc, fr, fq); S.done(cur); }
        if (!has_next) break;
#pragma unroll
        for (int a = 0; a < 2; ++a)
#pragma unroll
            for (int b = 0; b < 2; ++b)
#pragma unroll
                for (int m = 0; m < 4; ++m)
#pragma unroll
                    for (int n = 0; n < 2; ++n) acc[a][b][m][n] = (f32x4){0.f, 0.f, 0.f, 0.f};
        cur = nxt; cA = nA; cB = nB; ++ui;
        if constexpr (ALIGN_EPI) { if (wr == 1) PG8_BAR; }
    }
    PG8_WAIT_V(0);
    if constexpr (!ALIGN_EPI) { if (wr == 0) PG8_BAR; }
    PG8_BAR;
    if constexpr (Epi::AFTER_DRAIN) { E.fused(acc, cur, wr, wc, fr, fq, lds, wid, lane); S.done(cur); }
#undef PG8_SA
#undef PG8_SB
#undef PG8_STAGE
#undef PG8_LDA
#undef PG8_LDB
#undef PG8_MMA
#undef PG8_WAIT_V
#undef PG8_WAIT_L
#undef PG8_BAR
#undef PG8_SCHED
}
}

constexpr int NWAVES = 8;
#ifndef MK_N_LAUNCHES
#define MK_N_LAUNCHES 1
#endif
#ifndef SIMPLE_ATTN
#define SIMPLE_ATTN 0
#endif
#ifndef SIMPLE_GLA
#define SIMPLE_GLA 0
#endif
#ifndef PG_SP2
#define PG_SP2 true
#endif
#ifndef PG_ALIGN
#define PG_ALIGN true
#endif
#ifndef PROBE_REPEAT
#define PROBE_REPEAT -1
#endif
constexpr int N_PHASES = 14;
constexpr bool ONE_LAUNCH = (MK_N_LAUNCHES == 1);

constexpr int S = 8192, DM = 4096, DFF = 11008, PLE = 256;
constexpr int FH = 16, FD = 128, FW = 2048;
constexpr int GH = 4, GDK = 256, GDV = 512, GKW = 1024, GVW = 2048, GRANK = 16, GC = 64, NCH = S / GC;
constexpr int WIN_COLS = 12320, NWIN = 12288;
constexpr float EPS = 1e-6f;
constexpr float FOX_SCALE = 0.08838834764831845f;

constexpr size_t MiB = 1u << 20;
constexpr size_t WS_CTL = 0, CTL_ZERO_BYTES = 1 * MiB;
constexpr size_t WS_WSK = 1 * MiB;
constexpr size_t WS_WPP = 2 * MiB;
constexpr size_t WS_W1GU = 4 * MiB;
constexpr size_t WS_W1D = 176 * MiB;
constexpr size_t WS_W2GU = 262 * MiB;
constexpr size_t WS_W2D = 434 * MiB;
constexpr size_t WS_WIN = 520 * MiB;
constexpr size_t WS_WO = 616 * MiB;
constexpr size_t WS_WPG = 648 * MiB;
constexpr size_t WS_H = 680 * MiB;
constexpr size_t WS_F = 808 * MiB;
constexpr size_t WS_XN = 936 * MiB;
constexpr size_t WS_MIX = 1000 * MiB;
constexpr size_t WS_ACT = 1064 * MiB;
constexpr size_t WS_Q = 1064 * MiB, WS_K = 1096 * MiB, WS_V = 1128 * MiB;
constexpr size_t WS_GQ = 1160 * MiB, WS_GK = 1176 * MiB;
constexpr size_t WS_GV = 1192 * MiB, WS_GR = 1224 * MiB;
constexpr size_t WS_QDEC = 1256 * MiB, WS_KTE = 1272 * MiB, WS_VT = 1288 * MiB, WS_AM = 1320 * MiB;
constexpr size_t WS_MISC = 1324 * MiB;
constexpr size_t WS_OGLA = 1328 * MiB;
constexpr size_t WS_ERAW = 1256 * MiB;
constexpr size_t WS_PBF = 1392 * MiB;
constexpr size_t WS_END = 1396 * MiB;
static_assert(WS_ERAW + (size_t)S * DM * 4 <= WS_PBF && WS_ACT + (size_t)S * DFF * 2 <= WS_ERAW && WS_OGLA + (size_t)S * GVW * 4 <= WS_PBF, "d_ws map");
constexpr int CW_TMO = 0, CW_CODE = 1;
constexpr int CW_BAR = 4096;
constexpr int CW_NRM = 2048;

constexpr int RING_OFF = 0, RING_BYTES = 131072;
constexpr int LDS_BYTES = 147456;
constexpr int LDSCTL_OFF = LDS_BYTES - 1024, MISC_OFF = LDSCTL_OFF + 320;

#define GAS __attribute__((address_space(1)))
#define LAS __attribute__((address_space(3)))
typedef unsigned short bf16;
typedef unsigned v4u __attribute__((ext_vector_type(4)));
typedef unsigned v2u __attribute__((ext_vector_type(2)));
typedef float f32x4 __attribute__((ext_vector_type(4)));
typedef float f32x16 __attribute__((ext_vector_type(16)));
typedef short bf16x8 __attribute__((ext_vector_type(8)));
typedef GAS unsigned gu32;
typedef GAS unsigned long long gu64;
#define RLX_AGENT __ATOMIC_RELAXED, __HIP_MEMORY_SCOPE_AGENT
#define LDS_WAIT() asm volatile("s_waitcnt lgkmcnt(0)" ::: "memory")
#define VM_WAIT() asm volatile("s_waitcnt vmcnt(0)" ::: "memory")
__device__ __forceinline__ unsigned f2bf(float f) { unsigned u = __builtin_bit_cast(unsigned, f); return (u + 0x7fffu + ((u >> 16) & 1u)) >> 16; }
__device__ __forceinline__ unsigned pk2(float lo, float hi) { return f2bf(lo) | (f2bf(hi) << 16); }
__device__ __forceinline__ float bf2f(unsigned short b) { return __builtin_bit_cast(float, (unsigned)b << 16); }
__device__ __forceinline__ float bflo(unsigned w) { return __builtin_bit_cast(float, w << 16); }
__device__ __forceinline__ float bfhi(unsigned w) { return __builtin_bit_cast(float, w & 0xffff0000u); }
__device__ __forceinline__ float log_sigmoid_f(float z) { return fminf(z, 0.f) - log1pf(expf(-fabsf(z))); }
#define XB_TMO      128
#define XB_XCNT(j)  (256  + 64 * (j))
#define XB_XSUB(j)  (1280 + 64 * (j))
#define XB_XGEN(j)  (2304 + 64 * (j))
#define XB_TOP      3328
#define XB_TOPGEN   3392
#define XCD_BAR_WORDS 3456
#define XB_SPIN_CAP (1u << 21)

__device__ __forceinline__ unsigned xb_ld(unsigned* p)              { return __hip_atomic_load(p, __ATOMIC_RELAXED, __HIP_MEMORY_SCOPE_AGENT); }
__device__ __forceinline__ unsigned xb_add(unsigned* p, unsigned v) { return __hip_atomic_fetch_add(p, v, __ATOMIC_RELAXED, __HIP_MEMORY_SCOPE_AGENT); }
__device__ __forceinline__ unsigned xb_xcc_id() { return (unsigned)__builtin_amdgcn_s_getreg((3 << 11) | 20) & 0xFu; }
#define XB_SPIN(cond, bar) do { unsigned _sp = 0; while (cond) { __builtin_amdgcn_s_sleep(1); \
    if ((++_sp & 255u) == 0u) { if (xb_ld(&(bar)[XB_TMO])) break; if (_sp > XB_SPIN_CAP) { atomicAdd(&(bar)[XB_TMO], 1u); break; } } } } while (0)

struct XcdBarrier {
    unsigned* bar; unsigned x;
    volatile LAS unsigned* st;
};

__device__ __forceinline__ XcdBarrier xcd_barrier_post(unsigned* bar, volatile LAS unsigned* st) {
    XcdBarrier b; b.bar = bar; b.x = xb_xcc_id(); b.st = st;
    if (threadIdx.x == 0) (void)xb_add(&bar[XB_XCNT(b.x)], 1u);
    return b;
}
__device__ __forceinline__ void xcd_barrier_complete(unsigned* bar, unsigned x, unsigned& nloc, unsigned& nx) {
    const unsigned G = gridDim.x * gridDim.y * gridDim.z;
    unsigned sum, cnt, mine, sp = 0u;
    for (;;) {
        sum = 0u; cnt = 0u; mine = 0u;
#pragma unroll
        for (unsigned j = 0; j < 16; ++j) { const unsigned c = xb_ld(&bar[XB_XCNT(j)]); sum += c; cnt += (c > 0u) ? 1u : 0u; mine = (j == x) ? c : mine; }
        if (sum == G) break;
        __builtin_amdgcn_s_sleep(1);
        if ((++sp & 255u) == 0u) { if (xb_ld(&bar[XB_TMO])) break; if (sp > XB_SPIN_CAP) { atomicAdd(&bar[XB_TMO], 1u); break; } }
    }
    nloc = mine > 0u ? mine : 1u; nx = cnt > 0u ? cnt : 1u;
}

__device__ __forceinline__ void xcd_barrier(const XcdBarrier& b) {
    asm volatile("s_waitcnt vmcnt(0)" ::: "memory");
    __syncthreads();
    if (threadIdx.x == 0) {
        unsigned* bar = b.bar;
        __builtin_amdgcn_s_waitcnt(0);
        unsigned nloc = b.st[0], nx = b.st[1];
        if (nloc == 0u) { xcd_barrier_complete(bar, b.x, nloc, nx); b.st[0] = nloc; b.st[1] = nx; }
        const unsigned old = xb_add(&bar[XB_XSUB(b.x)], 1u);
        const unsigned gen = old / nloc;
        if (old + 1u == (gen + 1u) * nloc) {
            __builtin_amdgcn_fence(__ATOMIC_RELEASE, "agent");
            asm volatile("s_waitcnt vmcnt(0)" ::: "memory");
            const unsigned og = xb_add(&bar[XB_TOP], 1u);
            const unsigned tg = og / nx;
            if (og + 1u == (tg + 1u) * nx) xb_add(&bar[XB_TOPGEN], 1u);
            else XB_SPIN(xb_ld(&bar[XB_TOPGEN]) == tg, bar);
            __builtin_amdgcn_fence(__ATOMIC_ACQUIRE, "agent");
            xb_add(&bar[XB_XGEN(b.x)], 1u);
            asm volatile("s_waitcnt vmcnt(0)" ::: "memory");
        } else {
            XB_SPIN(xb_ld(&bar[XB_XGEN(b.x)]) == gen, bar);
            __builtin_amdgcn_fence(__ATOMIC_ACQUIRE, "agent");
            asm volatile("s_waitcnt vmcnt(0)" ::: "memory");
        }
    }
    __syncthreads();
}


struct Frame {
    LAS unsigned char* lds;
    volatile LAS unsigned* MISC;
    gu32* ctl;
    int tid, lane, wave;
    int vcu, G;
};
__device__ __forceinline__ float wave_sum(float v) {
#pragma unroll
    for (int o = 1; o < 64; o <<= 1) v += __shfl_xor(v, o);
    return v;
}
template <class RowMap>
__device__ __forceinline__ void p0_transpose_item(const float* W, int N, int K, LAS float* scr, int kb, int nb, int lane, const RowMap& rm) {
    const int k0 = 64 * kb, n0 = 32 * nb;
    float v[32];
#pragma unroll
    for (int i = 0; i < 32; ++i) v[i] = W[(size_t)(k0 + 2 * i + (lane >> 5)) * N + n0 + (lane & 31)];
#pragma unroll
    for (int i = 0; i < 32; ++i) scr[(2 * i + (lane >> 5)) * 33 + (lane & 31)] = v[i];
    LDS_WAIT(); asm volatile("" ::: "memory");
    const int c = lane & 7;
#pragma unroll
    for (int j = 0; j < 4; ++j) { const int n = (lane >> 3) + 8 * j; const LAS float* s = scr + (8 * c) * 33 + n;
        v4u o; o.x = pk2(s[0 * 33], s[1 * 33]); o.y = pk2(s[2 * 33], s[3 * 33]); o.z = pk2(s[4 * 33], s[5 * 33]); o.w = pk2(s[6 * 33], s[7 * 33]);
        *(GAS v4u*)(rm(n0 + n) + k0 + 8 * c) = o; }
    LDS_WAIT(); asm volatile("" ::: "memory");
}
struct RmPlain { bf16* WT; int K; __device__ __forceinline__ bf16* operator()(int n) const { return WT + (size_t)n * K; } };
struct RmGateUp { bf16* WT; int up; __device__ __forceinline__ bf16* operator()(int n) const { return WT + (size_t)(256 * (n >> 7) + 128 * up + (n & 127)) * DM; } };
struct RmWin { bf16* WT; bf16* SK;
    __device__ __forceinline__ bf16* operator()(int n) const {
        if (n < 6144) return WT + (size_t)n * DM;
        if (n < 6160) return SK + (size_t)(n - 6144) * DM;
        if (n < 12304) return WT + (size_t)(n - 16) * DM;
        return SK + (size_t)(16 + n - 12304) * DM; } };

constexpr int NSCAN = GH * 16;
constexpr int CV_GU = (DM / 64) * (DFF / 32), CV_D = (DFF / 64) * (DM / 32), CV_IN = (DM / 64) * (WIN_COLS / 32), CV_SQ = (DM / 64) * (DM / 32), CV_PP = (PLE / 64) * (DM / 32);
constexpr int CV_TAIL = CV_D / 2;
constexpr int CV_A = 2 * CV_GU + CV_IN, CV_B = CV_A + CV_D, CV_C = CV_B + 2 * CV_GU + 2 * CV_SQ + CV_PP, CV_D2 = CV_C + CV_D;
__device__ __forceinline__ void convert_items(Frame& F, const float* const* in, unsigned char* ws, int first, int last, int wv, int nwv) {
    LAS float* scr = (LAS float*)(F.lds + RING_OFF + F.wave * 16384);
    bf16* W1GU = (bf16*)(ws + WS_W1GU); bf16* W1D = (bf16*)(ws + WS_W1D); bf16* W2GU = (bf16*)(ws + WS_W2GU); bf16* W2D = (bf16*)(ws + WS_W2D);
    bf16* WIN = (bf16*)(ws + WS_WIN); bf16* WSK = (bf16*)(ws + WS_WSK); bf16* WO = (bf16*)(ws + WS_WO); bf16* WPG = (bf16*)(ws + WS_WPG); bf16* WPP = (bf16*)(ws + WS_WPP);
    for (int it = first + wv; it < last; it += nwv) {
        int r = it;
        if (r < CV_GU) { p0_transpose_item(in[3], DFF, DM, scr, r / (DFF / 32), r % (DFF / 32), F.lane, RmGateUp{W1GU, 0}); continue; } r -= CV_GU;
        if (r < CV_GU) { p0_transpose_item(in[4], DFF, DM, scr, r / (DFF / 32), r % (DFF / 32), F.lane, RmGateUp{W1GU, 1}); continue; } r -= CV_GU;
        if (r < CV_IN) { p0_transpose_item(in[8], WIN_COLS, DM, scr, r / (WIN_COLS / 32), r % (WIN_COLS / 32), F.lane, RmWin{WIN, WSK}); continue; } r -= CV_IN;
        if (r < CV_D) { p0_transpose_item(in[5], DM, DFF, scr, r / (DM / 32), r % (DM / 32), F.lane, RmPlain{W1D, DFF}); continue; } r -= CV_D;
        if (r < CV_GU) { p0_transpose_item(in[16], DFF, DM, scr, r / (DFF / 32), r % (DFF / 32), F.lane, RmGateUp{W2GU, 0}); continue; } r -= CV_GU;
        if (r < CV_GU) { p0_transpose_item(in[17], DFF, DM, scr, r / (DFF / 32), r % (DFF / 32), F.lane, RmGateUp{W2GU, 1}); continue; } r -= CV_GU;
        if (r < CV_SQ) { p0_transpose_item(in[13], DM, DM, scr, r / (DM / 32), r % (DM / 32), F.lane, RmPlain{WO, DM}); continue; } r -= CV_SQ;
        if (r < CV_SQ) { p0_transpose_item(in[22], DM, DM, scr, r / (DM / 32), r % (DM / 32), F.lane, RmPlain{WPG, DM}); continue; } r -= CV_SQ;
        if (r < CV_PP) { p0_transpose_item(in[20], DM, PLE, scr, r / (DM / 32), r % (DM / 32), F.lane, RmPlain{WPP, PLE}); continue; } r -= CV_PP;
        p0_transpose_item(in[18], DM, DFF, scr, r / (DM / 32), r % (DM / 32), F.lane, RmPlain{W2D, DFF});
    }
}

__device__ __forceinline__ void norm_row_to_bf16(const float* xrow, const float* g, bf16* orow, int lane) {
    const GAS f32x4* xr = (const GAS f32x4*)xrow + lane; const GAS f32x4* gr = (const GAS f32x4*)g + lane;
    f32x4 v[16]; float s = 0.f;
#pragma unroll
    for (int j = 0; j < 16; ++j) { v[j] = xr[64 * j]; s += (v[j].x * v[j].x + v[j].y * v[j].y) + (v[j].z * v[j].z + v[j].w * v[j].w); }
    const float rstd = 1.f / sqrtf(wave_sum(s) * (1.f / DM) + EPS);
    GAS v2u* o8 = (GAS v2u*)orow + lane;
#pragma unroll
    for (int j = 0; j < 16; ++j) { const f32x4 gg = gr[64 * j]; v2u w; w.x = pk2(v[j].x * rstd * gg.x, v[j].y * rstd * gg.y); w.y = pk2(v[j].z * rstd * gg.z, v[j].w * rstd * gg.w); o8[64 * j] = w; }
}
template <bool NORM2>
__device__ __forceinline__ void resid_row(const bf16* frow, const float* baserow, float wgt, const float* g1, const float* g2, float* hout, bf16* bout, int lane) {
    const GAS v2u* fr = (const GAS v2u*)frow + lane; const GAS f32x4* br = (const GAS f32x4*)baserow + lane;
    const GAS f32x4* g1r = (const GAS f32x4*)g1 + lane; const GAS f32x4* g2r = (const GAS f32x4*)g2 + lane;
    f32x4 v[16]; float s = 0.f;
#pragma unroll
    for (int j = 0; j < 16; ++j) { const v2u fw = fr[64 * j]; v[j] = (f32x4){bflo(fw.x), bfhi(fw.x), bflo(fw.y), bfhi(fw.y)}; s += (v[j].x * v[j].x + v[j].y * v[j].y) + (v[j].z * v[j].z + v[j].w * v[j].w); }
    const float rw = wgt / sqrtf(wave_sum(s) * (1.f / DM) + EPS);
    float s2 = 0.f; GAS f32x4* ho = (GAS f32x4*)hout + lane;
#pragma unroll
    for (int j = 0; j < 16; ++j) { const f32x4 b = br[64 * j], gg = g1r[64 * j]; v[j] = b + v[j] * rw * gg; ho[64 * j] = v[j];
        s2 += (v[j].x * v[j].x + v[j].y * v[j].y) + (v[j].z * v[j].z + v[j].w * v[j].w);
        if ((j & 3) == 3) asm volatile("" ::: "memory"); }
    GAS v2u* o8 = (GAS v2u*)bout + lane;
    if (NORM2) { const float r2 = 1.f / sqrtf(wave_sum(s2) * (1.f / DM) + EPS);
#pragma unroll
        for (int j = 0; j < 16; ++j) { const f32x4 gg = g2r[64 * j]; v2u w; w.x = pk2(v[j].x * r2 * gg.x, v[j].y * r2 * gg.y); w.y = pk2(v[j].z * r2 * gg.z, v[j].w * r2 * gg.w); o8[64 * j] = w;
            if ((j & 7) == 7) asm volatile("" ::: "memory"); } }
    else {
#pragma unroll
        for (int j = 0; j < 16; ++j) { v2u w; w.x = pk2(v[j].x, v[j].y); w.y = pk2(v[j].z, v[j].w); o8[64 * j] = w; } }
}

__device__ __forceinline__ void skinny_gemm(Frame& F, const bf16* XN, const bf16* WSK, float* FFGLR) {
    LAS float* red = (LAS float*)(F.lds + RING_OFF);
    const int r = F.lane & 31, h = F.lane >> 5;
    for (int blk = F.vcu; blk < S / 32; blk += F.G) {
        const bf16* ap = XN + (size_t)(blk * 32 + r) * DM + F.wave * 512 + 8 * h; const bf16* bp = WSK + (size_t)r * DM + F.wave * 512 + 8 * h;
        f32x16 acc = {};
#pragma unroll 8
        for (int ks = 0; ks < 32; ++ks) { const bf16x8 a = *(const GAS bf16x8*)(ap + ks * 16), b = *(const GAS bf16x8*)(bp + ks * 16);
            acc = __builtin_amdgcn_mfma_f32_32x32x16_bf16(a, b, acc, 0, 0, 0); }
        __syncthreads();
#pragma unroll
        for (int i = 0; i < 16; ++i) red[(F.wave * 32 + ((i & 3) + 8 * (i >> 2) + 4 * h)) * 33 + r] = acc[i];
        __syncthreads();
        for (int e = F.tid; e < 1024; e += NWAVES * 64) { const int row = e >> 5, col = e & 31; float s = 0.f;
#pragma unroll
            for (int w = 0; w < 8; ++w) s += red[(w * 32 + row) * 33 + col];
            FFGLR[(size_t)(blk * 32 + row) * 32 + col] = s; }
    }
    __syncthreads();
}


__device__ __forceinline__ void fox_norms(Frame& F, const bf16* Q, const bf16* K, gu32* NRM) {
    const int gw_ = F.vcu * NWAVES + F.wave, ngw = F.G * NWAVES, sub = F.lane >> 4, l16 = F.lane & 15;
    for (int hd = 0; hd < FH; ++hd) { float mq = 0.f, mk = 0.f;
        for (int r0 = gw_ * 4; r0 < S; r0 += ngw * 4) { const size_t o = ((size_t)hd * S + r0 + sub) * FD + l16 * 8;
            const v4u a = *(const GAS v4u*)(Q + o), b = *(const GAS v4u*)(K + o);
            float sq = bflo(a.x) * bflo(a.x) + bfhi(a.x) * bfhi(a.x) + bflo(a.y) * bflo(a.y) + bfhi(a.y) * bfhi(a.y) + bflo(a.z) * bflo(a.z) + bfhi(a.z) * bfhi(a.z) + bflo(a.w) * bflo(a.w) + bfhi(a.w) * bfhi(a.w);
            float sk = bflo(b.x) * bflo(b.x) + bfhi(b.x) * bfhi(b.x) + bflo(b.y) * bflo(b.y) + bfhi(b.y) * bfhi(b.y) + bflo(b.z) * bflo(b.z) + bfhi(b.z) * bfhi(b.z) + bflo(b.w) * bflo(b.w) + bfhi(b.w) * bfhi(b.w);
#pragma unroll
            for (int o2 = 1; o2 < 16; o2 <<= 1) { sq += __shfl_xor(sq, o2); sk += __shfl_xor(sk, o2); }
            mq = fmaxf(mq, sq); mk = fmaxf(mk, sk); }
        mq = fmaxf(mq, __shfl_xor(mq, 16)); mq = fmaxf(mq, __shfl_xor(mq, 32)); mk = fmaxf(mk, __shfl_xor(mk, 16)); mk = fmaxf(mk, __shfl_xor(mk, 32));
        if (F.lane == 0) { __hip_atomic_fetch_max(NRM + 2 * hd, __builtin_bit_cast(unsigned, mq), RLX_AGENT); __hip_atomic_fetch_max(NRM + 2 * hd + 1, __builtin_bit_cast(unsigned, mk), RLX_AGENT); } }
}
constexpr float CF_SCALE = SIMPLE_ATTN ? 1.0f : 11.313708498984761f;
__device__ __forceinline__ void fox_prep(Frame& F, const float* FFGLR, const float* bfv, float* cf) {
    LAS float* sc = (LAS float*)(F.lds + RING_OFF);
    for (int hd = F.vcu; hd < FH; hd += F.G) {
        const float b = bfv[hd]; const int t0 = F.tid * 16; float v[16]; float run = 0.f;
#pragma unroll
        for (int j = 0; j < 16; ++j) { run += log_sigmoid_f(FFGLR[(size_t)(t0 + j) * 32 + hd] + b); v[j] = run; }
        float inc = run;
#pragma unroll
        for (int o = 1; o < 64; o <<= 1) { const float n = __shfl_up(inc, o); if (F.lane >= o) inc += n; }
        __syncthreads();
        if (F.lane == 63) sc[512 + F.wave] = inc;
        __syncthreads();
        float woff = 0.f;
        for (int w = 0; w < F.wave; ++w) woff += sc[512 + w];
        const float excl = woff + inc - run;
#pragma unroll
        for (int j = 0; j < 16; ++j) cf[(size_t)hd * S + t0 + j] = (v[j] + excl) * CF_SCALE;
    }
    __syncthreads();
}

#if SIMPLE_ATTN
__device__ __forceinline__ void attn_simple(Frame& F, const bf16* Q, const bf16* K, const bf16* V, const float* cf, bf16* MIX) {
    LAS unsigned char* kt = F.lds + RING_OFF; LAS unsigned char* vt = kt + 16384; LAS float* ck = (LAS float*)(vt + 16384);
    const int row = F.tid >> 3, part = F.tid & 7;
    for (int item = F.vcu; item < FH * (S / 64); item += F.G) {
        const int hd = item & 15, qb = (S / 64 - 1) - (item >> 4), qrow = qb * 64 + row;
        float q[16], o[16]; float m = -1e30f, l = 0.f;
        { const GAS v4u* qp = (const GAS v4u*)(Q + ((size_t)hd * S + qrow) * FD + part * 16); const v4u a = qp[0], b = qp[1];
          const unsigned w[8] = {a.x, a.y, a.z, a.w, b.x, b.y, b.z, b.w};
#pragma unroll
          for (int j = 0; j < 8; ++j) { q[2 * j] = bflo(w[j]) * FOX_SCALE; q[2 * j + 1] = bfhi(w[j]) * FOX_SCALE; } }
#pragma unroll
        for (int j = 0; j < 16; ++j) o[j] = 0.f;
        const float cq = cf[(size_t)hd * S + qrow];
        for (int ktile = 0; ktile <= qb; ++ktile) {
            __syncthreads();
            for (int e = F.tid; e < 1024; e += NWAVES * 64) { const int key = e >> 4, ch = e & 15;
                *(LAS v4u*)(kt + key * 256 + ch * 16) = *(const GAS v4u*)(K + ((size_t)hd * S + ktile * 64 + key) * FD + ch * 8);
                *(LAS v4u*)(vt + key * 256 + ch * 16) = *(const GAS v4u*)(V + ((size_t)hd * S + ktile * 64 + key) * FD + ch * 8); }
            if (F.tid < 64) ck[F.tid] = cf[(size_t)hd * S + ktile * 64 + F.tid];
            __syncthreads();
#pragma unroll 1
            for (int kb = 0; kb < 4; ++kb) {
                float s[16]; float mx = -__builtin_inff();
#pragma unroll
                for (int kk = 0; kk < 16; ++kk) { const int key = kb * 16 + kk;
                    const v4u a = *(const LAS v4u*)(kt + key * 256 + part * 32), b = *(const LAS v4u*)(kt + key * 256 + part * 32 + 16);
                    const unsigned w[8] = {a.x, a.y, a.z, a.w, b.x, b.y, b.z, b.w}; float d = 0.f;
#pragma unroll
                    for (int j = 0; j < 8; ++j) d += q[2 * j] * bflo(w[j]) + q[2 * j + 1] * bfhi(w[j]);
                    d += __shfl_xor(d, 1); d += __shfl_xor(d, 2); d += __shfl_xor(d, 4);
                    d += cq - ck[key];
                    if (ktile * 64 + key > qrow) d = -__builtin_inff();
                    s[kk] = d; mx = fmaxf(mx, d); }
                const float mn = fmaxf(m, mx), alpha = __expf(m - mn); l *= alpha; m = mn;
#pragma unroll
                for (int j = 0; j < 16; ++j) o[j] *= alpha;
#pragma unroll
                for (int kk = 0; kk < 16; ++kk) { const int key = kb * 16 + kk; const float p = __expf(s[kk] - mn); l += p;
                    const v4u a = *(const LAS v4u*)(vt + key * 256 + part * 32), b = *(const LAS v4u*)(vt + key * 256 + part * 32 + 16);
                    const unsigned w[8] = {a.x, a.y, a.z, a.w, b.x, b.y, b.z, b.w};
#pragma unroll
                    for (int j = 0; j < 8; ++j) { o[2 * j] += p * bflo(w[j]); o[2 * j + 1] += p * bfhi(w[j]); } }
            }
        }
        const float il = 1.f / l; v4u w0, w1;
        w0.x = pk2(o[0] * il, o[1] * il); w0.y = pk2(o[2] * il, o[3] * il); w0.z = pk2(o[4] * il, o[5] * il); w0.w = pk2(o[6] * il, o[7] * il);
        w1.x = pk2(o[8] * il, o[9] * il); w1.y = pk2(o[10] * il, o[11] * il); w1.z = pk2(o[12] * il, o[13] * il); w1.w = pk2(o[14] * il, o[15] * il);
        GAS v4u* op = (GAS v4u*)(MIX + (size_t)qrow * DM + hd * FD + part * 16); op[0] = w0; op[1] = w1;
    }
    __syncthreads();
}
#endif

#if SIMPLE_GLA
__device__ __forceinline__ void gla_simple(Frame& F, const bf16* GQ, const bf16* GK, const bf16* GV, const float* FFGLR, const float* Wg, const float* bg, float* OGLA) {
    constexpr int TB = 16;
    LAS float* qs = (LAS float*)(F.lds + RING_OFF);
    LAS float* ks = qs + TB * 256;
    LAS float* vs = ks + TB * 256;
    LAS float* gs = vs + TB * 32;
    LAS float* red = gs + TB * 16;
    const int dk = F.tid & 255, half = F.tid >> 8;
    for (int item = F.vcu; item < GH * 16; item += F.G) {
        const int hd = item >> 4, sl = item & 15, col = hd * GDK + dk;
        float wg[16];
#pragma unroll
        for (int r = 0; r < 16; ++r) wg[r] = Wg[r * GKW + col];
        const float bgv = bg[col];
        float st[16];
#pragma unroll
        for (int j = 0; j < 16; ++j) st[j] = 0.f;
        for (int t0 = 0; t0 < S; t0 += TB) {
            __syncthreads();
            for (int e = F.tid; e < TB * 256; e += NWAVES * 64) { const int tt = e >> 8, d = e & 255;
                qs[e] = bf2f(GQ[(size_t)(t0 + tt) * GKW + hd * GDK + d]) * 0.0625f; ks[e] = bf2f(GK[(size_t)(t0 + tt) * GKW + hd * GDK + d]); }
            { const int tt = F.tid >> 5, c = F.tid & 31; vs[F.tid] = bf2f(GV[(size_t)(t0 + tt) * GVW + hd * GDV + sl * 32 + c]); }
            if (F.tid < TB * 16) { const int tt = F.tid >> 4, r = F.tid & 15; gs[F.tid] = FFGLR[(size_t)(t0 + tt) * 32 + 16 + r]; }
            __syncthreads();
#pragma unroll 1
            for (int tt = 0; tt < TB; ++tt) {
                float z = bgv;
#pragma unroll
                for (int r = 0; r < 16; ++r) z += gs[tt * 16 + r] * wg[r];
                const float a = expf(log_sigmoid_f(z) * 0.0625f), kv = ks[tt * 256 + dk], qv = qs[tt * 256 + dk];
                float part[16];
#pragma unroll
                for (int j = 0; j < 16; ++j) { st[j] = a * st[j] + kv * vs[tt * 32 + half * 16 + j]; part[j] = qv * st[j]; }
#pragma unroll
                for (int j = 0; j < 16; ++j) {
#pragma unroll
                    for (int o = 1; o < 64; o <<= 1) part[j] += __shfl_xor(part[j], o); }
                float mine = part[0];
#pragma unroll
                for (int j = 1; j < 16; ++j) mine = (F.lane == j) ? part[j] : mine;
                if (F.lane < 16) red[(tt * 8 + F.wave) * 16 + F.lane] = mine;
            }
            __syncthreads();
            { const int tt = F.tid >> 5, c = F.tid & 31, hw = c >> 4, j = c & 15; float s = 0.f;
#pragma unroll
              for (int w = 0; w < 4; ++w) s += red[(tt * 8 + hw * 4 + w) * 16 + j];
              OGLA[(size_t)(t0 + tt) * GVW + hd * GDV + sl * 32 + c] = s; }
        }
    }
    __syncthreads();
}
#endif

__device__ __forceinline__ void gla_post(Frame& F, const float* OGLA, const bf16* GR, const float* g, bf16* MIX) {
    const int gw = F.vcu * NWAVES + F.wave, NGW = F.G * NWAVES;
    for (int it = gw; it < S * GH; it += NGW) { const int row = it >> 2, hd = it & 3;
        const GAS f32x4* op = (const GAS f32x4*)(OGLA + (size_t)row * GVW + hd * GDV) + 2 * F.lane; const f32x4 a = op[0], b = op[1];
        const float ss = (a.x * a.x + a.y * a.y) + (a.z * a.z + a.w * a.w) + (b.x * b.x + b.y * b.y) + (b.z * b.z + b.w * b.w);
        const float rstd = 1.f / sqrtf(wave_sum(ss) * (1.f / GDV) + EPS);
        const v4u rw = *(const GAS v4u*)(GR + (size_t)row * GVW + hd * GDV + 8 * F.lane);
        const GAS f32x4* gp = (const GAS f32x4*)(g) + 2 * F.lane; const f32x4 g0 = gp[0], g1 = gp[1];
        v4u w;
        w.x = pk2(a.x * rstd * g0.x * pg8::silu_f(bflo(rw.x)), a.y * rstd * g0.y * pg8::silu_f(bfhi(rw.x)));
        w.y = pk2(a.z * rstd * g0.z * pg8::silu_f(bflo(rw.y)), a.w * rstd * g0.w * pg8::silu_f(bfhi(rw.y)));
        w.z = pk2(b.x * rstd * g1.x * pg8::silu_f(bflo(rw.z)), b.y * rstd * g1.y * pg8::silu_f(bfhi(rw.z)));
        w.w = pk2(b.z * rstd * g1.z * pg8::silu_f(bflo(rw.w)), b.w * rstd * g1.w * pg8::silu_f(bfhi(rw.w)));
        *(GAS v4u*)(MIX + (size_t)row * DM + FW + hd * GDV + 8 * F.lane) = w; }
}

#if !SIMPLE_ATTN
namespace fa {
constexpr int D = 128, NW = 8, QBLK = 32, KVBLK = 64, QB = NW * QBLK, LDO = 4096;
constexpr int SHM_V = KVBLK * D * 2, SHM_K = KVBLK * D * 2;
constexpr int OFF_Q = 2 * SHM_V + 2 * SHM_K, OFF_CK = 131072 + 1024, OFF_WS = OFF_CK + 512, ATT_LDS_END = OFF_WS + NW * 64 * 4;
constexpr float SCALE = 0.08838834764831845f, THR = 8.f;
typedef short s16x4 __attribute__((ext_vector_type(4)));
typedef unsigned u32x4 __attribute__((ext_vector_type(4)));
#define KSWZ(row, colB) ((row) * 256 + ((colB) ^ (((row) & 7) << 4)))
#define SBAR() __builtin_amdgcn_sched_barrier(0)
__device__ __forceinline__ int v_st(int k, int c) { const int kk = (k & ~0xC) | ((k & 4) << 1) | ((k & 8) >> 1); return ((kk >> 3) * 4 + (c >> 5)) * 512 + ((kk & 7) * 32 + (c & 31)) * 2; }
__device__ __forceinline__ int v_rd_base(int lane) { return ((lane & 3) << 3) | (((lane >> 2) & 3) << 6) | (((lane >> 4) & 1) << 5) | (((lane >> 5) & 1) << 8); }
constexpr int v_rd_off(int d0, int ks, int half) { return d0 * 512 + ks * 4096 + half * 2048; }
__device__ __forceinline__ int crow(int r, int hi) { return (r & 3) + 8 * (r >> 2) + 4 * hi; }
__device__ __forceinline__ unsigned cvtpk(float lo, float hi) { unsigned r; asm volatile("v_cvt_pk_bf16_f32 %0, %1, %2" : "=v"(r) : "v"(lo), "v"(hi)); return r; }
__device__ __forceinline__ bf16x8 ld8(const bf16* p) { return *reinterpret_cast<const bf16x8*>(p); }
__device__ __forceinline__ void mask_tile(f32x16& p0, f32x16& p1, int dq) {
    const float NEG = -__builtin_inff();
#pragma unroll
    for (int r = 0; r < 16; ++r) { const int c = (r & 3) + 8 * (r >> 2);
        if (dq - c < 0) p0[r] = NEG;
        if (dq - c - 32 < 0) p1[r] = NEG; }
}
__device__ __forceinline__ void partialSM(f32x16& p0, f32x16& p1, float& m_reg, float& mn, float& alpha) {
    float pmax = p0[0]; for (int r = 1; r < 16; ++r) pmax = fmaxf(pmax, p0[r]); for (int r = 0; r < 16; ++r) pmax = fmaxf(pmax, p1[r]);
    { auto rr = __builtin_amdgcn_permlane32_swap(__float_as_uint(pmax), __float_as_uint(pmax), false, false);
      pmax = fmaxf(__uint_as_float(rr[0]), __uint_as_float(rr[1])); }
    constexpr float C2 = 1.4426950408889634f * SCALE;
    if (__builtin_expect(__all((pmax - m_reg) * SCALE <= THR), 1)) { mn = m_reg; alpha = 1.f; }
    else { mn = fmaxf(m_reg, pmax); alpha = __builtin_amdgcn_exp2f((m_reg - mn) * C2); m_reg = mn; }
    const float mnL = -mn * C2;
    for (int r = 0; r < 16; ++r) p0[r] = fmaf(p0[r], C2, mnL); for (int r = 0; r < 16; ++r) p1[r] = fmaf(p1[r], C2, mnL);
    for (int r = 0; r < 16; ++r) p0[r] = __builtin_amdgcn_exp2f(p0[r]);
}
__device__ __forceinline__ void finishSM(f32x16& p0, f32x16& p1, float alpha, float& l_reg, bf16x8& pa0, bf16x8& pa1, bf16x8& pa2, bf16x8& pa3) {
    for (int r = 0; r < 16; ++r) p1[r] = __builtin_amdgcn_exp2f(p1[r]);
    float ps = 0; for (int r = 0; r < 16; ++r) ps += p0[r]; for (int r = 0; r < 16; ++r) ps += p1[r];
    { auto rr = __builtin_amdgcn_permlane32_swap(__float_as_uint(ps), __float_as_uint(ps), false, false);
      ps = __uint_as_float(rr[0]) + __uint_as_float(rr[1]); }
    l_reg = l_reg * alpha + ps;
#define PK4(P, B_, OUT) do { unsigned a0 = cvtpk(P[B_+0], P[B_+1]), a1 = cvtpk(P[B_+2], P[B_+3]);                          \
        unsigned b0 = cvtpk(P[B_+4], P[B_+5]), b1 = cvtpk(P[B_+6], P[B_+7]);                                             \
        auto r0 = __builtin_amdgcn_permlane32_swap(a0, b0, false, false); auto r1 = __builtin_amdgcn_permlane32_swap(a1, b1, false, false); \
        u32x4 w = {r0[0], r1[0], r0[1], r1[1]}; OUT = *reinterpret_cast<bf16x8*>(&w); } while (0)
    PK4(p0, 0, pa0); PK4(p0, 8, pa1); PK4(p1, 0, pa2); PK4(p1, 8, pa3);
#undef PK4
}
template <int KB>
__device__ __forceinline__ void qkt(f32x16& p0, f32x16& p1, const char* K_lds, const char* CK_lds, int r32, int hi, const char* Qw, float cq) {
#pragma unroll
    for (int g = 0; g < 4; ++g) { const f32x4 c0 = *(const f32x4*)(CK_lds + KB * 256 + (8 * g + 4 * hi) * 4), c1 = *(const f32x4*)(CK_lds + KB * 256 + (32 + 8 * g + 4 * hi) * 4);
#pragma unroll
        for (int i = 0; i < 4; ++i) { p0[4 * g + i] = cq - c0[i]; p1[4 * g + i] = cq - c1[i]; } }
    const char* kb[4];
#pragma unroll
    for (int dd = 0; dd < 4; ++dd) kb[dd] = K_lds + KB * SHM_K + KSWZ(r32, (dd * 16 + hi * 8) * 2);
#pragma unroll
    for (int d0 = 0; d0 < 8; ++d0) { const char* a = kb[d0 & 3] + (d0 >> 2) * 128;
        bf16x8 b0 = *reinterpret_cast<const bf16x8*>(a);
        bf16x8 b1 = *reinterpret_cast<const bf16x8*>(a + 32 * 256);
        bf16x8 qv = *reinterpret_cast<const bf16x8*>(Qw + KSWZ(r32, ((d0 & 3) * 16 + hi * 8) * 2) + (d0 >> 2) * 128);
        p0 = __builtin_amdgcn_mfma_f32_32x32x16_bf16(b0, qv, p0, 0, 0, 0);
        p1 = __builtin_amdgcn_mfma_f32_32x32x16_bf16(b1, qv, p1, 0, 0, 0); }
}
template <int VB>
__device__ __forceinline__ void pv_tile(f32x16* o, int vb0, bf16x8 pa0, bf16x8 pa1, bf16x8 pa2, bf16x8 pa3) {
#define TRRD(dst, off) asm volatile("ds_read_b64_tr_b16 %0, %1 offset:%2" : "=&v"(dst) : "v"(vb0), "i"(off) : "memory")
#define PV_D0(d0) do { s16x4 l0, l1, l2, l3, h0, h1, h2, h3; constexpr int b_ = VB * SHM_V + v_rd_off(d0, 0, 0); \
        TRRD(l0, b_); TRRD(h0, b_ + 2048); TRRD(l1, b_ + 4096); TRRD(h1, b_ + 6144); TRRD(l2, b_ + 8192); TRRD(h2, b_ + 10240); TRRD(l3, b_ + 12288); TRRD(h3, b_ + 14336); \
        asm volatile("s_waitcnt lgkmcnt(0)" ::: "memory"); SBAR();   \
        o[d0] = __builtin_amdgcn_mfma_f32_32x32x16_bf16(pa0, (bf16x8){l0[0], l0[1], l0[2], l0[3], h0[0], h0[1], h0[2], h0[3]}, o[d0], 0, 0, 0);   \
        o[d0] = __builtin_amdgcn_mfma_f32_32x32x16_bf16(pa1, (bf16x8){l1[0], l1[1], l1[2], l1[3], h1[0], h1[1], h1[2], h1[3]}, o[d0], 0, 0, 0);   \
        o[d0] = __builtin_amdgcn_mfma_f32_32x32x16_bf16(pa2, (bf16x8){l2[0], l2[1], l2[2], l2[3], h2[0], h2[1], h2[2], h2[3]}, o[d0], 0, 0, 0);   \
        o[d0] = __builtin_amdgcn_mfma_f32_32x32x16_bf16(pa3, (bf16x8){l3[0], l3[1], l3[2], l3[3], h3[0], h3[1], h3[2], h3[3]}, o[d0], 0, 0, 0); } while (0)
    PV_D0(0); PV_D0(1); PV_D0(2); PV_D0(3);
#undef PV_D0
#undef TRRD
}
struct Bases { const bf16* Q; const bf16* K; const bf16* V; const float* C; bf16* O; };
struct BlockRef { int hd, P0, jlo; };
constexpr int SEQ = 8192;
struct Seam { bf16x8 st_v0, st_v1, st_k0, st_k1; float cq; };
#define ROW(p, k0, rr) ((p) + (size_t)((k0) + (rr)) * D + sc)
#define VMW() asm volatile("s_waitcnt vmcnt(0)" ::: "memory")
#define VMWN(n) asm volatile("s_waitcnt vmcnt(%0)" :: "i"(n) : "memory")
#define SLOAD_H(Kp, Vp, Cp, k0) do { S.st_v0 = ld8(ROW(Vp, k0, sr)); S.st_v1 = ld8(ROW(Vp, k0, 32 + sr));              \
                         S.st_k0 = ld8(ROW(Kp, k0, sr)); S.st_k1 = ld8(ROW(Kp, k0, 32 + sr)); } while (0)
#define CLOAD(Cp, k0, bf) do { if (wid == 0) { int ln_ = lane; asm volatile("" : "+v"(ln_));   __builtin_amdgcn_global_load_lds((const unsigned*)((Cp) + (k0) + ln_), (LAS unsigned*)(CK_lds + (bf) * 256), 4, 0, 0); } } while (0)
#define SWRITE_HK(bf) do { *(bf16x8*)(K_lds + (bf) * SHM_K + kws) = S.st_k0; *(bf16x8*)(K_lds + (bf) * SHM_K + kws + 32 * 256) = S.st_k1; } while (0)
#define SWRITE_HV(bf) do { *(bf16x8*)(V_lds + (bf) * SHM_V + vst0) = S.st_v0; *(bf16x8*)(V_lds + (bf) * SHM_V + vst1) = S.st_v1; } while (0)
#define SWRITE_H(bf) do { SWRITE_HV(bf); SWRITE_HK(bf); } while (0)
__device__ __forceinline__ void fox_prime(const Bases& B, const BlockRef& cur, char* lds, Seam& S) {
    const int tid = threadIdx.x, wid = __builtin_amdgcn_readfirstlane(tid >> 6), lane = tid & 63, r32 = lane & 31, hi = lane >> 5;
    const int sr = tid >> 4, sc = (tid & 15) * 8, kws = KSWZ(sr, sc * 2); char* K_lds = lds + 2 * SHM_V; char* CK_lds = lds + OFF_CK;
    const int kb0 = cur.jlo * KVBLK;
    const bf16* curQ = B.Q + (size_t)cur.hd * SEQ * D; const bf16* curK = B.K + (size_t)cur.hd * SEQ * D; const bf16* curV = B.V + (size_t)cur.hd * SEQ * D; const float* curC = B.C + (size_t)cur.hd * SEQ;
    { char* Qw = lds + OFF_Q + wid * (QBLK * 256); bf16x8 qt[8];
#pragma unroll
      for (int d0 = 0; d0 < 8; ++d0) qt[d0] = ld8(curQ + (size_t)(cur.P0 + wid * QBLK + r32) * D + d0 * 16 + hi * 8);
#pragma unroll
      for (int d0 = 0; d0 < 8; ++d0) *(bf16x8*)(Qw + KSWZ(r32, ((d0 & 3) * 16 + hi * 8) * 2) + (d0 >> 2) * 128) = qt[d0]; }
    S.cq = curC[cur.P0 + wid * QBLK + r32];
    SLOAD_H(curK, curV, curC, kb0); CLOAD(curC, kb0, 0); VMW(); SWRITE_HK(0);
    __syncthreads();
}
__device__ __forceinline__ void fox_block(const Bases& B, const BlockRef& cur, const BlockRef& nxt, char* lds, Seam& S) {
    const int tid = threadIdx.x, wid = __builtin_amdgcn_readfirstlane(tid >> 6), lane = tid & 63, r32 = lane & 31, hi = lane >> 5;
    const int j_lo = cur.jlo, j_hi = (cur.P0 + QB - 1) / KVBLK + 1;
    const int NT = j_hi - j_lo;
    const int kbn = nxt.jlo * KVBLK;
    const int qlo = cur.P0 + wid * QBLK, qm = qlo + r32 - 4 * hi;
    char* V_lds = lds; char* K_lds = lds + 2 * SHM_V; char* CK_lds = lds + OFF_CK; char* Qw = lds + OFF_Q + wid * (QBLK * 256);
    float* ws = (float*)(lds + OFF_WS) + wid * 64; float* li_l = ws, * al_l = ws + 32;
    float m_reg = -1e30f, l_reg = 0; f32x16 o[4] = {};
    const float cq = S.cq;
    const int sr = tid >> 4, sc = (tid & 15) * 8, vst0 = v_st(sr, sc), vst1 = v_st(32 + sr, sc), kws = KSWZ(sr, sc * 2);
    const int vb0 = (int)(uintptr_t)V_lds + v_rd_base(lane);
    const bf16* Kh = B.K + (size_t)cur.hd * SEQ * D; const bf16* Vh = B.V + (size_t)cur.hd * SEQ * D; const float* Ch = B.C + (size_t)cur.hd * SEQ;
#define RESC(a) do { if (__any((a) < 1.f)) { if (hi == 0) al_l[r32] = (a); asm volatile("s_waitcnt lgkmcnt(0)" ::: "memory");              \
                     for (int d_ = 0; d_ < 4; ++d_) for (int r = 0; r < 16; ++r) o[d_][r] *= al_l[crow(r, hi)]; } } while (0)
#define KBASE(t) ((j_lo + (t)) * KVBLK)
#define MASKT(P0_, P1_, t) do { const int kb_ = KBASE(t); if (kb_ + KVBLK - 1 > qlo) mask_tile(P0_, P1_, qm - kb_); } while (0)
    constexpr int NQL = 9;
#define SEAM_K0() do { VMWN(NQL); SWRITE_HK(0); SBAR(); } while (0)
    f32x16 pA0, pA1, pB0, pB1; float mnA, mnB, alA, alB; bf16x8 pa0, pa1, pa2, pa3;
    SWRITE_HV(0); SBAR();
    if (NT > 1) { SLOAD_H(Kh, Vh, Ch, KBASE(1)); CLOAD(Ch, KBASE(1), 1); }
    SBAR(); qkt<0>(pA0, pA1, K_lds, CK_lds, r32, hi, Qw, cq);
    MASKT(pA0, pA1, 0); partialSM(pA0, pA1, m_reg, mnA, alA);
    if (NT > 1) { VMW(); SWRITE_H(1); }
    __syncthreads();
#define HALF_STEP(PX0, PX1, mnX, alX, PY0, PY1, alY, t, KB, VB, SB) do {                                                      \
        SBAR(); qkt<KB>(PX0, PX1, K_lds, CK_lds, r32, hi, Qw, cq);                                             \
        finishSM(PY0, PY1, alY, l_reg, pa0, pa1, pa2, pa3); SBAR();                                                           \
        if ((t) + 1 < NT) { SLOAD_H(Kh, Vh, Ch, KBASE((t) + 1)); CLOAD(Ch, KBASE((t) + 1), SB); SBAR(); }                                               \
        pv_tile<VB>(o, vb0, pa0, pa1, pa2, pa3); MASKT(PX0, PX1, (t)); partialSM(PX0, PX1, m_reg, mnX, alX);                                        \
        __syncthreads();                                                                                                      \
        if ((t) + 1 < NT) { VMW(); SWRITE_H(SB); }                                                                          \
        RESC(alX); __syncthreads(); } while (0)
    for (int t = 1; t + 1 < NT; t += 2) {
        HALF_STEP(pB0, pB1, mnB, alB, pA0, pA1, alA, t, 1, 0, 0);
        HALF_STEP(pA0, pA1, mnA, alA, pB0, pB1, alB, t + 1, 0, 1, 1);
    }
    const bool even = (NT & 1) == 0;
    if (even) { SBAR(); qkt<1>(pB0, pB1, K_lds, CK_lds, r32, hi, Qw, cq); SBAR(); }
    { const bf16* nK = B.K + (size_t)nxt.hd * SEQ * D; const bf16* nV = B.V + (size_t)nxt.hd * SEQ * D; const float* nC = B.C + (size_t)nxt.hd * SEQ;
      SLOAD_H(nK, nV, nC, kbn); CLOAD(nC, kbn, 0); } SBAR();
    finishSM(pA0, pA1, alA, l_reg, pa0, pa1, pa2, pa3); SBAR();
    pv_tile<0>(o, vb0, pa0, pa1, pa2, pa3);
    if (even) { MASKT(pB0, pB1, NT - 1); partialSM(pB0, pB1, m_reg, mnB, alB); __syncthreads(); RESC(alB);
        finishSM(pB0, pB1, alB, l_reg, pa0, pa1, pa2, pa3); SBAR(); pv_tile<1>(o, vb0, pa0, pa1, pa2, pa3); }
    SBAR();
    bf16x8 qt[8];
#pragma unroll
    for (int d0 = 0; d0 < 8; ++d0) qt[d0] = ld8(B.Q + (size_t)nxt.hd * SEQ * D + (size_t)(nxt.P0 + wid * QBLK + r32) * D + d0 * 16 + hi * 8);
    S.cq = (B.C + (size_t)nxt.hd * SEQ)[nxt.P0 + wid * QBLK + r32];
    SBAR(); SEAM_K0();
    if (hi == 0) li_l[r32] = l_reg; asm volatile("s_waitcnt lgkmcnt(0)" ::: "memory");
    float rli[16];
#pragma unroll
    for (int r = 0; r < 16; ++r) rli[r] = __builtin_amdgcn_rcpf(li_l[crow(r, hi)]);
    bf16* Ow = B.O + cur.hd * D + (size_t)(cur.P0 + wid * QBLK) * LDO;
#pragma unroll
    for (int r = 0; r < 16; ++r) { const int orow = crow(r, hi);
#pragma unroll
        for (int d0 = 0; d0 < 4; ++d0) { const float v = o[d0][r] * rli[r];
            const float vn = __shfl_xor(v, 1);
            if ((r32 & 1) == 0) *(unsigned*)(Ow + (size_t)orow * LDO + d0 * 32 + r32) = cvtpk(v, vn); } }
    SBAR();
#pragma unroll
    for (int d0 = 0; d0 < 8; ++d0) *(bf16x8*)(Qw + KSWZ(r32, ((d0 & 3) * 16 + hi * 8) * 2) + (d0 >> 2) * 128) = qt[d0];
    __syncthreads();
#undef RESC
#undef KBASE
#undef MASKT
#undef SEAM_K0
#undef HALF_STEP
}
#undef ROW
#undef VMW
#undef VMWN
#undef SLOAD_H
#undef CLOAD
#undef SWRITE_HK
#undef SWRITE_HV
#undef SWRITE_H
#undef KSWZ
#undef SBAR
}
#endif

#if !SIMPLE_ATTN
__device__ __forceinline__ int fox_jlo(const float* CS, const gu32* NRM, int hd, int P0, int lane) {
    const float qm2 = __builtin_bit_cast(float, __hip_atomic_load(NRM + 2 * hd, RLX_AGENT)), km2 = __builtin_bit_cast(float, __hip_atomic_load(NRM + 2 * hd + 1, RLX_AGENT));
    const float braw = 30.0f * 11.313708498984761f + 2.0f * sqrtf(qm2 * km2) * 1.0001f + 1.0f;
    const float* c = CS + (size_t)hd * S; const float c0 = c[P0]; const int jd = P0 >> 6;
    const int j0 = lane, j1 = lane + 64;
    const bool p0 = j0 <= jd && (c0 - c[64 * (j0 <= jd ? j0 : jd) + 63] > -braw), p1 = j1 <= jd && (c0 - c[64 * (j1 <= jd ? j1 : jd) + 63] > -braw);
    const unsigned long long b0 = __ballot(p0), b1 = __ballot(p1);
    int jl = b0 ? __builtin_ctzll(b0) : (b1 ? 64 + __builtin_ctzll(b1) : jd);
    return __builtin_amdgcn_readfirstlane(jl < jd ? jl : jd);
}
__device__ __forceinline__ fa::BlockRef fox_ref(int item, int pass, int jl0, int jl1) {
    const int y = item & 15, qb = pass ? 31 - y : y; fa::BlockRef r; r.hd = (item >> 4) & 15; r.P0 = qb * fa::QB; r.jlo = pass ? jl1 : jl0;
    return r;
}
__device__ __forceinline__ void fox_phase(Frame& F, char* lds, const bf16* Q, const bf16* K, const bf16* V, const float* CS, const gu32* NRM, bf16* MIX) {
    constexpr int NITEMS = FH * 16 * (PROBE_REPEAT == 61 ? 2 : 1);
    const int nw = SIMPLE_GLA ? F.G : F.G - NSCAN; int item = SIMPLE_GLA ? F.vcu : F.vcu - NSCAN; if (item >= NITEMS) return;
    int pass = 0;
    const fa::Bases B{Q, K, V, CS, MIX};
    int jl0 = fox_jlo(CS, NRM, (item >> 4) & 15, (item & 15) * fa::QB, F.lane), jl1 = fox_jlo(CS, NRM, (item >> 4) & 15, (31 - (item & 15)) * fa::QB, F.lane);
    fa::BlockRef cur = fox_ref(item, 0, jl0, jl1);
    fa::Seam Sm;
    fa::fox_prime(B, cur, lds, Sm);
    for (;;) {
        const bool more_pass = pass == 0, more_item = item + nw < NITEMS, last = !more_pass && !more_item;
        int itn = item, passn = pass + 1;
        if (!more_pass) { passn = 0; itn = more_item ? item + nw : item;
            if (more_item) { jl0 = fox_jlo(CS, NRM, (itn >> 4) & 15, (itn & 15) * fa::QB, F.lane); jl1 = fox_jlo(CS, NRM, (itn >> 4) & 15, (31 - (itn & 15)) * fa::QB, F.lane); } }
        const fa::BlockRef nxt = last ? cur : fox_ref(itn, passn, jl0, jl1);
        fa::fox_block(B, cur, nxt, lds, Sm);
        if (last) break;
        cur = nxt; item = itn; pass = passn;
    }
}
#endif

#if !SIMPLE_GLA
constexpr int GP_GLR = 0, GP_TOT = 4096, GP_QD = 6144, GP_KI = GP_QD + 64 * 528, GP_KET = GP_KI + 64 * 528, GP_AS = GP_KET + 256 * 144, GP_END = GP_AS + 64 * 144;
static_assert(GP_END <= 131072, "gla prep LDS");
__device__ __forceinline__ void gla_prep(Frame& F, const bf16* GQ, const bf16* GK, const bf16* GV, const float* FFGLR, const float* Wg, const float* bg,
                                         bf16* QDF, bf16* KEF, bf16* AMF, bf16* VTF, float* DL) {
    LAS float* glr = (LAS float*)(F.lds + GP_GLR); LAS float* tot = (LAS float*)(F.lds + GP_TOT);
    LAS unsigned char* QD = F.lds + GP_QD; LAS unsigned char* KI = F.lds + GP_KI; LAS unsigned char* KET = F.lds + GP_KET; LAS unsigned char* AS = F.lds + GP_AS;
    const int tid = F.tid, lane = F.lane, r = lane & 31, hh = lane >> 5;
    for (int job = F.vcu; job < NCH * GH; job += F.G) {
        const int n = job >> 2, h = job & 3, t0 = n * GC;
        __syncthreads();
        for (int e = tid; e < 1024; e += NWAVES * 64) glr[e] = FFGLR[(size_t)(t0 + (e >> 4)) * 32 + 16 + (e & 15)];
        {
            const int c = tid, slice = c >> 5, cr = c & 31; const bf16* vp = GV + (size_t)t0 * GVW + h * GDV + c;
            bf16* vo = VTF + ((size_t)((n * 4 + h) * 16 + slice) * 4) * 512 + cr * 8;
#pragma unroll
            for (int ks = 0; ks < 4; ++ks)
#pragma unroll
                for (int half = 0; half < 2; ++half) { unsigned short e[8];
#pragma unroll
                    for (int j = 0; j < 8; ++j) e[j] = vp[(size_t)(16 * ks + 8 * half + j) * GVW];
                    v4u o; o.x = e[0] | ((unsigned)e[1] << 16); o.y = e[2] | ((unsigned)e[3] << 16); o.z = e[4] | ((unsigned)e[5] << 16); o.w = e[6] | ((unsigned)e[7] << 16);
                    *(GAS v4u*)(vo + ks * 512 + half * 256) = o; }
        }
        __syncthreads();
        const int d = tid & 255, th = tid >> 8, col = h * GDK + d;
        float bcum[32];
        {   float wg[16];
#pragma unroll
            for (int q = 0; q < 16; ++q) wg[q] = Wg[q * GKW + col];
            const float bgv = bg[col]; float run = 0.f;
#pragma unroll
            for (int i = 0; i < 32; ++i) { const int t = th * 32 + i; float z = bgv;
#pragma unroll
                for (int q = 0; q < 16; ++q) z += glr[t * 16 + q] * wg[q];
                run += log_sigmoid_f(z) * 0.0625f; bcum[i] = run; }
            tot[th * 256 + d] = run; }
        __syncthreads();
        const float tot0 = tot[d], blast = tot0 + tot[256 + d], boff = th ? tot0 : 0.f;
        if (th == 1) DL[(size_t)(n * 4 + h) * 256 + d] = __expf(blast);
        {   const bf16* qp = GQ + (size_t)(t0 + th * 32) * GKW + col; const bf16* kp = GK + (size_t)(t0 + th * 32) * GKW + col;
            unsigned kew[4];
#pragma unroll
            for (int i = 0; i < 32; ++i) { const int t = th * 32 + i; const float bb = bcum[i] + boff, qv = bf2f(qp[(size_t)i * GKW]), kv = bf2f(kp[(size_t)i * GKW]);
                const float eb = __expf(bb), qd = qv * 0.0625f * eb, ki = kv * __expf(-bb), ke = kv * __expf(blast - bb);
                *(LAS unsigned short*)(QD + t * 528 + d * 2) = (unsigned short)f2bf(qd);
                *(LAS unsigned short*)(KI + t * 528 + d * 2) = (unsigned short)f2bf(ki);
                const unsigned kb = f2bf(ke);
                if (i & 1) kew[(i >> 1) & 3] |= kb << 16; else kew[(i >> 1) & 3] = kb;
                if ((i & 7) == 7) { v4u o; o.x = kew[0]; o.y = kew[1]; o.z = kew[2]; o.w = kew[3]; *(LAS v4u*)(KET + d * 144 + (t - 7) * 2) = o; } }
        }
        __syncthreads();
        {
            const int r16 = lane & 15, g = lane >> 4;
#pragma unroll
            for (int tt = 0; tt < 2; ++tt) { const int T = 2 * F.wave + tt, mti = T >> 2, nti = T & 3;
                f32x4 acc = {0.f, 0.f, 0.f, 0.f};
#pragma unroll
                for (int ks = 0; ks < 8; ++ks) { const bf16x8 a = *(const LAS bf16x8*)(QD + (mti * 16 + r16) * 528 + (ks * 32 + 8 * g) * 2), b = *(const LAS bf16x8*)(KI + (nti * 16 + r16) * 528 + (ks * 32 + 8 * g) * 2);
                    acc = __builtin_amdgcn_mfma_f32_16x16x32_bf16(a, b, acc, 0, 0, 0); }
#pragma unroll
                for (int i = 0; i < 4; ++i) { const int tq = mti * 16 + 4 * g + i, tk = nti * 16 + r16;
                    *(LAS unsigned short*)(AS + tq * 144 + tk * 2) = (unsigned short)f2bf(tk <= tq ? acc[i] : 0.f); } }
        }
        __syncthreads();
        {   const size_t jb = (size_t)(n * 4 + h);
            { const int f = tid >> 6, mt = f >> 2, ks = f & 3;
              *(GAS v4u*)(AMF + (jb * 8 + f) * 512 + lane * 8) = *(const LAS v4u*)(AS + (32 * mt + r) * 144 + (16 * ks + 8 * hh) * 2); }
#pragma unroll
            for (int i = 0; i < 4; ++i) { const int f = (tid >> 6) + 8 * i;
                { const int w = f >> 2, mt = (f >> 1) & 1, s = f & 1; const LAS unsigned char* src = QD + (32 * mt + r) * 528 + (32 * w + 16 * s + 4 * hh) * 2;
                  const v2u lo = *(const LAS v2u*)src, hi = *(const LAS v2u*)(src + 16); v4u o; o.x = lo.x; o.y = lo.y; o.z = hi.x; o.w = hi.y;
                  *(GAS v4u*)(QDF + (jb * 32 + f) * 512 + lane * 8) = o; }
                { const int w = f >> 2, ks = f & 3;
                  *(GAS v4u*)(KEF + (jb * 32 + f) * 512 + lane * 8) = *(const LAS v4u*)(KET + (32 * w + r) * 144 + (16 * ks + 8 * hh) * 2); } }
        }
    }
    __syncthreads();
}

struct GlaSet { bf16x8 qd[4], ke[4], vt[4], am, vx; f32x4 dl[4]; };
constexpr int GS_PW = 32 * 68, GS_PB = 8 * GS_PW;
__device__ __forceinline__ bf16x8 pack_bf8(const f32x16& x, int s) {
    v4u p; p.x = pk2(x[8 * s], x[8 * s + 1]); p.y = pk2(x[8 * s + 2], x[8 * s + 3]); p.z = pk2(x[8 * s + 4], x[8 * s + 5]); p.w = pk2(x[8 * s + 6], x[8 * s + 7]);
    return __builtin_bit_cast(bf16x8, p);
}
__device__ __forceinline__ void gla_scan(Frame& F, const bf16* QDF, const bf16* KEF, const bf16* AMF, const bf16* VTF, const float* DL, float* OGLA) {
    LAS float* P = (LAS float*)(F.lds + RING_OFF);
    const int tid = F.tid, lane = F.lane, w = F.wave, r = lane & 31, hh = lane >> 5;
    for (int job = F.vcu; job < GH * 16; job += F.G) {
        const int h = job >> 4, sl = job & 15;
        const GAS char* qb = (const GAS char*)QDF + ((size_t)h * 32 + w * 4) * 1024;
        const GAS char* kb = (const GAS char*)KEF + ((size_t)h * 32 + w * 4) * 1024;
        const GAS char* ab = (const GAS char*)AMF + ((size_t)h * 8 + (w & 1) * 4 + (w >> 1)) * 1024;
        const GAS char* vb = (const GAS char*)VTF + (((size_t)h * 16 + sl) * 4) * 1024;
        const GAS char* db = (const GAS char*)DL + (h * 256 + 32 * w) * 4;
        GAS char* ob = (GAS char*)OGLA + ((size_t)h * GDV + sl * 32) * 4;
        unsigned lo16 = lane * 16, lod = hh * 16, loo = ((tid >> 5) * 4 * GVW + (tid & 31)) * 4;
        asm volatile("" : "+v"(lo16), "+v"(lod), "+v"(loo));
        f32x16 St = {};
        GlaSet A, B;
#define GLA_LOAD(X, n_) do { const size_t n__ = (size_t)(n_); \
            const GAS char* q__ = qb + n__ * 131072; const GAS char* k__ = kb + n__ * 131072; const GAS char* v__ = vb + n__ * 262144; const GAS char* d__ = db + n__ * 4096; \
            _Pragma("unroll") for (int i_ = 0; i_ < 4; ++i_) { X.qd[i_] = *(const GAS bf16x8*)(q__ + i_ * 1024 + lo16); X.ke[i_] = *(const GAS bf16x8*)(k__ + i_ * 1024 + lo16); \
                X.vt[i_] = *(const GAS bf16x8*)(v__ + i_ * 1024 + lo16); X.dl[i_] = *(const GAS f32x4*)(d__ + 32 * i_ + lod); } \
            X.am = *(const GAS bf16x8*)(ab + n__ * 32768 + lo16); X.vx = *(const GAS bf16x8*)(v__ + (w >> 1) * 1024 + lo16); } while (0)
#define GLA_COMPUTE(X) do { \
            const bf16x8 xs0 = pack_bf8(St, 0), xs1 = pack_bf8(St, 1); O0 = (f32x16){}; O1 = (f32x16){}; \
            O0 = __builtin_amdgcn_mfma_f32_32x32x16_bf16(X.qd[0], xs0, O0, 0, 0, 0); O1 = __builtin_amdgcn_mfma_f32_32x32x16_bf16(X.qd[2], xs0, O1, 0, 0, 0); \
            O0 = __builtin_amdgcn_mfma_f32_32x32x16_bf16(X.qd[1], xs1, O0, 0, 0, 0); O1 = __builtin_amdgcn_mfma_f32_32x32x16_bf16(X.qd[3], xs1, O1, 0, 0, 0); \
            if (w & 1) O1 = __builtin_amdgcn_mfma_f32_32x32x16_bf16(X.am, X.vx, O1, 0, 0, 0); else O0 = __builtin_amdgcn_mfma_f32_32x32x16_bf16(X.am, X.vx, O0, 0, 0, 0); \
            _Pragma("unroll") for (int g_ = 0; g_ < 4; ++g_) _Pragma("unroll") for (int i_ = 0; i_ < 4; ++i_) St[4 * g_ + i_] *= X.dl[g_][i_]; \
            _Pragma("unroll") for (int ks_ = 0; ks_ < 4; ++ks_) St = __builtin_amdgcn_mfma_f32_32x32x16_bf16(X.ke[ks_], X.vt[ks_], St, 0, 0, 0); } while (0)
#define GLA_WRITE(buf_) do { LAS float* Pw = P + (buf_) * GS_PB + w * GS_PW + r * 68 + 4 * hh; \
              _Pragma("unroll") for (int g_ = 0; g_ < 4; ++g_) { *(LAS f32x4*)(Pw + 8 * g_) = (f32x4){O0[4 * g_], O0[4 * g_ + 1], O0[4 * g_ + 2], O0[4 * g_ + 3]}; \
                  *(LAS f32x4*)(Pw + 32 + 8 * g_) = (f32x4){O1[4 * g_], O1[4 * g_ + 1], O1[4 * g_ + 2], O1[4 * g_ + 3]}; } } while (0)
#define GLA_REDUCE(n_) do { const LAS float* Pr = P + ((n_) & 1) * GS_PB + (tid & 31) * 68 + (tid >> 5) * 4; f32x4 s_ = *(const LAS f32x4*)Pr; \
              _Pragma("unroll") for (int w_ = 1; w_ < 8; ++w_) s_ += *(const LAS f32x4*)(Pr + w_ * GS_PW); \
              GAS char* o_ = ob + (size_t)(n_) * (GC * GVW * 4); *(GAS float*)(o_ + loo) = s_[0]; *(GAS float*)(o_ + GVW * 4 + loo) = s_[1]; *(GAS float*)(o_ + 2 * GVW * 4 + loo) = s_[2]; *(GAS float*)(o_ + 3 * GVW * 4 + loo) = s_[3]; } while (0)
        f32x16 O0, O1;
        __syncthreads();
        GLA_LOAD(A, 0); GLA_LOAD(B, 1);
        GLA_COMPUTE(A); GLA_WRITE(0);
        for (int n = 0; n < NCH; n += 2) {
            if (n + 2 < NCH) GLA_LOAD(A, n + 2);
            GLA_COMPUTE(B);
            __syncthreads(); GLA_REDUCE(n); GLA_WRITE(1);
            if (n + 3 < NCH) GLA_LOAD(B, n + 3);
            if (n + 2 < NCH) GLA_COMPUTE(A);
            __syncthreads(); GLA_REDUCE(n + 1); if (n + 2 < NCH) GLA_WRITE(0);
        }
#undef GLA_COMPUTE
#undef GLA_WRITE
#undef GLA_REDUCE
#undef GLA_LOAD
    }
    __syncthreads();
}
#endif

struct Args { const float* in[23]; float* out; unsigned char* ws; int ph_lo, ph_hi, li, pad; };
__global__ void __launch_bounds__(NWAVES * 64, 2) fwd(Args args) {
    extern __shared__ __attribute__((aligned(16))) unsigned char lds[];
    Frame F;
    F.lds = (LAS unsigned char*)lds;
    F.MISC = (volatile LAS unsigned*)(F.lds + MISC_OFF);
    F.tid = threadIdx.x; F.lane = F.tid & 63; F.wave = __builtin_amdgcn_readfirstlane(F.tid >> 6);
    F.G = gridDim.x; { const int bx = blockIdx.x; F.vcu = (F.G % 8 == 0) ? (bx % 8) * (F.G / 8) + bx / 8 : bx; }
    unsigned char* ws = args.ws;
    F.ctl = (gu32*)(ws + WS_CTL);
    for (int u = F.tid; u < (LDS_BYTES - LDSCTL_OFF) / 4; u += NWAVES * 64) ((LAS unsigned*)(F.lds + LDSCTL_OFF))[u] = 0u;
    __syncthreads();
    XcdBarrier bar; bar.bar = (unsigned*)(F.ctl + CW_BAR); bar.x = 0; bar.st = nullptr;
    if (ONE_LAUNCH) bar = xcd_barrier_post((unsigned*)(F.ctl + CW_BAR), F.MISC + 8);
#define GRID_BAR() do { if (ONE_LAUNCH) xcd_barrier(bar); } while (0)
    const int lo = args.ph_lo, hi = args.ph_hi;
#define IN(k) (lo <= (k) && (k) < hi)
#define PHASE_BEGIN() do { int t_ = threadIdx.x; asm volatile("" : "+v"(t_)); F.tid = t_; F.lane = t_ & 63; F.wave = __builtin_amdgcn_readfirstlane(t_ >> 6); } while (0)
#define BOTH(k) (IN(k) && IN((k) + 1))
#define REP(k) for (int rep_ = 0; rep_ < ((PROBE_REPEAT) == (k) ? 2 : 1); ++rep_)
#define gw (F.vcu * NWAVES + F.wave)
#define NGW (F.G * NWAVES)
    const float* x = args.in[0];
    bf16* W1GU = (bf16*)(ws + WS_W1GU); bf16* W1D = (bf16*)(ws + WS_W1D); bf16* W2GU = (bf16*)(ws + WS_W2GU); bf16* W2D = (bf16*)(ws + WS_W2D);
    bf16* WIN = (bf16*)(ws + WS_WIN); bf16* WSK = (bf16*)(ws + WS_WSK); bf16* WO = (bf16*)(ws + WS_WO); bf16* WPG = (bf16*)(ws + WS_WPG); bf16* WPP = (bf16*)(ws + WS_WPP);
    float* H = (float*)(ws + WS_H); bf16* Fb = (bf16*)(ws + WS_F); bf16* XN = (bf16*)(ws + WS_XN); bf16* MIX = (bf16*)(ws + WS_MIX); bf16* ACT = (bf16*)(ws + WS_ACT);
    bf16* Qb = (bf16*)(ws + WS_Q); bf16* Kb = (bf16*)(ws + WS_K); bf16* Vb = (bf16*)(ws + WS_V);
    bf16* GQ = (bf16*)(ws + WS_GQ); bf16* GK = (bf16*)(ws + WS_GK); bf16* GV = (bf16*)(ws + WS_GV); bf16* GR = (bf16*)(ws + WS_GR);
    float* CF = (float*)(ws + WS_MISC); float* FFGLR = (float*)(ws + WS_MISC + 1 * MiB); float* RSTDE = (float*)(ws + WS_WSK + 512 * 1024);
    float* OGLA = (float*)(ws + WS_OGLA); bf16* ERAW = (bf16*)(ws + WS_ERAW); bf16* PBF = (bf16*)(ws + WS_PBF);

    if (IN(0)) { PHASE_BEGIN(); REP(0) {
        convert_items(F, args.in, ws, 0, CV_B - CV_TAIL, gw, NGW);
        for (int m = gw; m < S; m += NGW) norm_row_to_bf16(x + (size_t)m * DM, args.in[2], XN + (size_t)m * DM, F.lane);
        { const float* p = args.in[1]; const int gt = F.vcu * NWAVES * 64 + F.tid, NT = F.G * NWAVES * 64;
          for (int i = gt; i < S * PLE / 4; i += NT) { const f32x4 v = ((const GAS f32x4*)p)[i]; v2u w; w.x = pk2(v.x, v.y); w.y = pk2(v.z, v.w); ((GAS v2u*)PBF)[i] = w; } }
        }
        if (BOTH(0)) GRID_BAR();
    }
    if (IN(1)) { PHASE_BEGIN(); REP(1) {
        pg8::Gemm g{XN, W1GU, S, 2 * DFF, DM}; pg8::StaticOrder So; So.init(S, 2 * DFF, F.G, (int)blockIdx.x);
        pg8::EpiSwiGLU E{ACT, DFF};
        pg8::gemm_phase<pg8::EpiSwiGLU, pg8::StaticOrder, PG_ALIGN, PG_SP2>(F.lds + RING_OFF, g, So, E);
        { constexpr int NFULL = ((S / 256) * (2 * DFF / 256)) % 256;
          if (F.G == 256 && (int)blockIdx.x >= NFULL) convert_items(F, args.in, ws, CV_B - CV_TAIL, CV_B, ((int)blockIdx.x - NFULL) * NWAVES + F.wave, (256 - NFULL) * NWAVES);
          else if (F.G != 256) convert_items(F, args.in, ws, CV_B - CV_TAIL, CV_B, gw, NGW); }
        }
        if (BOTH(1)) GRID_BAR();
    }
    if (IN(2)) { PHASE_BEGIN(); REP(2) {
        pg8::Gemm g{ACT, W1D, S, DM, DFF}; pg8::StaticOrder So; So.init(S, DM, F.G, (int)blockIdx.x);
        pg8::EpiBf16 E{Fb, DM};
        pg8::gemm_phase<pg8::EpiBf16, pg8::StaticOrder, PG_ALIGN, PG_SP2>(F.lds + RING_OFF, g, So, E);
        }
        if (BOTH(2)) GRID_BAR();
    }
    if (IN(3)) { PHASE_BEGIN(); REP(3) {
        for (int m = gw; m < S; m += NGW) resid_row<true>(Fb + (size_t)m * DM, x + (size_t)m * DM, 0.5f, args.in[6], args.in[7], H + (size_t)m * DM, XN + (size_t)m * DM, F.lane);
        }
        if (BOTH(3)) GRID_BAR();
    }
    if (IN(4)) { PHASE_BEGIN(); REP(4) {
        pg8::Gemm g{XN, WIN, S, NWIN, DM}; pg8::StaticOrder So; So.init(S, NWIN, F.G, (int)blockIdx.x);
        pg8::EpiWin E{Qb, S};
        pg8::gemm_phase<pg8::EpiWin, pg8::StaticOrder, PG_ALIGN, PG_SP2>(F.lds + RING_OFF, g, So, E);
        skinny_gemm(F, XN, WSK, FFGLR);
        }
        if (BOTH(4)) GRID_BAR();
    }
    if (IN(5)) { PHASE_BEGIN(); REP(5) {
        fox_prep(F, FFGLR, args.in[9], CF);
#if !SIMPLE_ATTN
        fox_norms(F, Qb, Kb, F.ctl + CW_NRM);
#endif
#if !SIMPLE_GLA
        gla_prep(F, GQ, GK, GV, FFGLR, args.in[10], args.in[11], (bf16*)(ws + WS_QDEC), (bf16*)(ws + WS_KTE), (bf16*)(ws + WS_AM), (bf16*)(ws + WS_VT), (float*)(ws + WS_MISC + 2560 * 1024));
#endif
        }
        if (BOTH(5)) GRID_BAR();
    }
    if (IN(6)) { PHASE_BEGIN(); REP(6) {
#if SIMPLE_GLA
        gla_simple(F, GQ, GK, GV, FFGLR, args.in[10], args.in[11], OGLA);
#else
        if (F.vcu < NSCAN) {
        gla_scan(F, (const bf16*)(ws + WS_QDEC), (const bf16*)(ws + WS_KTE), (const bf16*)(ws + WS_AM), (const bf16*)(ws + WS_VT), (const float*)(ws + WS_MISC + 2560 * 1024), OGLA);
#if PROBE_REPEAT == 60
        gla_scan(F, (const bf16*)(ws + WS_QDEC), (const bf16*)(ws + WS_KTE), (const bf16*)(ws + WS_AM), (const bf16*)(ws + WS_VT), (const float*)(ws + WS_MISC + 2560 * 1024), OGLA);
#endif
        }
#endif
#if SIMPLE_ATTN
        attn_simple(F, Qb, Kb, Vb, CF, MIX);
#else
        if (F.vcu >= NSCAN || SIMPLE_GLA) {
            fox_phase(F, (char*)lds + RING_OFF, Qb, Kb, Vb, CF, (const gu32*)(F.ctl + CW_NRM), MIX);
            __syncthreads();
            convert_items(F, args.in, ws, CV_B, CV_D2 - CV_TAIL, (F.vcu - NSCAN) * NWAVES + F.wave, (F.G - NSCAN) * NWAVES);
        }
#endif
        }
        if (BOTH(6)) GRID_BAR();
    }
    if (IN(7)) { PHASE_BEGIN(); REP(7) {
        gla_post(F, OGLA, GR, args.in[12], MIX);
        }
        if (BOTH(7)) GRID_BAR();
    }
    if (IN(8)) { PHASE_BEGIN(); REP(8) {
        pg8::Gemm g{MIX, WO, S, DM, DM}; pg8::StaticOrder So; So.init(S, DM, F.G, (int)blockIdx.x);
        pg8::EpiBf16 E{Fb, DM};
        pg8::gemm_phase<pg8::EpiBf16, pg8::StaticOrder, PG_ALIGN, PG_SP2>(F.lds + RING_OFF, g, So, E);
        }
        if (BOTH(8)) GRID_BAR();
    }
    if (IN(9)) { PHASE_BEGIN(); REP(9) {
        for (int m = gw; m < S; m += NGW) resid_row<true>(Fb + (size_t)m * DM, H + (size_t)m * DM, 1.0f, args.in[14], args.in[15], H + (size_t)m * DM, XN + (size_t)m * DM, F.lane);
        }
        if (BOTH(9)) GRID_BAR();
    }
    if (IN(10)) { PHASE_BEGIN(); REP(10) {
        pg8::Gemm g{XN, W2GU, S, 2 * DFF, DM}; pg8::StaticOrder So; So.init(S, 2 * DFF, F.G, (int)blockIdx.x);
        pg8::EpiSwiGLU E{ACT, DFF};
        pg8::gemm_phase<pg8::EpiSwiGLU, pg8::StaticOrder, PG_ALIGN, PG_SP2>(F.lds + RING_OFF, g, So, E);
        { constexpr int NFULL = ((S / 256) * (2 * DFF / 256)) % 256;
          if (F.G == 256 && (int)blockIdx.x >= NFULL) convert_items(F, args.in, ws, CV_D2 - CV_TAIL, CV_D2, ((int)blockIdx.x - NFULL) * NWAVES + F.wave, (256 - NFULL) * NWAVES);
          else if (F.G != 256) convert_items(F, args.in, ws, CV_D2 - CV_TAIL, CV_D2, gw, NGW); }
        }
        if (BOTH(10)) GRID_BAR();
    }
    if (IN(11)) { PHASE_BEGIN(); REP(11) {
        { pg8::Gemm g{ACT, W2D, S, DM, DFF}; pg8::StaticOrder So; So.init(S, DM, F.G, (int)blockIdx.x);
          pg8::EpiBf16 E{Fb, DM};
          pg8::gemm_phase<pg8::EpiBf16, pg8::StaticOrder, PG_ALIGN, PG_SP2>(F.lds + RING_OFF, g, So, E); }
        { pg8::Gemm g{PBF, WPP, S, DM, PLE}; pg8::StaticOrder So; So.init(S, DM, F.G, (int)blockIdx.x);
          pg8::EpiBf16 E{ERAW, DM};
          pg8::gemm_phase<pg8::EpiBf16, pg8::StaticOrder, PG_ALIGN, PG_SP2>(F.lds + RING_OFF, g, So, E); }
        }
        if (BOTH(11)) GRID_BAR();
    }
    if (IN(12)) { PHASE_BEGIN(); REP(12) {
        for (int m = gw; m < S; m += NGW) {
            resid_row<false>(Fb + (size_t)m * DM, H + (size_t)m * DM, 0.5f, args.in[19], args.in[19], H + (size_t)m * DM, XN + (size_t)m * DM, F.lane);
            const GAS v4u* er = (const GAS v4u*)(ERAW + (size_t)m * DM) + F.lane; float s = 0.f;
#pragma unroll
            for (int j = 0; j < 8; ++j) { const v4u v = er[64 * j]; s += (bflo(v.x) * bflo(v.x) + bfhi(v.x) * bfhi(v.x)) + (bflo(v.y) * bflo(v.y) + bfhi(v.y) * bfhi(v.y)) + (bflo(v.z) * bflo(v.z) + bfhi(v.z) * bfhi(v.z)) + (bflo(v.w) * bflo(v.w) + bfhi(v.w) * bfhi(v.w)); }
            s = wave_sum(s); if (F.lane == 0) RSTDE[m] = 1.f / sqrtf(s * (1.f / DM) + EPS);
        }
        }
        if (BOTH(12)) GRID_BAR();
    }
    if (IN(13)) { PHASE_BEGIN(); REP(13) {
        pg8::Gemm g{XN, WPG, S, DM, DM}; pg8::StaticOrder So; So.init(S, DM, F.G, (int)blockIdx.x);
        pg8::EpiPleGate E{H, ERAW, RSTDE, args.in[21], args.out, DM};
        pg8::gemm_phase<pg8::EpiPleGate, pg8::StaticOrder, PG_ALIGN, PG_SP2>(F.lds + RING_OFF, g, So, E);
        }
    }
#undef IN
#undef gw
#undef NGW
#undef PHASE_BEGIN
#undef BOTH
#undef GRID_BAR
}

extern "C" void kernel_launch(void* const* d_in, const int* in_sizes, int n_in, void* d_out, int out_size, void* d_ws, size_t ws_size, hipStream_t stream) {
    static int grid = 0;
    if (grid == 0) {
        if (n_in != 23 || in_sizes[0] != S * DM || out_size != S * DM || ws_size < WS_END) {
            fprintf(stderr, "kernel_launch: built for 23 inputs, x/out of %d floats, >= %zu bytes of workspace; got n_in %d, in0 %d, out %d, ws %zu; nothing launched\n", S * DM, (size_t)WS_END, n_in, n_in > 0 ? in_sizes[0] : -1, out_size, ws_size);
            grid = -1; return; }
        int dev = 0, cus = 0, per_cu = 0;
        if (hipGetDevice(&dev) != hipSuccess || hipDeviceGetAttribute(&cus, hipDeviceAttributeMultiprocessorCount, dev) != hipSuccess) { fprintf(stderr, "kernel_launch: device query failed\n"); grid = -1; return; }
        if (hipFuncSetAttribute((const void*)fwd, hipFuncAttributeMaxDynamicSharedMemorySize, LDS_BYTES) != hipSuccess) { fprintf(stderr, "kernel_launch: hipFuncSetAttribute failed\n"); grid = -1; return; }
        if (hipOccupancyMaxActiveBlocksPerMultiprocessor(&per_cu, (const void*)fwd, NWAVES * 64, LDS_BYTES) != hipSuccess || per_cu < 1)
            fprintf(stderr, "kernel_launch: note: occupancy query reports %d workgroups per CU\n", per_cu);
        (void)hipGetLastError();
        grid = cus;
    }
    if (grid < 0) return;
    if (hipMemsetAsync((char*)d_ws + WS_CTL, 0, CTL_ZERO_BYTES, stream) != hipSuccess) { fprintf(stderr, "kernel_launch: hipMemsetAsync failed\n"); return; }
    Args a{};
    for (int i = 0; i < 23; ++i) a.in[i] = (const float*)d_in[i];
    a.out = (float*)d_out; a.ws = (unsigned char*)d_ws;
    if (ONE_LAUNCH) {
        a.ph_lo = 0; a.ph_hi = N_PHASES; a.li = 0;
        hipLaunchKernelGGL(fwd, dim3(grid), dim3(NWAVES * 64), LDS_BYTES, stream, a);
    } else {
        for (int li = 0; li < N_PHASES; ++li) { a.ph_lo = li; a.ph_hi = li + 1; a.li = li;
            hipLaunchKernelGGL(fwd, dim3(grid), dim3(NWAVES * 64), LDS_BYTES, stream, a); }
    }
    const hipError_t le = hipPeekAtLastError();
    if (le != hipSuccess) fprintf(stderr, "kernel_launch: launch failed: %s\n", hipGetErrorName(le));
}
```

```cpp
#include <hip/hip_runtime.h>
#include <cstdio>
#include <cstdint>
namespace pg8 {
#define PG8_LAS __attribute__((address_space(3)))
typedef unsigned short bf16_t;
typedef short bf16x8 __attribute__((ext_vector_type(8)));
typedef float f32x4 __attribute__((ext_vector_type(4)));
typedef unsigned u32x4 __attribute__((ext_vector_type(4)));
constexpr int BM = 256, BK = 64, HALF = 128, HTB = HALF * BK * 2  , STAGE_BYTES = 8 * HTB, NXCD = 8, WGM = 8;

__host__ __device__ __forceinline__ int lds_byte(int r, int c) { const int st = (r >> 4) * 2 + (c >> 5), rr = r & 15, cc = c & 31, ob = rr * 64 + cc * 2; return st * 1024 + (ob ^ (((ob >> 9) & 1) << 5)); }
__host__ __device__ __forceinline__ void stage_rc(int b, int& R, int& C) { const int st = b / 1024, sb = b % 1024, swz = sb ^ (((sb >> 9) & 1) << 5); R = (st >> 1) * 16 + swz / 64; C = (st & 1) * 32 + (swz % 64) / 2; }
__host__ __device__ __forceinline__ int perm32(int rho) { const int n = rho >> 4, i = rho & 15; return 8 * (i >> 2) + 4 * n + (i & 3); }

struct Unit { int pm, pn; };
struct Gemm { const bf16_t* A; const bf16_t* Bt; int M, N, K; };

struct StaticOrder {
    int nM, nN, nwg, G, c;
    __host__ __device__ void init(int M, int N, int G_, int c_) { nM = M / BM; nN = N / BM; nwg = nM * nN; G = G_; c = c_; }
    __host__ __device__ bool next(int i, Unit& u) const {
        const long L = (long)i * G + c; if (L >= nwg) return false;
        int wgid = (int)L; { const int q = nwg / NXCD, r = nwg % NXCD, xcd = wgid % NXCD, off = wgid / NXCD; wgid = (xcd < r ? xcd * (q + 1) : r * (q + 1) + (xcd - r) * q) + off; }
        const int nig = WGM * nN, gid = wgid / nig, fm = gid * WGM, gsz = (nM - fm) < WGM ? (nM - fm) : WGM;
        u.pm = fm + ((wgid % nig) % gsz); u.pn = (wgid % nig) / gsz; return true;
    }
    __device__ __forceinline__ void a_ready(const Unit&) const {}
    __device__ __forceinline__ void done(const Unit&) const {}
};

__device__ __forceinline__ unsigned cvt_pk_bf16(float lo, float hi) { unsigned r; asm volatile("v_cvt_pk_bf16_f32 %0, %1, %2" : "=v"(r) : "v"(lo), "v"(hi)); return r; }
typedef float f32x2 __attribute__((ext_vector_type(2)));

struct EpiF32 {
    static constexpr bool PERM = false, AFTER_DRAIN = false;
    float* C; int ldc;
    __device__ __forceinline__ void operator()(const f32x4 (&acc)[2][2][4][2], const Unit& u, int wr, int wc, int fr, int fq) const {
        const int row0 = u.pm * BM + wr * 64 + fr, col0 = u.pn * BM + wc * 32 + 4 * fq;
#pragma unroll
        for (int ai = 0; ai < 2; ++ai)
#pragma unroll
            for (int m = 0; m < 4; ++m) { float* rowp = C + (size_t)(row0 + ai * HALF + m * 16) * ldc + col0;
#pragma unroll
                for (int bj = 0; bj < 2; ++bj)
#pragma unroll
                    for (int n = 0; n < 2; ++n) *(f32x4*)(rowp + bj * HALF + n * 16) = acc[ai][bj][m][n]; }
    }
};
struct EpiBf16 {
    static constexpr bool PERM = true, AFTER_DRAIN = false;
    bf16_t* O; int ldc;
    __device__ __forceinline__ void operator()(const f32x4 (&acc)[2][2][4][2], const Unit& u, int wr, int wc, int fr, int fq) const {
        const int row0 = u.pm * BM + wr * 64 + fr, col0 = u.pn * BM + wc * 32 + 8 * fq;
#pragma unroll
        for (int ai = 0; ai < 2; ++ai)
#pragma unroll
            for (int m = 0; m < 4; ++m) { bf16_t* rowp = O + (size_t)(row0 + ai * HALF + m * 16) * ldc + col0;
#pragma unroll
                for (int bj = 0; bj < 2; ++bj) { const f32x4 v0 = acc[ai][bj][m][0], v1 = acc[ai][bj][m][1];
                    u32x4 w; w.x = cvt_pk_bf16(v0[0], v0[1]); w.y = cvt_pk_bf16(v0[2], v0[3]); w.z = cvt_pk_bf16(v1[0], v1[1]); w.w = cvt_pk_bf16(v1[2], v1[3]);
                    *(u32x4*)(rowp + bj * HALF) = w; } }
    }
};
__device__ __forceinline__ float silu_f(float g) { return g * __builtin_amdgcn_rcpf(1.0f + __builtin_amdgcn_exp2f(-1.4426950408889634f * g)); }
__device__ __forceinline__ float sigmoid_f(float g) { return __builtin_amdgcn_rcpf(1.0f + __builtin_amdgcn_exp2f(-1.4426950408889634f * g)); }
struct EpiSwiGLU {
    static constexpr bool PERM = true, AFTER_DRAIN = false;
    bf16_t* O; int ldc;
    __device__ __forceinline__ void operator()(const f32x4 (&acc)[2][2][4][2], const Unit& u, int wr, int wc, int fr, int fq) const {
        const int row0 = u.pm * BM + wr * 64 + fr, col0 = u.pn * HALF + wc * 32 + 8 * fq;
#pragma unroll
        for (int ai = 0; ai < 2; ++ai)
#pragma unroll
            for (int m = 0; m < 4; ++m) { bf16_t* rowp = O + (size_t)(row0 + ai * HALF + m * 16) * ldc + col0;
                const f32x4 g0 = acc[ai][0][m][0], g1 = acc[ai][0][m][1], u0 = acc[ai][1][m][0], u1 = acc[ai][1][m][1];
                u32x4 w; w.x = cvt_pk_bf16(silu_f(g0[0]) * u0[0], silu_f(g0[1]) * u0[1]); w.y = cvt_pk_bf16(silu_f(g0[2]) * u0[2], silu_f(g0[3]) * u0[3]);
                w.z = cvt_pk_bf16(silu_f(g1[0]) * u1[0], silu_f(g1[1]) * u1[1]); w.w = cvt_pk_bf16(silu_f(g1[2]) * u1[2], silu_f(g1[3]) * u1[3]);
                *(u32x4*)rowp = w; }
    }
};
struct EpiWin {
    static constexpr bool PERM = true, AFTER_DRAIN = false;
    bf16_t* R; int S;
    __device__ __forceinline__ void operator()(const f32x4 (&acc)[2][2][4][2], const Unit& u, int wr, int wc, int fr, int fq) const {
        const int row0 = u.pm * BM + wr * 64 + fr, pn = u.pn, cin = wc * 32 + 8 * fq;
        int ldc; size_t off0, off1;
        if (pn < 24) { ldc = 128; off0 = (size_t)(pn >> 3) * (16u << 20) + (size_t)(2 * (pn & 7)) * S * 128 + cin; off1 = off0 + (size_t)S * 128; }
        else { size_t tb; int c0;
            if (pn < 28) { tb = (size_t)48 << 20; ldc = 1024; c0 = (pn - 24) * 256; } else if (pn < 32) { tb = (size_t)56 << 20; ldc = 1024; c0 = (pn - 28) * 256; }
            else if (pn < 40) { tb = (size_t)64 << 20; ldc = 2048; c0 = (pn - 32) * 256; } else { tb = (size_t)80 << 20; ldc = 2048; c0 = (pn - 40) * 256; }
            off0 = tb + (size_t)(c0 + cin); off1 = off0 + HALF; }
#pragma unroll
        for (int ai = 0; ai < 2; ++ai)
#pragma unroll
            for (int m = 0; m < 4; ++m) { const size_t ro = (size_t)(row0 + ai * HALF + m * 16) * ldc;
#pragma unroll
                for (int bj = 0; bj < 2; ++bj) { const f32x4 v0 = acc[ai][bj][m][0], v1 = acc[ai][bj][m][1];
                    u32x4 w; w.x = cvt_pk_bf16(v0[0], v0[1]); w.y = cvt_pk_bf16(v0[2], v0[3]); w.z = cvt_pk_bf16(v1[0], v1[1]); w.w = cvt_pk_bf16(v1[2], v1[3]);
                    *(u32x4*)(R + ro + (bj ? off1 : off0)) = w; } }
    }
};
struct EpiPleGate {
    static constexpr bool PERM = false, AFTER_DRAIN = false;
    const float* H; const bf16_t* ERAW; const float* rstd_e; const float* g; float* out; int ldc;
    __device__ __forceinline__ void operator()(const f32x4 (&acc)[2][2][4][2], const Unit& u, int wr, int wc, int fr, int fq) const {
        const int row0 = u.pm * BM + wr * 64 + fr, col0 = u.pn * BM + wc * 32 + 4 * fq;
        f32x4 gv[2][2];
#pragma unroll
        for (int bj = 0; bj < 2; ++bj)
#pragma unroll
            for (int n = 0; n < 2; ++n) gv[bj][n] = *(const f32x4*)(g + col0 + bj * HALF + n * 16);
#pragma unroll
        for (int ai = 0; ai < 2; ++ai)
#pragma unroll
            for (int m = 0; m < 4; ++m) { const int row = row0 + ai * HALF + m * 16; const size_t ro = (size_t)row * ldc + col0; const float rs = rstd_e[row];
#pragma unroll
                for (int bj = 0; bj < 2; ++bj)
#pragma unroll
                    for (int n = 0; n < 2; ++n) { const size_t o = ro + bj * HALF + n * 16; const f32x4 a = acc[ai][bj][m][n];
                        const f32x4 hv = *(const f32x4*)(H + o); const unsigned long long ew = *(const unsigned long long*)(ERAW + o);
                        const f32x4 ev = {__builtin_bit_cast(float, (unsigned)ew << 16), __builtin_bit_cast(float, (unsigned)ew & 0xffff0000u), __builtin_bit_cast(float, (unsigned)(ew >> 32) << 16), __builtin_bit_cast(float, (unsigned)(ew >> 32) & 0xffff0000u)}; f32x4 r;
#pragma unroll
                        for (int j = 0; j < 4; ++j) r[j] = hv[j] + ev[j] * rs * gv[bj][n][j] * sigmoid_f(a[j]);
                        *(f32x4*)(out + o) = r; }
                asm volatile("" ::: "memory"); }
    }
};
template <class Epi, class Sched, bool ALIGN_EPI = false, bool SP2 = false>
__device__ __forceinline__ void gemm_phase(PG8_LAS unsigned char* lds, const Gemm g, const Sched& S, const Epi& E) {
    int tid_ = threadIdx.x; asm volatile("" : "+v"(tid_));
    const int tid = tid_, wid = __builtin_amdgcn_readfirstlane(tid >> 6), lane = tid & 63, wr = wid >> 2, wc = wid & 3, fr = lane & 15, fq = lane >> 4;
    const int K = g.K, nt = K / BK;
    unsigned voffA[2], voffB[2];
#pragma unroll
    for (int i = 0; i < 2; ++i) { int R, C; stage_rc(tid * 16 + i * 8192, R, C); const int Rb = Epi::PERM ? ((R & ~31) + perm32(R & 31)) : R;
        voffA[i] = (unsigned)(R * K + C) * 2u; voffB[i] = (unsigned)(Rb * K + C) * 2u; }
    const size_t kstep = (size_t)(BK * 2);
    const size_t hstep = (size_t)HALF * K * 2;
    const size_t tstep = 2 * hstep;
    const unsigned ldsw = (unsigned)wid * 1024u;
    const int aoff = lds_byte(wr * 64 + fr, fq * 8), boff = lds_byte(wc * 32 + fr, fq * 8);
#define PG8_SA(b, h) (((b) * 2 + (h)) * HTB)
#define PG8_SB(b, h) ((4 + (b) * 2 + (h)) * HTB)
#define PG8_STAGE(bufoff, gbase, voff) do { _Pragma("unroll") for (int _i = 0; _i < 2; ++_i) \
        __builtin_amdgcn_global_load_lds((const unsigned*)((const char*)(gbase) + (voff)[_i]), (PG8_LAS unsigned*)(lds + (bufoff) + ldsw + _i * 8192), 16, 0, 0); } while (0)
#define PG8_LDA(dst, b, h) do { _Pragma("unroll") for (int m = 0; m < 4; ++m) _Pragma("unroll") for (int k = 0; k < 2; ++k) dst[m][k] = *(const PG8_LAS bf16x8*)(lds + PG8_SA(b, h) + aoff + m * 2048 + k * 1024); } while (0)
#define PG8_LDB(dst, b, h) do { _Pragma("unroll") for (int n = 0; n < 2; ++n) _Pragma("unroll") for (int k = 0; k < 2; ++k) dst[n][k] = *(const PG8_LAS bf16x8*)(lds + PG8_SB(b, h) + boff + n * 2048 + k * 1024); } while (0)
#define PG8_MMA(ai, bj, At, Bt) do { __builtin_amdgcn_s_setprio(1); _Pragma("unroll") for (int m = 0; m < 4; ++m) _Pragma("unroll") for (int n = 0; n < 2; ++n) _Pragma("unroll") for (int k = 0; k < 2; ++k) \
        acc[ai][bj][m][n] = __builtin_amdgcn_mfma_f32_16x16x32_bf16(Bt[n][k], At[m][k], acc[ai][bj][m][n], 0, 0, 0); __builtin_amdgcn_s_setprio(0); } while (0)
#define PG8_WAIT_V(n) asm volatile("s_waitcnt vmcnt(" #n ")" ::: "memory")
#define PG8_WAIT_L(n) asm volatile("s_waitcnt lgkmcnt(" #n ")" ::: "memory")
#define PG8_BAR __builtin_amdgcn_s_barrier()
#define PG8_SCHED __builtin_amdgcn_sched_barrier(0)
    Unit cur, nxt; int ui = 0;
    if (!S.next(0, cur)) return;
    f32x4 acc[2][2][4][2];
#pragma unroll
    for (int a = 0; a < 2; ++a)
#pragma unroll
        for (int b = 0; b < 2; ++b)
#pragma unroll
            for (int m = 0; m < 4; ++m)
#pragma unroll
                for (int n = 0; n < 2; ++n) acc[a][b][m][n] = (f32x4){0.f, 0.f, 0.f, 0.f};
    bf16x8 At[4][2], B0[2][2], B1[2][2];
    const char* cA = (const char*)g.A + (size_t)cur.pm * tstep; const char* cB = (const char*)g.Bt + (size_t)cur.pn * tstep;
    S.a_ready(cur);
    if constexpr (SP2) {
        PG8_STAGE(PG8_SB(0, 0), cB, voffB); PG8_STAGE(PG8_SB(0, 1), cB + hstep, voffB); PG8_STAGE(PG8_SA(0, 0), cA, voffA); PG8_STAGE(PG8_SA(0, 1), cA + hstep, voffA);
        if (wr == 1) PG8_BAR;
        PG8_WAIT_V(2); PG8_BAR;
        PG8_STAGE(PG8_SB(1, 0), cB + kstep, voffB); PG8_STAGE(PG8_SA(1, 0), cA + kstep, voffA); PG8_STAGE(PG8_SB(1, 1), cB + hstep + kstep, voffB);
        PG8_WAIT_V(6); PG8_BAR;
    } else {
        PG8_STAGE(PG8_SB(0, 0), cB, voffB); PG8_STAGE(PG8_SA(0, 0), cA, voffA); PG8_STAGE(PG8_SB(0, 1), cB + hstep, voffB); PG8_STAGE(PG8_SA(0, 1), cA + hstep, voffA);
        if (wr == 1) PG8_BAR;
        PG8_WAIT_V(4); PG8_BAR;
        PG8_STAGE(PG8_SB(1, 0), cB + kstep, voffB); PG8_STAGE(PG8_SA(1, 0), cA + kstep, voffA); PG8_STAGE(PG8_SB(1, 1), cB + hstep + kstep, voffB);
        PG8_WAIT_V(6); PG8_BAR;
    }
    for (;;) {
        const bool has_next = S.next(ui + 1, nxt);
        const char* nA = has_next ? (const char*)g.A + (size_t)nxt.pm * tstep : cA; const char* nB = has_next ? (const char*)g.Bt + (size_t)nxt.pn * tstep : cB;
        for (int t = 0; t < nt; t += 2) {
            const bool last = (t == nt - 2);
            const char* a1 = cA + (size_t)(t + 1) * kstep;
            const char* a2 = last ? nA : cA + (size_t)(t + 2) * kstep; const char* b2 = last ? nB : cB + (size_t)(t + 2) * kstep;
            const char* a3 = a2 + kstep; const char* b3 = b2 + kstep;
            if (last && has_next) S.a_ready(nxt);
            if constexpr (SP2) {
            PG8_LDB(B0, 0, 0); PG8_LDB(B1, 0, 1); PG8_SCHED; PG8_LDA(At, 0, 0); PG8_STAGE(PG8_SA(1, 1), a1 + hstep, voffA);
            PG8_WAIT_V(8); PG8_WAIT_L(0); PG8_BAR; PG8_MMA(0, 0, At, B0); PG8_MMA(0, 1, At, B1); PG8_BAR; PG8_SCHED;
            PG8_LDA(At, 0, 1); PG8_STAGE(PG8_SB(0, 0), b2, voffB); PG8_STAGE(PG8_SB(0, 1), b2 + hstep, voffB); PG8_STAGE(PG8_SA(0, 0), a2, voffA);
            PG8_WAIT_V(8); PG8_WAIT_L(0); PG8_BAR; PG8_MMA(1, 0, At, B0); PG8_MMA(1, 1, At, B1); PG8_BAR; PG8_SCHED;
            PG8_LDB(B0, 1, 0); PG8_LDB(B1, 1, 1); PG8_SCHED; PG8_LDA(At, 1, 0); PG8_STAGE(PG8_SA(0, 1), a2 + hstep, voffA);
            PG8_WAIT_V(8); PG8_WAIT_L(0); PG8_BAR; PG8_MMA(0, 0, At, B0); PG8_MMA(0, 1, At, B1); PG8_BAR; PG8_SCHED;
            PG8_LDA(At, 1, 1); PG8_STAGE(PG8_SB(1, 0), b3, voffB); PG8_STAGE(PG8_SB(1, 1), b3 + hstep, voffB); PG8_STAGE(PG8_SA(1, 0), a3, voffA);
            PG8_WAIT_V(8); PG8_WAIT_L(0); PG8_BAR; PG8_MMA(1, 0, At, B0); PG8_MMA(1, 1, At, B1); PG8_BAR; PG8_SCHED;
            } else {
            PG8_LDB(B0, 0, 0); PG8_SCHED; PG8_LDA(At, 0, 0); PG8_STAGE(PG8_SA(1, 1), a1 + hstep, voffA);
            PG8_WAIT_L(8); PG8_BAR; PG8_WAIT_L(0); PG8_MMA(0, 0, At, B0); PG8_BAR; PG8_SCHED;
            PG8_LDB(B1, 0, 1); PG8_STAGE(PG8_SB(0, 0), b2, voffB);
            PG8_BAR; PG8_WAIT_L(0); PG8_MMA(0, 1, At, B1); PG8_BAR;
            PG8_LDA(At, 0, 1); PG8_STAGE(PG8_SA(0, 0), a2, voffA);
            PG8_BAR; PG8_WAIT_L(0); PG8_MMA(1, 0, At, B0); PG8_BAR; PG8_SCHED;
            PG8_STAGE(PG8_SB(0, 1), b2 + hstep, voffB);
            PG8_WAIT_V(6); PG8_BAR; PG8_MMA(1, 1, At, B1); PG8_BAR;
            PG8_LDB(B0, 1, 0); PG8_SCHED; PG8_LDA(At, 1, 0); PG8_STAGE(PG8_SA(0, 1), a2 + hstep, voffA);
            PG8_WAIT_L(8); PG8_BAR; PG8_WAIT_L(0); PG8_MMA(0, 0, At, B0); PG8_BAR; PG8_SCHED;
            PG8_LDB(B1, 1, 1); PG8_STAGE(PG8_SB(1, 0), b3, voffB);
            PG8_BAR; PG8_WAIT_L(0); PG8_MMA(0, 1, At, B1); PG8_BAR;
            PG8_LDA(At, 1, 1); PG8_STAGE(PG8_SA(1, 0), a3, voffA);
            PG8_BAR; PG8_WAIT_L(0); PG8_MMA(1, 0, At, B0); PG8_BAR; PG8_SCHED;
            PG8_STAGE(PG8_SB(1, 1), b3 + hstep, voffB);
            PG8_WAIT_V(6); PG8_BAR; PG8_MMA(1, 1, At, B1); PG8_BAR;
            }
        }
        if constexpr (ALIGN_EPI) { if (wr == 0) PG8_BAR; }
        if constexpr (!Epi::AFTER_DRAIN) { E(acc, cur, wr, wc, fr, fq); S.done(cur); }
        if (!has_next) break;
#pragma unroll
        for (int a = 0; a < 2; ++a)
#pragma unroll
            for (int b = 0; b < 2; ++b)
#pragma unroll
                for (int m = 0; m < 4; ++m)
#pragma unroll
                    for (int n = 0; n < 2; ++n) acc[a][b][m][n] = (f32x4){0.f, 0.f, 0.f, 0.f};
        cur = nxt; cA = nA; cB = nB; ++ui;
        if constexpr (ALIGN_EPI) { if (wr == 1) PG8_BAR; }
    }
    PG8_WAIT_V(0);
    if constexpr (!ALIGN_EPI) { if (wr == 0) PG8_BAR; }
    PG8_BAR;
    if constexpr (Epi::AFTER_DRAIN) { E.fused(acc, cur, wr, wc, fr, fq, lds, wid, lane); S.done(cur); }
#undef PG8_SA
#undef PG8_SB
#undef PG8_STAGE
#undef PG8_LDA
#undef PG8_LDB
#undef PG8_MMA
#undef PG8_WAIT_V
#undef PG8_WAIT_L
#undef PG8_BAR
#undef PG8_SCHED
}
}

constexpr int NWAVES = 8;
#ifndef MK_N_LAUNCHES
#define MK_N_LAUNCHES 1
#endif
#ifndef SIMPLE_ATTN
#define SIMPLE_ATTN 0
#endif
#ifndef SIMPLE_GLA
#define SIMPLE_GLA 0
#endif
#ifndef PG_SP2
#define PG_SP2 true
#endif
#ifndef PG_ALIGN
#define PG_ALIGN true
#endif
#ifndef PROBE_REPEAT
#define PROBE_REPEAT -1
#endif
constexpr int N_PHASES = 14;
constexpr bool ONE_LAUNCH = (MK_N_LAUNCHES == 1);

constexpr int S = 8192, DM = 4096, DFF = 11008, PLE = 256;
constexpr int FH = 16, FD = 128, FW = 2048;
constexpr int GH = 4, GDK = 256, GDV = 512, GKW = 1024, GVW = 2048, GRANK = 16, GC = 64, NCH = S / GC;
constexpr int WIN_COLS = 12320, NWIN = 12288;
constexpr float EPS = 1e-6f;
constexpr float FOX_SCALE = 0.08838834764831845f;

constexpr size_t MiB = 1u << 20;
constexpr size_t WS_CTL = 0, CTL_ZERO_BYTES = 1 * MiB;
constexpr size_t WS_WSK = 1 * MiB;
constexpr size_t WS_WPP = 2 * MiB;
constexpr size_t WS_W1GU = 4 * MiB;
constexpr size_t WS_W1D = 176 * MiB;
constexpr size_t WS_W2GU = 262 * MiB;
constexpr size_t WS_W2D = 434 * MiB;
constexpr size_t WS_WIN = 520 * MiB;
constexpr size_t WS_WO = 616 * MiB;
constexpr size_t WS_WPG = 648 * MiB;
constexpr size_t WS_H = 680 * MiB;
constexpr size_t WS_F = 808 * MiB;
constexpr size_t WS_XN = 936 * MiB;
constexpr size_t WS_MIX = 1000 * MiB;
constexpr size_t WS_ACT = 1064 * MiB;
constexpr size_t WS_Q = 1064 * MiB, WS_K = 1096 * MiB, WS_V = 1128 * MiB;
constexpr size_t WS_GQ = 1160 * MiB, WS_GK = 1176 * MiB;
constexpr size_t WS_GV = 1192 * MiB, WS_GR = 1224 * MiB;
constexpr size_t WS_QDEC = 1256 * MiB, WS_KTE = 1272 * MiB, WS_VT = 1288 * MiB, WS_AM = 1320 * MiB;
constexpr size_t WS_MISC = 1324 * MiB;
constexpr size_t WS_OGLA = 1328 * MiB;
constexpr size_t WS_ERAW = 1256 * MiB;
constexpr size_t WS_PBF = 1392 * MiB;
constexpr size_t WS_END = 1396 * MiB;
static_assert(WS_ERAW + (size_t)S * DM * 4 <= WS_PBF && WS_ACT + (size_t)S * DFF * 2 <= WS_ERAW && WS_OGLA + (size_t)S * GVW * 4 <= WS_PBF, "d_ws map");
constexpr int CW_TMO = 0, CW_CODE = 1;
constexpr int CW_BAR = 4096;
constexpr int CW_NRM = 2048;

constexpr int RING_OFF = 0, RING_BYTES = 131072;
constexpr int LDS_BYTES = 147456;
constexpr int LDSCTL_OFF = LDS_BYTES - 1024, MISC_OFF = LDSCTL_OFF + 320;

#define GAS __attribute__((address_space(1)))
#define LAS __attribute__((address_space(3)))
typedef unsigned short bf16;
typedef unsigned v4u __attribute__((ext_vector_type(4)));
typedef unsigned v2u __attribute__((ext_vector_type(2)));
typedef float f32x4 __attribute__((ext_vector_type(4)));
typedef float f32x16 __attribute__((ext_vector_type(16)));
typedef short bf16x8 __attribute__((ext_vector_type(8)));
typedef GAS unsigned gu32;
typedef GAS unsigned long long gu64;
#define RLX_AGENT __ATOMIC_RELAXED, __HIP_MEMORY_SCOPE_AGENT
#define LDS_WAIT() asm volatile("s_waitcnt lgkmcnt(0)" ::: "memory")
#define VM_WAIT() asm volatile("s_waitcnt vmcnt(0)" ::: "memory")
__device__ __forceinline__ unsigned f2bf(float f) { unsigned u = __builtin_bit_cast(unsigned, f); return (u + 0x7fffu + ((u >> 16) & 1u)) >> 16; }
__device__ __forceinline__ unsigned pk2(float lo, float hi) { return f2bf(lo) | (f2bf(hi) << 16); }
__device__ __forceinline__ float bf2f(unsigned short b) { return __builtin_bit_cast(float, (unsigned)b << 16); }
__device__ __forceinline__ float bflo(unsigned w) { return __builtin_bit_cast(float, w << 16); }
__device__ __forceinline__ float bfhi(unsigned w) { return __builtin_bit_cast(float, w & 0xffff0000u); }
__device__ __forceinline__ float log_sigmoid_f(float z) { return fminf(z, 0.f) - log1pf(expf(-fabsf(z))); }
#define XB_TMO      128
#define XB_XCNT(j)  (256  + 64 * (j))
#define XB_XSUB(j)  (1280 + 64 * (j))
#define XB_XGEN(j)  (2304 + 64 * (j))
#define XB_TOP      3328
#define XB_TOPGEN   3392
#define XCD_BAR_WORDS 3456
#define XB_SPIN_CAP (1u << 21)

__device__ __forceinline__ unsigned xb_ld(unsigned* p)              { return __hip_atomic_load(p, __ATOMIC_RELAXED, __HIP_MEMORY_SCOPE_AGENT); }
__device__ __forceinline__ unsigned xb_add(unsigned* p, unsigned v) { return __hip_atomic_fetch_add(p, v, __ATOMIC_RELAXED, __HIP_MEMORY_SCOPE_AGENT); }
__device__ __forceinline__ unsigned xb_xcc_id() { return (unsigned)__builtin_amdgcn_s_getreg((3 << 11) | 20) & 0xFu; }
#define XB_SPIN(cond, bar) do { unsigned _sp = 0; while (cond) { __builtin_amdgcn_s_sleep(1); \
    if ((++_sp & 255u) == 0u) { if (xb_ld(&(bar)[XB_TMO])) break; if (_sp > XB_SPIN_CAP) { atomicAdd(&(bar)[XB_TMO], 1u); break; } } } } while (0)

struct XcdBarrier {
    unsigned* bar; unsigned x;
    volatile LAS unsigned* st;
};

__device__ __forceinline__ XcdBarrier xcd_barrier_post(unsigned* bar, volatile LAS unsigned* st) {
    XcdBarrier b; b.bar = bar; b.x = xb_xcc_id(); b.st = st;
    if (threadIdx.x == 0) (void)xb_add(&bar[XB_XCNT(b.x)], 1u);
    return b;
}
__device__ __forceinline__ void xcd_barrier_complete(unsigned* bar, unsigned x, unsigned& nloc, unsigned& nx) {
    const unsigned G = gridDim.x * gridDim.y * gridDim.z;
    unsigned sum, cnt, mine, sp = 0u;
    for (;;) {
        sum = 0u; cnt = 0u; mine = 0u;
#pragma unroll
        for (unsigned j = 0; j < 16; ++j) { const unsigned c = xb_ld(&bar[XB_XCNT(j)]); sum += c; cnt += (c > 0u) ? 1u : 0u; mine = (j == x) ? c : mine; }
        if (sum == G) break;
        __builtin_amdgcn_s_sleep(1);
        if ((++sp & 255u) == 0u) { if (xb_ld(&bar[XB_TMO])) break; if (sp > XB_SPIN_CAP) { atomicAdd(&bar[XB_TMO], 1u); break; } }
    }
    nloc = mine > 0u ? mine : 1u; nx = cnt > 0u ? cnt : 1u;
}

__device__ __forceinline__ void xcd_barrier(const XcdBarrier& b) {
    asm volatile("s_waitcnt vmcnt(0)" ::: "memory");
    __syncthreads();
    if (threadIdx.x == 0) {
        unsigned* bar = b.bar;
        __builtin_amdgcn_s_waitcnt(0);
        unsigned nloc = b.st[0], nx = b.st[1];
        if (nloc == 0u) { xcd_barrier_complete(bar, b.x, nloc, nx); b.st[0] = nloc; b.st[1] = nx; }
        const unsigned old = xb_add(&bar[XB_XSUB(b.x)], 1u);
        const unsigned gen = old / nloc;
        if (old + 1u == (gen + 1u) * nloc) {
            __builtin_amdgcn_fence(__ATOMIC_RELEASE, "agent");
            asm volatile("s_waitcnt vmcnt(0)" ::: "memory");
            const unsigned og = xb_add(&bar[XB_TOP], 1u);
            const unsigned tg = og / nx;
            if (og + 1u == (tg + 1u) * nx) xb_add(&bar[XB_TOPGEN], 1u);
            else XB_SPIN(xb_ld(&bar[XB_TOPGEN]) == tg, bar);
            __builtin_amdgcn_fence(__ATOMIC_ACQUIRE, "agent");
            xb_add(&bar[XB_XGEN(b.x)], 1u);
            asm volatile("s_waitcnt vmcnt(0)" ::: "memory");
        } else {
            XB_SPIN(xb_ld(&bar[XB_XGEN(b.x)]) == gen, bar);
            __builtin_amdgcn_fence(__ATOMIC_ACQUIRE, "agent");
            asm volatile("s_waitcnt vmcnt(0)" ::: "memory");
        }
    }
    __syncthreads();
}


struct Frame {
    LAS unsigned char* lds;
    volatile LAS unsigned* MISC;
    gu32* ctl;
    int tid, lane, wave;
    int vcu, G;
};
__device__ __forceinline__ float wave_sum(float v) {
#pragma unroll
    for (int o = 1; o < 64; o <<= 1) v += __shfl_xor(v, o);
    return v;
}
template <class RowMap>
__device__ __forceinline__ void p0_transpose_item(const float* W, int N, int K, LAS float* scr, int kb, int nb, int lane, const RowMap& rm) {
    const int k0 = 64 * kb, n0 = 32 * nb;
    float v[32];
#pragma unroll
    for (int i = 0; i < 32; ++i) v[i] = W[(size_t)(k0 + 2 * i + (lane >> 5)) * N + n0 + (lane & 31)];
#pragma unroll
    for (int i = 0; i < 32; ++i) scr[(2 * i + (lane >> 5)) * 33 + (lane & 31)] = v[i];
    LDS_WAIT(); asm volatile("" ::: "memory");
    const int c = lane & 7;
#pragma unroll
    for (int j = 0; j < 4; ++j) { const int n = (lane >> 3) + 8 * j; const LAS float* s = scr + (8 * c) * 33 + n;
        v4u o; o.x = pk2(s[0 * 33], s[1 * 33]); o.y = pk2(s[2 * 33], s[3 * 33]); o.z = pk2(s[4 * 33], s[5 * 33]); o.w = pk2(s[6 * 33], s[7 * 33]);
        *(GAS v4u*)(rm(n0 + n) + k0 + 8 * c) = o; }
    LDS_WAIT(); asm volatile("" ::: "memory");
}
struct RmPlain { bf16* WT; int K; __device__ __forceinline__ bf16* operator()(int n) const { return WT + (size_t)n * K; } };
struct RmGateUp { bf16* WT; int up; __device__ __forceinline__ bf16* operator()(int n) const { return WT + (size_t)(256 * (n >> 7) + 128 * up + (n & 127)) * DM; } };
struct RmWin { bf16* WT; bf16* SK;
    __device__ __forceinline__ bf16* operator()(int n) const {
        if (n < 6144) return WT + (size_t)n * DM;
        if (n < 6160) return SK + (size_t)(n - 6144) * DM;
        if (n < 12304) return WT + (size_t)(n - 16) * DM;
        return SK + (size_t)(16 + n - 12304) * DM; } };

constexpr int NSCAN = GH * 16;
constexpr int CV_GU = (DM / 64) * (DFF / 32), CV_D = (DFF / 64) * (DM / 32), CV_IN = (DM / 64) * (WIN_COLS / 32), CV_SQ = (DM / 64) * (DM / 32), CV_PP = (PLE / 64) * (DM / 32);
constexpr int CV_TAIL = CV_D / 2;
constexpr int CV_A = 2 * CV_GU + CV_IN, CV_B = CV_A + CV_D, CV_C = CV_B + 2 * CV_GU + 2 * CV_SQ + CV_PP, CV_D2 = CV_C + CV_D;
__device__ __forceinline__ void convert_items(Frame& F, const float* const* in, unsigned char* ws, int first, int last, int wv, int nwv) {
    LAS float* scr = (LAS float*)(F.lds + RING_OFF + F.wave * 16384);
    bf16* W1GU = (bf16*)(ws + WS_W1GU); bf16* W1D = (bf16*)(ws + WS_W1D); bf16* W2GU = (bf16*)(ws + WS_W2GU); bf16* W2D = (bf16*)(ws + WS_W2D);
    bf16* WIN = (bf16*)(ws + WS_WIN); bf16* WSK = (bf16*)(ws + WS_WSK); bf16* WO = (bf16*)(ws + WS_WO); bf16* WPG = (bf16*)(ws + WS_WPG); bf16* WPP = (bf16*)(ws + WS_WPP);
    for (int it = first + wv; it < last; it += nwv) {
        int r = it;
        if (r < CV_GU) { p0_transpose_item(in[3], DFF, DM, scr, r / (DFF / 32), r % (DFF / 32), F.lane, RmGateUp{W1GU, 0}); continue; } r -= CV_GU;
        if (r < CV_GU) { p0_transpose_item(in[4], DFF, DM, scr, r / (DFF / 32), r % (DFF / 32), F.lane, RmGateUp{W1GU, 1}); continue; } r -= CV_GU;
        if (r < CV_IN) { p0_transpose_item(in[8], WIN_COLS, DM, scr, r / (WIN_COLS / 32), r % (WIN_COLS / 32), F.lane, RmWin{WIN, WSK}); continue; } r -= CV_IN;
        if (r < CV_D) { p0_transpose_item(in[5], DM, DFF, scr, r / (DM / 32), r % (DM / 32), F.lane, RmPlain{W1D, DFF}); continue; } r -= CV_D;
        if (r < CV_GU) { p0_transpose_item(in[16], DFF, DM, scr, r / (DFF / 32), r % (DFF / 32), F.lane, RmGateUp{W2GU, 0}); continue; } r -= CV_GU;
        if (r < CV_GU) { p0_transpose_item(in[17], DFF, DM, scr, r / (DFF / 32), r % (DFF / 32), F.lane, RmGateUp{W2GU, 1}); continue; } r -= CV_GU;
        if (r < CV_SQ) { p0_transpose_item(in[13], DM, DM, scr, r / (DM / 32), r % (DM / 32), F.lane, RmPlain{WO, DM}); continue; } r -= CV_SQ;
        if (r < CV_SQ) { p0_transpose_item(in[22], DM, DM, scr, r / (DM / 32), r % (DM / 32), F.lane, RmPlain{WPG, DM}); continue; } r -= CV_SQ;
        if (r < CV_PP) { p0_transpose_item(in[20], DM, PLE, scr, r / (DM / 32), r % (DM / 32), F.lane, RmPlain{WPP, PLE}); continue; } r -= CV_PP;
        p0_transpose_item(in[18], DM, DFF, scr, r / (DM / 32), r % (DM / 32), F.lane, RmPlain{W2D, DFF});
    }
}

__device__ __forceinline__ void norm_row_to_bf16(const float* xrow, const float* g, bf16* orow, int lane) {
    const GAS f32x4* xr = (const GAS f32x4*)xrow + lane; const GAS f32x4* gr = (const GAS f32x4*)g + lane;
    f32x4 v[16]; float s = 0.f;
#pragma unroll
    for (int j = 0; j < 16; ++j) { v[j] = xr[64 * j]; s += (v[j].x * v[j].x + v[j].y * v[j].y) + (v[j].z * v[j].z + v[j].w * v[j].w); }
    const float rstd = 1.f / sqrtf(wave_sum(s) * (1.f / DM) + EPS);
    GAS v2u* o8 = (GAS v2u*)orow + lane;
#pragma unroll
    for (int j = 0; j < 16; ++j) { const f32x4 gg = gr[64 * j]; v2u w; w.x = pk2(v[j].x * rstd * gg.x, v[j].y * rstd * gg.y); w.y = pk2(v[j].z * rstd * gg.z, v[j].w * rstd * gg.w); o8[64 * j] = w; }
}
template <bool NORM2>
__device__ __forceinline__ void resid_row(const bf16* frow, const float* baserow, float wgt, const float* g1, const float* g2, float* hout, bf16* bout, int lane) {
    const GAS v2u* fr = (const GAS v2u*)frow + lane; const GAS f32x4* br = (const GAS f32x4*)baserow + lane;
    const GAS f32x4* g1r = (const GAS f32x4*)g1 + lane; const GAS f32x4* g2r = (const GAS f32x4*)g2 + lane;
    f32x4 v[16]; float s = 0.f;
#pragma unroll
    for (int j = 0; j < 16; ++j) { const v2u fw = fr[64 * j]; v[j] = (f32x4){bflo(fw.x), bfhi(fw.x), bflo(fw.y), bfhi(fw.y)}; s += (v[j].x * v[j].x + v[j].y * v[j].y) + (v[j].z * v[j].z + v[j].w * v[j].w); }
    const float rw = wgt / sqrtf(wave_sum(s) * (1.f / DM) + EPS);
    float s2 = 0.f; GAS f32x4* ho = (GAS f32x4*)hout + lane;
#pragma unroll
    for (int j = 0; j < 16; ++j) { const f32x4 b = br[64 * j], gg = g1r[64 * j]; v[j] = b + v[j] * rw * gg; ho[64 * j] = v[j];
        s2 += (v[j].x * v[j].x + v[j].y * v[j].y) + (v[j].z * v[j].z + v[j].w * v[j].w);
        if ((j & 3) == 3) asm volatile("" ::: "memory"); }
    GAS v2u* o8 = (GAS v2u*)bout + lane;
    if (NORM2) { const float r2 = 1.f / sqrtf(wave_sum(s2) * (1.f / DM) + EPS);
#pragma unroll
        for (int j = 0; j < 16; ++j) { const f32x4 gg = g2r[64 * j]; v2u w; w.x = pk2(v[j].x * r2 * gg.x, v[j].y * r2 * gg.y); w.y = pk2(v[j].z * r2 * gg.z, v[j].w * r2 * gg.w); o8[64 * j] = w;
            if ((j & 7) == 7) asm volatile("" ::: "memory"); } }
    else {
#pragma unroll
        for (int j = 0; j < 16; ++j) { v2u w; w.x = pk2(v[j].x, v[j].y); w.y = pk2(v[j].z, v[j].w); o8[64 * j] = w; } }
}

__device__ __forceinline__ void skinny_gemm(Frame& F, const bf16* XN, const bf16* WSK, float* FFGLR) {
    LAS float* red = (LAS float*)(F.lds + RING_OFF);
    const int r = F.lane & 31, h = F.lane >> 5;
    for (int blk = F.vcu; blk < S / 32; blk += F.G) {
        const bf16* ap = XN + (size_t)(blk * 32 + r) * DM + F.wave * 512 + 8 * h; const bf16* bp = WSK + (size_t)r * DM + F.wave * 512 + 8 * h;
        f32x16 acc = {};
#pragma unroll 8
        for (int ks = 0; ks < 32; ++ks) { const bf16x8 a = *(const GAS bf16x8*)(ap + ks * 16), b = *(const GAS bf16x8*)(bp + ks * 16);
            acc = __builtin_amdgcn_mfma_f32_32x32x16_bf16(a, b, acc, 0, 0, 0); }
        __syncthreads();
#pragma unroll
        for (int i = 0; i < 16; ++i) red[(F.wave * 32 + ((i & 3) + 8 * (i >> 2) + 4 * h)) * 33 + r] = acc[i];
        __syncthreads();
        for (int e = F.tid; e < 1024; e += NWAVES * 64) { const int row = e >> 5, col = e & 31; float s = 0.f;
#pragma unroll
            for (int w = 0; w < 8; ++w) s += red[(w * 32 + row) * 33 + col];
            FFGLR[(size_t)(blk * 32 + row) * 32 + col] = s; }
    }
    __syncthreads();
}


__device__ __forceinline__ void fox_norms(Frame& F, const bf16* Q, const bf16* K, gu32* NRM) {
    const int gw_ = F.vcu * NWAVES + F.wave, ngw = F.G * NWAVES, sub = F.lane >> 4, l16 = F.lane & 15;
    for (int hd = 0; hd < FH; ++hd) { float mq = 0.f, mk = 0.f;
        for (int r0 = gw_ * 4; r0 < S; r0 += ngw * 4) { const size_t o = ((size_t)hd * S + r0 + sub) * FD + l16 * 8;
            const v4u a = *(const GAS v4u*)(Q + o), b = *(const GAS v4u*)(K + o);
            float sq = bflo(a.x) * bflo(a.x) + bfhi(a.x) * bfhi(a.x) + bflo(a.y) * bflo(a.y) + bfhi(a.y) * bfhi(a.y) + bflo(a.z) * bflo(a.z) + bfhi(a.z) * bfhi(a.z) + bflo(a.w) * bflo(a.w) + bfhi(a.w) * bfhi(a.w);
            float sk = bflo(b.x) * bflo(b.x) + bfhi(b.x) * bfhi(b.x) + bflo(b.y) * bflo(b.y) + bfhi(b.y) * bfhi(b.y) + bflo(b.z) * bflo(b.z) + bfhi(b.z) * bfhi(b.z) + bflo(b.w) * bflo(b.w) + bfhi(b.w) * bfhi(b.w);
#pragma unroll
            for (int o2 = 1; o2 < 16; o2 <<= 1) { sq += __shfl_xor(sq, o2); sk += __shfl_xor(sk, o2); }
            mq = fmaxf(mq, sq); mk = fmaxf(mk, sk); }
        mq = fmaxf(mq, __shfl_xor(mq, 16)); mq = fmaxf(mq, __shfl_xor(mq, 32)); mk = fmaxf(mk, __shfl_xor(mk, 16)); mk = fmaxf(mk, __shfl_xor(mk, 32));
        if (F.lane == 0) { __hip_atomic_fetch_max(NRM + 2 * hd, __builtin_bit_cast(unsigned, mq), RLX_AGENT); __hip_atomic_fetch_max(NRM + 2 * hd + 1, __builtin_bit_cast(unsigned, mk), RLX_AGENT); } }
}
constexpr float CF_SCALE = SIMPLE_ATTN ? 1.0f : 11.313708498984761f;
__device__ __forceinline__ void fox_prep(Frame& F, const float* FFGLR, const float* bfv, float* cf) {
    LAS float* sc = (LAS float*)(F.lds + RING_OFF);
    for (int hd = F.vcu; hd < FH; hd += F.G) {
        const float b = bfv[hd]; const int t0 = F.tid * 16; float v[16]; float run = 0.f;
#pragma unroll
        for (int j = 0; j < 16; ++j) { run += log_sigmoid_f(FFGLR[(size_t)(t0 + j) * 32 + hd] + b); v[j] = run; }
        float inc = run;
#pragma unroll
        for (int o = 1; o < 64; o <<= 1) { const float n = __shfl_up(inc, o); if (F.lane >= o) inc += n; }
        __syncthreads();
        if (F.lane == 63) sc[512 + F.wave] = inc;
        __syncthreads();
        float woff = 0.f;
        for (int w = 0; w < F.wave; ++w) woff += sc[512 + w];
        const float excl = woff + inc - run;
#pragma unroll
        for (int j = 0; j < 16; ++j) cf[(size_t)hd * S + t0 + j] = (v[j] + excl) * CF_SCALE;
    }
    __syncthreads();
}

#if SIMPLE_ATTN
__device__ __forceinline__ void attn_simple(Frame& F, const bf16* Q, const bf16* K, const bf16* V, const float* cf, bf16* MIX) {
    LAS unsigned char* kt = F.lds + RING_OFF; LAS unsigned char* vt = kt + 16384; LAS float* ck = (LAS float*)(vt + 16384);
    const int row = F.tid >> 3, part = F.tid & 7;
    for (int item = F.vcu; item < FH * (S / 64); item += F.G) {
        const int hd = item & 15, qb = (S / 64 - 1) - (item >> 4), qrow = qb * 64 + row;
        float q[16], o[16]; float m = -1e30f, l = 0.f;
        { const GAS v4u* qp = (const GAS v4u*)(Q + ((size_t)hd * S + qrow) * FD + part * 16); const v4u a = qp[0], b = qp[1];
          const unsigned w[8] = {a.x, a.y, a.z, a.w, b.x, b.y, b.z, b.w};
#pragma unroll
          for (int j = 0; j < 8; ++j) { q[2 * j] = bflo(w[j]) * FOX_SCALE; q[2 * j + 1] = bfhi(w[j]) * FOX_SCALE; } }
#pragma unroll
        for (int j = 0; j < 16; ++j) o[j] = 0.f;
        const float cq = cf[(size_t)hd * S + qrow];
        for (int ktile = 0; ktile <= qb; ++ktile) {
            __syncthreads();
            for (int e = F.tid; e < 1024; e += NWAVES * 64) { const int key = e >> 4, ch = e & 15;
                *(LAS v4u*)(kt + key * 256 + ch * 16) = *(const GAS v4u*)(K + ((size_t)hd * S + ktile * 64 + key) * FD + ch * 8);
                *(LAS v4u*)(vt + key * 256 + ch * 16) = *(const GAS v4u*)(V + ((size_t)hd * S + ktile * 64 + key) * FD + ch * 8); }
            if (F.tid < 64) ck[F.tid] = cf[(size_t)hd * S + ktile * 64 + F.tid];
            __syncthreads();
#pragma unroll 1
            for (int kb = 0; kb < 4; ++kb) {
                float s[16]; float mx = -__builtin_inff();
#pragma unroll
                for (int kk = 0; kk < 16; ++kk) { const int key = kb * 16 + kk;
                    const v4u a = *(const LAS v4u*)(kt + key * 256 + part * 32), b = *(const LAS v4u*)(kt + key * 256 + part * 32 + 16);
                    const unsigned w[8] = {a.x, a.y, a.z, a.w, b.x, b.y, b.z, b.w}; float d = 0.f;
#pragma unroll
                    for (int j = 0; j < 8; ++j) d += q[2 * j] * bflo(w[j]) + q[2 * j + 1] * bfhi(w[j]);
                    d += __shfl_xor(d, 1); d += __shfl_xor(d, 2); d += __shfl_xor(d, 4);
                    d += cq - ck[key];
                    if (ktile * 64 + key > qrow) d = -__builtin_inff();
                    s[kk] = d; mx = fmaxf(mx, d); }
                const float mn = fmaxf(m, mx), alpha = __expf(m - mn); l *= alpha; m = mn;
#pragma unroll
                for (int j = 0; j < 16; ++j) o[j] *= alpha;
#pragma unroll
                for (int kk = 0; kk < 16; ++kk) { const int key = kb * 16 + kk; const float p = __expf(s[kk] - mn); l += p;
                    const v4u a = *(const LAS v4u*)(vt + key * 256 + part * 32), b = *(const LAS v4u*)(vt + key * 256 + part * 32 + 16);
                    const unsigned w[8] = {a.x, a.y, a.z, a.w, b.x, b.y, b.z, b.w};
#pragma unroll
                    for (int j = 0; j < 8; ++j) { o[2 * j] += p * bflo(w[j]); o[2 * j + 1] += p * bfhi(w[j]); } }
            }
        }
        const float il = 1.f / l; v4u w0, w1;
        w0.x = pk2(o[0] * il, o[1] * il); w0.y = pk2(o[2] * il, o[3] * il); w0.z = pk2(o[4] * il, o[5] * il); w0.w = pk2(o[6] * il, o[7] * il);
        w1.x = pk2(o[8] * il, o[9] * il); w1.y = pk2(o[10] * il, o[11] * il); w1.z = pk2(o[12] * il, o[13] * il); w1.w = pk2(o[14] * il, o[15] * il);
        GAS v4u* op = (GAS v4u*)(MIX + (size_t)qrow * DM + hd * FD + part * 16); op[0] = w0; op[1] = w1;
    }
    __syncthreads();
}
#endif

#if SIMPLE_GLA
__device__ __forceinline__ void gla_simple(Frame& F, const bf16* GQ, const bf16* GK, const bf16* GV, const float* FFGLR, const float* Wg, const float* bg, float* OGLA) {
    constexpr int TB = 16;
    LAS float* qs = (LAS float*)(F.lds + RING_OFF);
    LAS float* ks = qs + TB * 256;
    LAS float* vs = ks + TB * 256;
    LAS float* gs = vs + TB * 32;
    LAS float* red = gs + TB * 16;
    const int dk = F.tid & 255, half = F.tid >> 8;
    for (int item = F.vcu; item < GH * 16; item += F.G) {
        const int hd = item >> 4, sl = item & 15, col = hd * GDK + dk;
        float wg[16];
#pragma unroll
        for (int r = 0; r < 16; ++r) wg[r] = Wg[r * GKW + col];
        const float bgv = bg[col];
        float st[16];
#pragma unroll
        for (int j = 0; j < 16; ++j) st[j] = 0.f;
        for (int t0 = 0; t0 < S; t0 += TB) {
            __syncthreads();
            for (int e = F.tid; e < TB * 256; e += NWAVES * 64) { const int tt = e >> 8, d = e & 255;
                qs[e] = bf2f(GQ[(size_t)(t0 + tt) * GKW + hd * GDK + d]) * 0.0625f; ks[e] = bf2f(GK[(size_t)(t0 + tt) * GKW + hd * GDK + d]); }
            { const int tt = F.tid >> 5, c = F.tid & 31; vs[F.tid] = bf2f(GV[(size_t)(t0 + tt) * GVW + hd * GDV + sl * 32 + c]); }
            if (F.tid < TB * 16) { const int tt = F.tid >> 4, r = F.tid & 15; gs[F.tid] = FFGLR[(size_t)(t0 + tt) * 32 + 16 + r]; }
            __syncthreads();
#pragma unroll 1
            for (int tt = 0; tt < TB; ++tt) {
                float z = bgv;
#pragma unroll
                for (int r = 0; r < 16; ++r) z += gs[tt * 16 + r] * wg[r];
                const float a = expf(log_sigmoid_f(z) * 0.0625f), kv = ks[tt * 256 + dk], qv = qs[tt * 256 + dk];
                float part[16];
#pragma unroll
                for (int j = 0; j < 16; ++j) { st[j] = a * st[j] + kv * vs[tt * 32 + half * 16 + j]; part[j] = qv * st[j]; }
#pragma unroll
                for (int j = 0; j < 16; ++j) {
#pragma unroll
                    for (int o = 1; o < 64; o <<= 1) part[j] += __shfl_xor(part[j], o); }
                float mine = part[0];
#pragma unroll
                for (int j = 1; j < 16; ++j) mine = (F.lane == j) ? part[j] : mine;
                if (F.lane < 16) red[(tt * 8 + F.wave) * 16 + F.lane] = mine;
            }
            __syncthreads();
            { const int tt = F.tid >> 5, c = F.tid & 31, hw = c >> 4, j = c & 15; float s = 0.f;
#pragma unroll
              for (int w = 0; w < 4; ++w) s += red[(tt * 8 + hw * 4 + w) * 16 + j];
              OGLA[(size_t)(t0 + tt) * GVW + hd * GDV + sl * 32 + c] = s; }
        }
    }
    __syncthreads();
}
#endif

__device__ __forceinline__ void gla_post(Frame& F, const float* OGLA, const bf16* GR, const float* g, bf16* MIX) {
    const int gw = F.vcu * NWAVES + F.wave, NGW = F.G * NWAVES;
    for (int it = gw; it < S * GH; it += NGW) { const int row = it >> 2, hd = it & 3;
        const GAS f32x4* op = (const GAS f32x4*)(OGLA + (size_t)row * GVW + hd * GDV) + 2 * F.lane; const f32x4 a = op[0], b = op[1];
        const float ss = (a.x * a.x + a.y * a.y) + (a.z * a.z + a.w * a.w) + (b.x * b.x + b.y * b.y) + (b.z * b.z + b.w * b.w);
        const float rstd = 1.f / sqrtf(wave_sum(ss) * (1.f / GDV) + EPS);
        const v4u rw = *(const GAS v4u*)(GR + (size_t)row * GVW + hd * GDV + 8 * F.lane);
        const GAS f32x4* gp = (const GAS f32x4*)(g) + 2 * F.lane; const f32x4 g0 = gp[0], g1 = gp[1];
        v4u w;
        w.x = pk2(a.x * rstd * g0.x * pg8::silu_f(bflo(rw.x)), a.y * rstd * g0.y * pg8::silu_f(bfhi(rw.x)));
        w.y = pk2(a.z * rstd * g0.z * pg8::silu_f(bflo(rw.y)), a.w * rstd * g0.w * pg8::silu_f(bfhi(rw.y)));
        w.z = pk2(b.x * rstd * g1.x * pg8::silu_f(bflo(rw.z)), b.y * rstd * g1.y * pg8::silu_f(bfhi(rw.z)));
        w.w = pk2(b.z * rstd * g1.z * pg8::silu_f(bflo(rw.w)), b.w * rstd * g1.w * pg8::silu_f(bfhi(rw.w)));
        *(GAS v4u*)(MIX + (size_t)row * DM + FW + hd * GDV + 8 * F.lane) = w; }
}

#if !SIMPLE_ATTN
namespace fa {
constexpr int D = 128, NW = 8, QBLK = 32, KVBLK = 64, QB = NW * QBLK, LDO = 4096;
constexpr int SHM_V = KVBLK * D * 2, SHM_K = KVBLK * D * 2;
constexpr int OFF_Q = 2 * SHM_V + 2 * SHM_K, OFF_CK = 131072 + 1024, OFF_WS = OFF_CK + 512, ATT_LDS_END = OFF_WS + NW * 64 * 4;
constexpr float SCALE = 0.08838834764831845f, THR = 8.f;
typedef short s16x4 __attribute__((ext_vector_type(4)));
typedef unsigned u32x4 __attribute__((ext_vector_type(4)));
#define KSWZ(row, colB) ((row) * 256 + ((colB) ^ (((row) & 7) << 4)))
#define SBAR() __builtin_amdgcn_sched_barrier(0)
__device__ __forceinline__ int v_st(int k, int c) { const int kk = (k & ~0xC) | ((k & 4) << 1) | ((k & 8) >> 1); return ((kk >> 3) * 4 + (c >> 5)) * 512 + ((kk & 7) * 32 + (c & 31)) * 2; }
__device__ __forceinline__ int v_rd_base(int lane) { return ((lane & 3) << 3) | (((lane >> 2) & 3) << 6) | (((lane >> 4) & 1) << 5) | (((lane >> 5) & 1) << 8); }
constexpr int v_rd_off(int d0, int ks, int half) { return d0 * 512 + ks * 4096 + half * 2048; }
__device__ __forceinline__ int crow(int r, int hi) { return (r & 3) + 8 * (r >> 2) + 4 * hi; }
__device__ __forceinline__ unsigned cvtpk(float lo, float hi) { unsigned r; asm volatile("v_cvt_pk_bf16_f32 %0, %1, %2" : "=v"(r) : "v"(lo), "v"(hi)); return r; }
__device__ __forceinline__ bf16x8 ld8(const bf16* p) { return *reinterpret_cast<const bf16x8*>(p); }
__device__ __forceinline__ void mask_tile(f32x16& p0, f32x16& p1, int dq) {
    const float NEG = -__builtin_inff();
#pragma unroll
    for (int r = 0; r < 16; ++r) { const int c = (r & 3) + 8 * (r >> 2);
        if (dq - c < 0) p0[r] = NEG;
        if (dq - c - 32 < 0) p1[r] = NEG; }
}
__device__ __forceinline__ void partialSM(f32x16& p0, f32x16& p1, float& m_reg, float& mn, float& alpha) {
    float pmax = p0[0]; for (int r = 1; r < 16; ++r) pmax = fmaxf(pmax, p0[r]); for (int r = 0; r < 16; ++r) pmax = fmaxf(pmax, p1[r]);
    { auto rr = __builtin_amdgcn_permlane32_swap(__float_as_uint(pmax), __float_as_uint(pmax), false, false);
      pmax = fmaxf(__uint_as_float(rr[0]), __uint_as_float(rr[1])); }
    constexpr float C2 = 1.4426950408889634f * SCALE;
    if (__builtin_expect(__all((pmax - m_reg) * SCALE <= THR), 1)) { mn = m_reg; alpha = 1.f; }
    else { mn = fmaxf(m_reg, pmax); alpha = __builtin_amdgcn_exp2f((m_reg - mn) * C2); m_reg = mn; }
    const float mnL = -mn * C2;
    for (int r = 0; r < 16; ++r) p0[r] = fmaf(p0[r], C2, mnL); for (int r = 0; r < 16; ++r) p1[r] = fmaf(p1[r], C2, mnL);
    for (int r = 0; r < 16; ++r) p0[r] = __builtin_amdgcn_exp2f(p0[r]);
}
__device__ __forceinline__ void finishSM(f32x16& p0, f32x16& p1, float alpha, float& l_reg, bf16x8& pa0, bf16x8& pa1, bf16x8& pa2, bf16x8& pa3) {
    for (int r = 0; r < 16; ++r) p1[r] = __builtin_amdgcn_exp2f(p1[r]);
    float ps = 0; for (int r = 0; r < 16; ++r) ps += p0[r]; for (int r = 0; r < 16; ++r) ps += p1[r];
    { auto rr = __builtin_amdgcn_permlane32_swap(__float_as_uint(ps), __float_as_uint(ps), false, false);
      ps = __uint_as_float(rr[0]) + __uint_as_float(rr[1]); }
    l_reg = l_reg * alpha + ps;
#define PK4(P, B_, OUT) do { unsigned a0 = cvtpk(P[B_+0], P[B_+1]), a1 = cvtpk(P[B_+2], P[B_+3]);                          \
        unsigned b0 = cvtpk(P[B_+4], P[B_+5]), b1 = cvtpk(P[B_+6], P[B_+7]);                                             \
        auto r0 = __builtin_amdgcn_permlane32_swap(a0, b0, false, false); auto r1 = __builtin_amdgcn_permlane32_swap(a1, b1, false, false); \
        u32x4 w = {r0[0], r1[0], r0[1], r1[1]}; OUT = *reinterpret_cast<bf16x8*>(&w); } while (0)
    PK4(p0, 0, pa0); PK4(p0, 8, pa1); PK4(p1, 0, pa2); PK4(p1, 8, pa3);
#undef PK4
}
template <int KB>
__device__ __forceinline__ void qkt(f32x16& p0, f32x16& p1, const char* K_lds, const char* CK_lds, int r32, int hi, const char* Qw, float cq) {
#pragma unroll
    for (int g = 0; g < 4; ++g) { const f32x4 c0 = *(const f32x4*)(CK_lds + KB * 256 + (8 * g + 4 * hi) * 4), c1 = *(const f32x4*)(CK_lds + KB * 256 + (32 + 8 * g + 4 * hi) * 4);
#pragma unroll
        for (int i = 0; i < 4; ++i) { p0[4 * g + i] = cq - c0[i]; p1[4 * g + i] = cq - c1[i]; } }
    const char* kb[4];
#pragma unroll
    for (int dd = 0; dd < 4; ++dd) kb[dd] = K_lds + KB * SHM_K + KSWZ(r32, (dd * 16 + hi * 8) * 2);
#pragma unroll
    for (int d0 = 0; d0 < 8; ++d0) { const char* a = kb[d0 & 3] + (d0 >> 2) * 128;
        bf16x8 b0 = *reinterpret_cast<const bf16x8*>(a);
        bf16x8 b1 = *reinterpret_cast<const bf16x8*>(a + 32 * 256);
        bf16x8 qv = *reinterpret_cast<const bf16x8*>(Qw + KSWZ(r32, ((d0 & 3) * 16 + hi * 8) * 2) + (d0 >> 2) * 128);
        p0 = __builtin_amdgcn_mfma_f32_32x32x16_bf16(b0, qv, p0, 0, 0, 0);
        p1 = __builtin_amdgcn_mfma_f32_32x32x16_bf16(b1, qv, p1, 0, 0, 0); }
}
template <int VB>
__device__ __forceinline__ void pv_tile(f32x16* o, int vb0, bf16x8 pa0, bf16x8 pa1, bf16x8 pa2, bf16x8 pa3) {
#define TRRD(dst, off) asm volatile("ds_read_b64_tr_b16 %0, %1 offset:%2" : "=&v"(dst) : "v"(vb0), "i"(off) : "memory")
#define PV_D0(d0) do { s16x4 l0, l1, l2, l3, h0, h1, h2, h3; constexpr int b_ = VB * SHM_V + v_rd_off(d0, 0, 0); \
        TRRD(l0, b_); TRRD(h0, b_ + 2048); TRRD(l1, b_ + 4096); TRRD(h1, b_ + 6144); TRRD(l2, b_ + 8192); TRRD(h2, b_ + 10240); TRRD(l3, b_ + 12288); TRRD(h3, b_ + 14336); \
        asm volatile("s_waitcnt lgkmcnt(0)" ::: "memory"); SBAR();   \
        o[d0] = __builtin_amdgcn_mfma_f32_32x32x16_bf16(pa0, (bf16x8){l0[0], l0[1], l0[2], l0[3], h0[0], h0[1], h0[2], h0[3]}, o[d0], 0, 0, 0);   \
        o[d0] = __builtin_amdgcn_mfma_f32_32x32x16_bf16(pa1, (bf16x8){l1[0], l1[1], l1[2], l1[3], h1[0], h1[1], h1[2], h1[3]}, o[d0], 0, 0, 0);   \
        o[d0] = __builtin_amdgcn_mfma_f32_32x32x16_bf16(pa2, (bf16x8){l2[0], l2[1], l2[2], l2[3], h2[0], h2[1], h2[2], h2[3]}, o[d0], 0, 0, 0);   \
        o[d0] = __builtin_amdgcn_mfma_f32_32x32x16_bf16(pa3, (bf16x8){l3[0], l3[1], l3[2], l3[3], h3[0], h3[1], h3[2], h3[3]}, o[d0], 0, 0, 0); } while (0)
    PV_D0(0); PV_D0(1); PV_D0(2); PV_D0(3);
#undef PV_D0
#undef TRRD
}
struct Bases { const bf16* Q; const bf16* K; const bf16* V; const float* C; bf16* O; };
struct BlockRef { int hd, P0, jlo; };
constexpr int SEQ = 8192;
struct Seam { bf16x8 st_v0, st_v1, st_k0, st_k1; float cq; };
#define ROW(p, k0, rr) ((p) + (size_t)((k0) + (rr)) * D + sc)
#define VMW() asm volatile("s_waitcnt vmcnt(0)" ::: "memory")
#define VMWN(n) asm volatile("s_waitcnt vmcnt(%0)" :: "i"(n) : "memory")
#define SLOAD_H(Kp, Vp, Cp, k0) do { S.st_v0 = ld8(ROW(Vp, k0, sr)); S.st_v1 = ld8(ROW(Vp, k0, 32 + sr));              \
                         S.st_k0 = ld8(ROW(Kp, k0, sr)); S.st_k1 = ld8(ROW(Kp, k0, 32 + sr)); } while (0)
#define CLOAD(Cp, k0, bf) do { if (wid == 0) { int ln_ = lane; asm volatile("" : "+v"(ln_));   __builtin_amdgcn_global_load_lds((const unsigned*)((Cp) + (k0) + ln_), (LAS unsigned*)(CK_lds + (bf) * 256), 4, 0, 0); } } while (0)
#define SWRITE_HK(bf) do { *(bf16x8*)(K_lds + (bf) * SHM_K + kws) = S.st_k0; *(bf16x8*)(K_lds + (bf) * SHM_K + kws + 32 * 256) = S.st_k1; } while (0)
#define SWRITE_HV(bf) do { *(bf16x8*)(V_lds + (bf) * SHM_V + vst0) = S.st_v0; *(bf16x8*)(V_lds + (bf) * SHM_V + vst1) = S.st_v1; } while (0)
#define SWRITE_H(bf) do { SWRITE_HV(bf); SWRITE_HK(bf); } while (0)
__device__ __forceinline__ void fox_prime(const Bases& B, const BlockRef& cur, char* lds, Seam& S) {
    const int tid = threadIdx.x, wid = __builtin_amdgcn_readfirstlane(tid >> 6), lane = tid & 63, r32 = lane & 31, hi = lane >> 5;
    const int sr = tid >> 4, sc = (tid & 15) * 8, kws = KSWZ(sr, sc * 2); char* K_lds = lds + 2 * SHM_V; char* CK_lds = lds + OFF_CK;
    const int kb0 = cur.jlo * KVBLK;
    const bf16* curQ = B.Q + (size_t)cur.hd * SEQ * D; const bf16* curK = B.K + (size_t)cur.hd * SEQ * D; const bf16* curV = B.V + (size_t)cur.hd * SEQ * D; const float* curC = B.C + (size_t)cur.hd * SEQ;
    { char* Qw = lds + OFF_Q + wid * (QBLK * 256); bf16x8 qt[8];
#pragma unroll
      for (int d0 = 0; d0 < 8; ++d0) qt[d0] = ld8(curQ + (size_t)(cur.P0 + wid * QBLK + r32) * D + d0 * 16 + hi * 8);
#pragma unroll
      for (int d0 = 0; d0 < 8; ++d0) *(bf16x8*)(Qw + KSWZ(r32, ((d0 & 3) * 16 + hi * 8) * 2) + (d0 >> 2) * 128) = qt[d0]; }
    S.cq = curC[cur.P0 + wid * QBLK + r32];
    SLOAD_H(curK, curV, curC, kb0); CLOAD(curC, kb0, 0); VMW(); SWRITE_HK(0);
    __syncthreads();
}
__device__ __forceinline__ void fox_block(const Bases& B, const BlockRef& cur, const BlockRef& nxt, char* lds, Seam& S) {
    const int tid = threadIdx.x, wid = __builtin_amdgcn_readfirstlane(tid >> 6), lane = tid & 63, r32 = lane & 31, hi = lane >> 5;
    const int j_lo = cur.jlo, j_hi = (cur.P0 + QB - 1) / KVBLK + 1;
    const int NT = j_hi - j_lo;
    const int kbn = nxt.jlo * KVBLK;
    const int qlo = cur.P0 + wid * QBLK, qm = qlo + r32 - 4 * hi;
    char* V_lds = lds; char* K_lds = lds + 2 * SHM_V; char* CK_lds = lds + OFF_CK; char* Qw = lds + OFF_Q + wid * (QBLK * 256);
    float* ws = (float*)(lds + OFF_WS) + wid * 64; float* li_l = ws, * al_l = ws + 32;
    float m_reg = -1e30f, l_reg = 0; f32x16 o[4] = {};
    const float cq = S.cq;
    const int sr = tid >> 4, sc = (tid & 15) * 8, vst0 = v_st(sr, sc), vst1 = v_st(32 + sr, sc), kws = KSWZ(sr, sc * 2);
    const int vb0 = (int)(uintptr_t)V_lds + v_rd_base(lane);
    const bf16* Kh = B.K + (size_t)cur.hd * SEQ * D; const bf16* Vh = B.V + (size_t)cur.hd * SEQ * D; const float* Ch = B.C + (size_t)cur.hd * SEQ;
#define RESC(a) do { if (__any((a) < 1.f)) { if (hi == 0) al_l[r32] = (a); asm volatile("s_waitcnt lgkmcnt(0)" ::: "memory");              \
                     for (int d_ = 0; d_ < 4; ++d_) for (int r = 0; r < 16; ++r) o[d_][r] *= al_l[crow(r, hi)]; } } while (0)
#define KBASE(t) ((j_lo + (t)) * KVBLK)
#define MASKT(P0_, P1_, t) do { const int kb_ = KBASE(t); if (kb_ + KVBLK - 1 > qlo) mask_tile(P0_, P1_, qm - kb_); } while (0)
    constexpr int NQL = 9;
#define SEAM_K0() do { VMWN(NQL); SWRITE_HK(0); SBAR(); } while (0)
    f32x16 pA0, pA1, pB0, pB1; float mnA, mnB, alA, alB; bf16x8 pa0, pa1, pa2, pa3;
    SWRITE_HV(0); SBAR();
    if (NT > 1) { SLOAD_H(Kh, Vh, Ch, KBASE(1)); CLOAD(Ch, KBASE(1), 1); }
    SBAR(); qkt<0>(pA0, pA1, K_lds, CK_lds, r32, hi, Qw, cq);
    MASKT(pA0, pA1, 0); partialSM(pA0, pA1, m_reg, mnA, alA);
    if (NT > 1) { VMW(); SWRITE_H(1); }
    __syncthreads();
#define HALF_STEP(PX0, PX1, mnX, alX, PY0, PY1, alY, t, KB, VB, SB) do {                                                      \
        SBAR(); qkt<KB>(PX0, PX1, K_lds, CK_lds, r32, hi, Qw, cq);                                             \
        finishSM(PY0, PY1, alY, l_reg, pa0, pa1, pa2, pa3); SBAR();                                                           \
        if ((t) + 1 < NT) { SLOAD_H(Kh, Vh, Ch, KBASE((t) + 1)); CLOAD(Ch, KBASE((t) + 1), SB); SBAR(); }                                               \
        pv_tile<VB>(o, vb0, pa0, pa1, pa2, pa3); MASKT(PX0, PX1, (t)); partialSM(PX0, PX1, m_reg, mnX, alX);                                        \
        __syncthreads();                                                                                                      \
        if ((t) + 1 < NT) { VMW(); SWRITE_H(SB); }                                                                          \
        RESC(alX); __syncthreads(); } while (0)
    for (int t = 1; t + 1 < NT; t += 2) {
        HALF_STEP(pB0, pB1, mnB, alB, pA0, pA1, alA, t, 1, 0, 0);
        HALF_STEP(pA0, pA1, mnA, alA, pB0, pB1, alB, t + 1, 0, 1, 1);
    }
    const bool even = (NT & 1) == 0;
    if (even) { SBAR(); qkt<1>(pB0, pB1, K_lds, CK_lds, r32, hi, Qw, cq); SBAR(); }
    { const bf16* nK = B.K + (size_t)nxt.hd * SEQ * D; const bf16* nV = B.V + (size_t)nxt.hd * SEQ * D; const float* nC = B.C + (size_t)nxt.hd * SEQ;
      SLOAD_H(nK, nV, nC, kbn); CLOAD(nC, kbn, 0); } SBAR();
    finishSM(pA0, pA1, alA, l_reg, pa0, pa1, pa2, pa3); SBAR();
    pv_tile<0>(o, vb0, pa0, pa1, pa2, pa3);
    if (even) { MASKT(pB0, pB1, NT - 1); partialSM(pB0, pB1, m_reg, mnB, alB); __syncthreads(); RESC(alB);
        finishSM(pB0, pB1, alB, l_reg, pa0, pa1, pa2, pa3); SBAR(); pv_tile<1>(o, vb0, pa0, pa1, pa2, pa3); }
    SBAR();
    bf16x8 qt[8];
#pragma unroll
    for (int d0 = 0; d0 < 8; ++d0) qt[d0] = ld8(B.Q + (size_t)nxt.hd * SEQ * D + (size_t)(nxt.P0 + wid * QBLK + r32) * D + d0 * 16 + hi * 8);
    S.cq = (B.C + (size_t)nxt.hd * SEQ)[nxt.P0 + wid * QBLK + r32];
    SBAR(); SEAM_K0();
    if (hi == 0) li_l[r32] = l_reg; asm volatile("s_waitcnt lgkmcnt(0)" ::: "memory");
    float rli[16];
#pragma unroll
    for (int r = 0; r < 16; ++r) rli[r] = __builtin_amdgcn_rcpf(li_l[crow(r, hi)]);
    bf16* Ow = B.O + cur.hd * D + (size_t)(cur.P0 + wid * QBLK) * LDO;
#pragma unroll
    for (int r = 0; r < 16; ++r) { const int orow = crow(r, hi);
#pragma unroll
        for (int d0 = 0; d0 < 4; ++d0) { const float v = o[d0][r] * rli[r];
            const float vn = __shfl_xor(v, 1);
            if ((r32 & 1) == 0) *(unsigned*)(Ow + (size_t)orow * LDO + d0 * 32 + r32) = cvtpk(v, vn); } }
    SBAR();
#pragma unroll
    for (int d0 = 0; d0 < 8; ++d0) *(bf16x8*)(Qw + KSWZ(r32, ((d0 & 3) * 16 + hi * 8) * 2) + (d0 >> 2) * 128) = qt[d0];
    __syncthreads();
#undef RESC
#undef KBASE
#undef MASKT
#undef SEAM_K0
#undef HALF_STEP
}
#undef ROW
#undef VMW
#undef VMWN
#undef SLOAD_H
#undef CLOAD
#undef SWRITE_HK
#undef SWRITE_HV
#undef SWRITE_H
#undef KSWZ
#undef SBAR
}
#endif

#if !SIMPLE_ATTN
__device__ __forceinline__ int fox_jlo(const float* CS, const gu32* NRM, int hd, int P0, int lane) {
    const float qm2 = __builtin_bit_cast(float, __hip_atomic_load(NRM + 2 * hd, RLX_AGENT)), km2 = __builtin_bit_cast(float, __hip_atomic_load(NRM + 2 * hd + 1, RLX_AGENT));
    const float braw = 30.0f * 11.313708498984761f + 2.0f * sqrtf(qm2 * km2) * 1.0001f + 1.0f;
    const float* c = CS + (size_t)hd * S; const float c0 = c[P0]; const int jd = P0 >> 6;
    const int j0 = lane, j1 = lane + 64;
    const bool p0 = j0 <= jd && (c0 - c[64 * (j0 <= jd ? j0 : jd) + 63] > -braw), p1 = j1 <= jd && (c0 - c[64 * (j1 <= jd ? j1 : jd) + 63] > -braw);
    const unsigned long long b0 = __ballot(p0), b1 = __ballot(p1);
    int jl = b0 ? __builtin_ctzll(b0) : (b1 ? 64 + __builtin_ctzll(b1) : jd);
    return __builtin_amdgcn_readfirstlane(jl < jd ? jl : jd);
}
__device__ __forceinline__ fa::BlockRef fox_ref(int item, int pass, int jl0, int jl1) {
    const int y = item & 15, qb = pass ? 31 - y : y; fa::BlockRef r; r.hd = (item >> 4) & 15; r.P0 = qb * fa::QB; r.jlo = pass ? jl1 : jl0;
    return r;
}
__device__ __forceinline__ void fox_phase(Frame& F, char* lds, const bf16* Q, const bf16* K, const bf16* V, const float* CS, const gu32* NRM, bf16* MIX) {
    constexpr int NITEMS = FH * 16 * (PROBE_REPEAT == 61 ? 2 : 1);
    const int nw = SIMPLE_GLA ? F.G : F.G - NSCAN; int item = SIMPLE_GLA ? F.vcu : F.vcu - NSCAN; if (item >= NITEMS) return;
    int pass = 0;
    const fa::Bases B{Q, K, V, CS, MIX};
    int jl0 = fox_jlo(CS, NRM, (item >> 4) & 15, (item & 15) * fa::QB, F.lane), jl1 = fox_jlo(CS, NRM, (item >> 4) & 15, (31 - (item & 15)) * fa::QB, F.lane);
    fa::BlockRef cur = fox_ref(item, 0, jl0, jl1);
    fa::Seam Sm;
    fa::fox_prime(B, cur, lds, Sm);
    for (;;) {
        const bool more_pass = pass == 0, more_item = item + nw < NITEMS, last = !more_pass && !more_item;
        int itn = item, passn = pass + 1;
        if (!more_pass) { passn = 0; itn = more_item ? item + nw : item;
            if (more_item) { jl0 = fox_jlo(CS, NRM, (itn >> 4) & 15, (itn & 15) * fa::QB, F.lane); jl1 = fox_jlo(CS, NRM, (itn >> 4) & 15, (31 - (itn & 15)) * fa::QB, F.lane); } }
        const fa::BlockRef nxt = last ? cur : fox_ref(itn, passn, jl0, jl1);
        fa::fox_block(B, cur, nxt, lds, Sm);
        if (last) break;
        cur = nxt; item = itn; pass = passn;
    }
}
#endif

#if !SIMPLE_GLA
constexpr int GP_GLR = 0, GP_TOT = 4096, GP_QD = 6144, GP_KI = GP_QD + 64 * 528, GP_KET = GP_KI + 64 * 528, GP_AS = GP_KET + 256 * 144, GP_END = GP_AS + 64 * 144;
static_assert(GP_END <= 131072, "gla prep LDS");
__device__ __forceinline__ void gla_prep(Frame& F, const bf16* GQ, const bf16* GK, const bf16* GV, const float* FFGLR, const float* Wg, const float* bg,
                                         bf16* QDF, bf16* KEF, bf16* AMF, bf16* VTF, float* DL) {
    LAS float* glr = (LAS float*)(F.lds + GP_GLR); LAS float* tot = (LAS float*)(F.lds + GP_TOT);
    LAS unsigned char* QD = F.lds + GP_QD; LAS unsigned char* KI = F.lds + GP_KI; LAS unsigned char* KET = F.lds + GP_KET; LAS unsigned char* AS = F.lds + GP_AS;
    const int tid = F.tid, lane = F.lane, r = lane & 31, hh = lane >> 5;
    for (int job = F.vcu; job < NCH * GH; job += F.G) {
        const int n = job >> 2, h = job & 3, t0 = n * GC;
        __syncthreads();
        for (int e = tid; e < 1024; e += NWAVES * 64) glr[e] = FFGLR[(size_t)(t0 + (e >> 4)) * 32 + 16 + (e & 15)];
        {
            const int c = tid, slice = c >> 5, cr = c & 31; const bf16* vp = GV + (size_t)t0 * GVW + h * GDV + c;
            bf16* vo = VTF + ((size_t)((n * 4 + h) * 16 + slice) * 4) * 512 + cr * 8;
#pragma unroll
            for (int ks = 0; ks < 4; ++ks)
#pragma unroll
                for (int half = 0; half < 2; ++half) { unsigned short e[8];
#pragma unroll
                    for (int j = 0; j < 8; ++j) e[j] = vp[(size_t)(16 * ks + 8 * half + j) * GVW];
                    v4u o; o.x = e[0] | ((unsigned)e[1] << 16); o.y = e[2] | ((unsigned)e[3] << 16); o.z = e[4] | ((unsigned)e[5] << 16); o.w = e[6] | ((unsigned)e[7] << 16);
                    *(GAS v4u*)(vo + ks * 512 + half * 256) = o; }
        }
        __syncthreads();
        const int d = tid & 255, th = tid >> 8, col = h * GDK + d;
        float bcum[32];
        {   float wg[16];
#pragma unroll
            for (int q = 0; q < 16; ++q) wg[q] = Wg[q * GKW + col];
            const float bgv = bg[col]; float run = 0.f;
#pragma unroll
            for (int i = 0; i < 32; ++i) { const int t = th * 32 + i; float z = bgv;
#pragma unroll
                for (int q = 0; q < 16; ++q) z += glr[t * 16 + q] * wg[q];
                run += log_sigmoid_f(z) * 0.0625f; bcum[i] = run; }
            tot[th * 256 + d] = run; }
        __syncthreads();
        const float tot0 = tot[d], blast = tot0 + tot[256 + d], boff = th ? tot0 : 0.f;
        if (th == 1) DL[(size_t)(n * 4 + h) * 256 + d] = __expf(blast);
        {   const bf16* qp = GQ + (size_t)(t0 + th * 32) * GKW + col; const bf16* kp = GK + (size_t)(t0 + th * 32) * GKW + col;
            unsigned kew[4];
#pragma unroll
            for (int i = 0; i < 32; ++i) { const int t = th * 32 + i; const float bb = bcum[i] + boff, qv = bf2f(qp[(size_t)i * GKW]), kv = bf2f(kp[(size_t)i * GKW]);
                const float eb = __expf(bb), qd = qv * 0.0625f * eb, ki = kv * __expf(-bb), ke = kv * __expf(blast - bb);
                *(LAS unsigned short*)(QD + t * 528 + d * 2) = (unsigned short)f2bf(qd);
                *(LAS unsigned short*)(KI + t * 528 + d * 2) = (unsigned short)f2bf(ki);
                const unsigned kb = f2bf(ke);
                if (i & 1) kew[(i >> 1) & 3] |= kb << 16; else kew[(i >> 1) & 3] = kb;
                if ((i & 7) == 7) { v4u o; o.x = kew[0]; o.y = kew[1]; o.z = kew[2]; o.w = kew[3]; *(LAS v4u*)(KET + d * 144 + (t - 7) * 2) = o; } }
        }
        __syncthreads();
        {
            const int r16 = lane & 15, g = lane >> 4;
#pragma unroll
            for (int tt = 0; tt < 2; ++tt) { const int T = 2 * F.wave + tt, mti = T >> 2, nti = T & 3;
                f32x4 acc = {0.f, 0.f, 0.f, 0.f};
#pragma unroll
                for (int ks = 0; ks < 8; ++ks) { const bf16x8 a = *(const LAS bf16x8*)(QD + (mti * 16 + r16) * 528 + (ks * 32 + 8 * g) * 2), b = *(const LAS bf16x8*)(KI + (nti * 16 + r16) * 528 + (ks * 32 + 8 * g) * 2);
                    acc = __builtin_amdgcn_mfma_f32_16x16x32_bf16(a, b, acc, 0, 0, 0); }
#pragma unroll
                for (int i = 0; i < 4; ++i) { const int tq = mti * 16 + 4 * g + i, tk = nti * 16 + r16;
                    *(LAS unsigned short*)(AS + tq * 144 + tk * 2) = (unsigned short)f2bf(tk <= tq ? acc[i] : 0.f); } }
        }
        __syncthreads();
        {   const size_t jb = (size_t)(n * 4 + h);
            { const int f = tid >> 6, mt = f >> 2, ks = f & 3;
              *(GAS v4u*)(AMF + (jb * 8 + f) * 512 + lane * 8) = *(const LAS v4u*)(AS + (32 * mt + r) * 144 + (16 * ks + 8 * hh) * 2); }
#pragma unroll
            for (int i = 0; i < 4; ++i) { const int f = (tid >> 6) + 8 * i;
                { const int w = f >> 2, mt = (f >> 1) & 1, s = f & 1; const LAS unsigned char* src = QD + (32 * mt + r) * 528 + (32 * w + 16 * s + 4 * hh) * 2;
                  const v2u lo = *(const LAS v2u*)src, hi = *(const LAS v2u*)(src + 16); v4u o; o.x = lo.x; o.y = lo.y; o.z = hi.x; o.w = hi.y;
                  *(GAS v4u*)(QDF + (jb * 32 + f) * 512 + lane * 8) = o; }
                { const int w = f >> 2, ks = f & 3;
                  *(GAS v4u*)(KEF + (jb * 32 + f) * 512 + lane * 8) = *(const LAS v4u*)(KET + (32 * w + r) * 144 + (16 * ks + 8 * hh) * 2); } }
        }
    }
    __syncthreads();
}

struct GlaSet { bf16x8 qd[4], ke[4], vt[4], am, vx; f32x4 dl[4]; };
constexpr int GS_PW = 32 * 68, GS_PB = 8 * GS_PW;
__device__ __forceinline__ bf16x8 pack_bf8(const f32x16& x, int s) {
    v4u p; p.x = pk2(x[8 * s], x[8 * s + 1]); p.y = pk2(x[8 * s + 2], x[8 * s + 3]); p.z = pk2(x[8 * s + 4], x[8 * s + 5]); p.w = pk2(x[8 * s + 6], x[8 * s + 7]);
    return __builtin_bit_cast(bf16x8, p);
}
__device__ __forceinline__ void gla_scan(Frame& F, const bf16* QDF, const bf16* KEF, const bf16* AMF, const bf16* VTF, const float* DL, float* OGLA) {
    LAS float* P = (LAS float*)(F.lds + RING_OFF);
    const int tid = F.tid, lane = F.lane, w = F.wave, r = lane & 31, hh = lane >> 5;
    for (int job = F.vcu; job < GH * 16; job += F.G) {
        const int h = job >> 4, sl = job & 15;
        const GAS char* qb = (const GAS char*)QDF + ((size_t)h * 32 + w * 4) * 1024;
        const GAS char* kb = (const GAS char*)KEF + ((size_t)h * 32 + w * 4) * 1024;
        const GAS char* ab = (const GAS char*)AMF + ((size_t)h * 8 + (w & 1) * 4 + (w >> 1)) * 1024;
        const GAS char* vb = (const GAS char*)VTF + (((size_t)h * 16 + sl) * 4) * 1024;
        const GAS char* db = (const GAS char*)DL + (h * 256 + 32 * w) * 4;
        GAS char* ob = (GAS char*)OGLA + ((size_t)h * GDV + sl * 32) * 4;
        unsigned lo16 = lane * 16, lod = hh * 16, loo = ((tid >> 5) * 4 * GVW + (tid & 31)) * 4;
        asm volatile("" : "+v"(lo16), "+v"(lod), "+v"(loo));
        f32x16 St = {};
        GlaSet A, B;
#define GLA_LOAD(X, n_) do { const size_t n__ = (size_t)(n_); \
            const GAS char* q__ = qb + n__ * 131072; const GAS char* k__ = kb + n__ * 131072; const GAS char* v__ = vb + n__ * 262144; const GAS char* d__ = db + n__ * 4096; \
            _Pragma("unroll") for (int i_ = 0; i_ < 4; ++i_) { X.qd[i_] = *(const GAS bf16x8*)(q__ + i_ * 1024 + lo16); X.ke[i_] = *(const GAS bf16x8*)(k__ + i_ * 1024 + lo16); \
                X.vt[i_] = *(const GAS bf16x8*)(v__ + i_ * 1024 + lo16); X.dl[i_] = *(const GAS f32x4*)(d__ + 32 * i_ + lod); } \
            X.am = *(const GAS bf16x8*)(ab + n__ * 32768 + lo16); X.vx = *(const GAS bf16x8*)(v__ + (w >> 1) * 1024 + lo16); } while (0)
#define GLA_COMPUTE(X) do { \
            const bf16x8 xs0 = pack_bf8(St, 0), xs1 = pack_bf8(St, 1); O0 = (f32x16){}; O1 = (f32x16){}; \
            O0 = __builtin_amdgcn_mfma_f32_32x32x16_bf16(X.qd[0], xs0, O0, 0, 0, 0); O1 = __builtin_amdgcn_mfma_f32_32x32x16_bf16(X.qd[2], xs0, O1, 0, 0, 0); \
            O0 = __builtin_amdgcn_mfma_f32_32x32x16_bf16(X.qd[1], xs1, O0, 0, 0, 0); O1 = __builtin_amdgcn_mfma_f32_32x32x16_bf16(X.qd[3], xs1, O1, 0, 0, 0); \
            if (w & 1) O1 = __builtin_amdgcn_mfma_f32_32x32x16_bf16(X.am, X.vx, O1, 0, 0, 0); else O0 = __builtin_amdgcn_mfma_f32_32x32x16_bf16(X.am, X.vx, O0, 0, 0, 0); \
            _Pragma("unroll") for (int g_ = 0; g_ < 4; ++g_) _Pragma("unroll") for (int i_ = 0; i_ < 4; ++i_) St[4 * g_ + i_] *= X.dl[g_][i_]; \
            _Pragma("unroll") for (int ks_ = 0; ks_ < 4; ++ks_) St = __builtin_amdgcn_mfma_f32_32x32x16_bf16(X.ke[ks_], X.vt[ks_], St, 0, 0, 0); } while (0)
#define GLA_WRITE(buf_) do { LAS float* Pw = P + (buf_) * GS_PB + w * GS_PW + r * 68 + 4 * hh; \
              _Pragma("unroll") for (int g_ = 0; g_ < 4; ++g_) { *(LAS f32x4*)(Pw + 8 * g_) = (f32x4){O0[4 * g_], O0[4 * g_ + 1], O0[4 * g_ + 2], O0[4 * g_ + 3]}; \
                  *(LAS f32x4*)(Pw + 32 + 8 * g_) = (f32x4){O1[4 * g_], O1[4 * g_ + 1], O1[4 * g_ + 2], O1[4 * g_ + 3]}; } } while (0)
#define GLA_REDUCE(n_) do { const LAS float* Pr = P + ((n_) & 1) * GS_PB + (tid & 31) * 68 + (tid >> 5) * 4; f32x4 s_ = *(const LAS f32x4*)Pr; \
              _Pragma("unroll") for (int w_ = 1; w_ < 8; ++w_) s_ += *(const LAS f32x4*)(Pr + w_ * GS_PW); \
              GAS char* o_ = ob + (size_t)(n_) * (GC * GVW * 4); *(GAS float*)(o_ + loo) = s_[0]; *(GAS float*)(o_ + GVW * 4 + loo) = s_[1]; *(GAS float*)(o_ + 2 * GVW * 4 + loo) = s_[2]; *(GAS float*)(o_ + 3 * GVW * 4 + loo) = s_[3]; } while (0)
#define GLA_BAR() do { asm volatile("s_waitcnt lgkmcnt(0)" ::: "memory"); __builtin_amdgcn_s_barrier(); asm volatile("" ::: "memory"); } while (0)
        f32x16 O0, O1;
        __syncthreads();
        GLA_LOAD(A, 0); GLA_LOAD(B, 1);
        GLA_COMPUTE(A); GLA_WRITE(0);
        for (int n = 0; n < NCH; n += 2) {
            if (n + 2 < NCH) GLA_LOAD(A, n + 2);
            GLA_COMPUTE(B);
            GLA_BAR(); GLA_REDUCE(n); GLA_WRITE(1);
            if (n + 3 < NCH) GLA_LOAD(B, n + 3);
            if (n + 2 < NCH) GLA_COMPUTE(A);
            GLA_BAR(); GLA_REDUCE(n + 1); if (n + 2 < NCH) GLA_WRITE(0);
        }
#undef GLA_COMPUTE
#undef GLA_BAR
#undef GLA_WRITE
#undef GLA_REDUCE
#undef GLA_LOAD
    }
    __syncthreads();
}
#endif

struct Args { const float* in[23]; float* out; unsigned char* ws; int ph_lo, ph_hi, li, pad; };
__global__ void __launch_bounds__(NWAVES * 64, 2) fwd(Args args) {
    extern __shared__ __attribute__((aligned(16))) unsigned char lds[];
    Frame F;
    F.lds = (LAS unsigned char*)lds;
    F.MISC = (volatile LAS unsigned*)(F.lds + MISC_OFF);
    F.tid = threadIdx.x; F.lane = F.tid & 63; F.wave = __builtin_amdgcn_readfirstlane(F.tid >> 6);
    F.G = gridDim.x; { const int bx = blockIdx.x; F.vcu = (F.G % 8 == 0) ? (bx % 8) * (F.G / 8) + bx / 8 : bx; }
    unsigned char* ws = args.ws;
    F.ctl = (gu32*)(ws + WS_CTL);
    for (int u = F.tid; u < (LDS_BYTES - LDSCTL_OFF) / 4; u += NWAVES * 64) ((LAS unsigned*)(F.lds + LDSCTL_OFF))[u] = 0u;
    __syncthreads();
    XcdBarrier bar; bar.bar = (unsigned*)(F.ctl + CW_BAR); bar.x = 0; bar.st = nullptr;
    if (ONE_LAUNCH) bar = xcd_barrier_post((unsigned*)(F.ctl + CW_BAR), F.MISC + 8);
#define GRID_BAR() do { if (ONE_LAUNCH) xcd_barrier(bar); } while (0)
    const int lo = args.ph_lo, hi = args.ph_hi;
#define IN(k) (lo <= (k) && (k) < hi)
#define PHASE_BEGIN() do { int t_ = threadIdx.x; asm volatile("" : "+v"(t_)); F.tid = t_; F.lane = t_ & 63; F.wave = __builtin_amdgcn_readfirstlane(t_ >> 6); } while (0)
#define BOTH(k) (IN(k) && IN((k) + 1))
#define REP(k) for (int rep_ = 0; rep_ < ((PROBE_REPEAT) == (k) ? 2 : 1); ++rep_)
#define gw (F.vcu * NWAVES + F.wave)
#define NGW (F.G * NWAVES)
    const float* x = args.in[0];
    bf16* W1GU = (bf16*)(ws + WS_W1GU); bf16* W1D = (bf16*)(ws + WS_W1D); bf16* W2GU = (bf16*)(ws + WS_W2GU); bf16* W2D = (bf16*)(ws + WS_W2D);
    bf16* WIN = (bf16*)(ws + WS_WIN); bf16* WSK = (bf16*)(ws + WS_WSK); bf16* WO = (bf16*)(ws + WS_WO); bf16* WPG = (bf16*)(ws + WS_WPG); bf16* WPP = (bf16*)(ws + WS_WPP);
    float* H = (float*)(ws + WS_H); bf16* Fb = (bf16*)(ws + WS_F); bf16* XN = (bf16*)(ws + WS_XN); bf16* MIX = (bf16*)(ws + WS_MIX); bf16* ACT = (bf16*)(ws + WS_ACT);
    bf16* Qb = (bf16*)(ws + WS_Q); bf16* Kb = (bf16*)(ws + WS_K); bf16* Vb = (bf16*)(ws + WS_V);
    bf16* GQ = (bf16*)(ws + WS_GQ); bf16* GK = (bf16*)(ws + WS_GK); bf16* GV = (bf16*)(ws + WS_GV); bf16* GR = (bf16*)(ws + WS_GR);
    float* CF = (float*)(ws + WS_MISC); float* FFGLR = (float*)(ws + WS_MISC + 1 * MiB); float* RSTDE = (float*)(ws + WS_WSK + 512 * 1024);
    float* OGLA = (float*)(ws + WS_OGLA); bf16* ERAW = (bf16*)(ws + WS_ERAW); bf16* PBF = (bf16*)(ws + WS_PBF);

    if (IN(0)) { PHASE_BEGIN(); REP(0) {
        convert_items(F, args.in, ws, 0, CV_B - CV_TAIL, gw, NGW);
        for (int m = gw; m < S; m += NGW) norm_row_to_bf16(x + (size_t)m * DM, args.in[2], XN + (size_t)m * DM, F.lane);
        { const float* p = args.in[1]; const int gt = F.vcu * NWAVES * 64 + F.tid, NT = F.G * NWAVES * 64;
          for (int i = gt; i < S * PLE / 4; i += NT) { const f32x4 v = ((const GAS f32x4*)p)[i]; v2u w; w.x = pk2(v.x, v.y); w.y = pk2(v.z, v.w); ((GAS v2u*)PBF)[i] = w; } }
        }
        if (BOTH(0)) GRID_BAR();
    }
    if (IN(1)) { PHASE_BEGIN(); REP(1) {
        pg8::Gemm g{XN, W1GU, S, 2 * DFF, DM}; pg8::StaticOrder So; So.init(S, 2 * DFF, F.G, (int)blockIdx.x);
        pg8::EpiSwiGLU E{ACT, DFF};
        pg8::gemm_phase<pg8::EpiSwiGLU, pg8::StaticOrder, PG_ALIGN, PG_SP2>(F.lds + RING_OFF, g, So, E);
        { constexpr int NFULL = ((S / 256) * (2 * DFF / 256)) % 256;
          if (F.G == 256 && (int)blockIdx.x >= NFULL) convert_items(F, args.in, ws, CV_B - CV_TAIL, CV_B, ((int)blockIdx.x - NFULL) * NWAVES + F.wave, (256 - NFULL) * NWAVES);
          else if (F.G != 256) convert_items(F, args.in, ws, CV_B - CV_TAIL, CV_B, gw, NGW); }
        }
        if (BOTH(1)) GRID_BAR();
    }
    if (IN(2)) { PHASE_BEGIN(); REP(2) {
        pg8::Gemm g{ACT, W1D, S, DM, DFF}; pg8::StaticOrder So; So.init(S, DM, F.G, (int)blockIdx.x);
        pg8::EpiBf16 E{Fb, DM};
        pg8::gemm_phase<pg8::EpiBf16, pg8::StaticOrder, PG_ALIGN, PG_SP2>(F.lds + RING_OFF, g, So, E);
        }
        if (BOTH(2)) GRID_BAR();
    }
    if (IN(3)) { PHASE_BEGIN(); REP(3) {
        for (int m = gw; m < S; m += NGW) resid_row<true>(Fb + (size_t)m * DM, x + (size_t)m * DM, 0.5f, args.in[6], args.in[7], H + (size_t)m * DM, XN + (size_t)m * DM, F.lane);
        }
        if (BOTH(3)) GRID_BAR();
    }
    if (IN(4)) { PHASE_BEGIN(); REP(4) {
        pg8::Gemm g{XN, WIN, S, NWIN, DM}; pg8::StaticOrder So; So.init(S, NWIN, F.G, (int)blockIdx.x);
        pg8::EpiWin E{Qb, S};
        pg8::gemm_phase<pg8::EpiWin, pg8::StaticOrder, PG_ALIGN, PG_SP2>(F.lds + RING_OFF, g, So, E);
        skinny_gemm(F, XN, WSK, FFGLR);
        }
        if (BOTH(4)) GRID_BAR();
    }
    if (IN(5)) { PHASE_BEGIN(); REP(5) {
        fox_prep(F, FFGLR, args.in[9], CF);
#if !SIMPLE_ATTN
        fox_norms(F, Qb, Kb, F.ctl + CW_NRM);
#endif
#if !SIMPLE_GLA
        gla_prep(F, GQ, GK, GV, FFGLR, args.in[10], args.in[11], (bf16*)(ws + WS_QDEC), (bf16*)(ws + WS_KTE), (bf16*)(ws + WS_AM), (bf16*)(ws + WS_VT), (float*)(ws + WS_MISC + 2560 * 1024));
#endif
        }
        if (BOTH(5)) GRID_BAR();
    }
    if (IN(6)) { PHASE_BEGIN(); REP(6) {
#if SIMPLE_GLA
        gla_simple(F, GQ, GK, GV, FFGLR, args.in[10], args.in[11], OGLA);
#else
        if (F.vcu < NSCAN) {
        gla_scan(F, (const bf16*)(ws + WS_QDEC), (const bf16*)(ws + WS_KTE), (const bf16*)(ws + WS_AM), (const bf16*)(ws + WS_VT), (const float*)(ws + WS_MISC + 2560 * 1024), OGLA);
#if PROBE_REPEAT == 60
        gla_scan(F, (const bf16*)(ws + WS_QDEC), (const bf16*)(ws + WS_KTE), (const bf16*)(ws + WS_AM), (const bf16*)(ws + WS_VT), (const float*)(ws + WS_MISC + 2560 * 1024), OGLA);
#endif
        }
#endif
#if SIMPLE_ATTN
        attn_simple(F, Qb, Kb, Vb, CF, MIX);
#else
        if (F.vcu >= NSCAN || SIMPLE_GLA) {
            fox_phase(F, (char*)lds + RING_OFF, Qb, Kb, Vb, CF, (const gu32*)(F.ctl + CW_NRM), MIX);
            __syncthreads();
            convert_items(F, args.in, ws, CV_B, CV_D2 - CV_TAIL, (F.vcu - NSCAN) * NWAVES + F.wave, (F.G - NSCAN) * NWAVES);
        }
#endif
        }
        if (BOTH(6)) GRID_BAR();
    }
    if (IN(7)) { PHASE_BEGIN(); REP(7) {
        gla_post(F, OGLA, GR, args.in[12], MIX);
        }
        if (BOTH(7)) GRID_BAR();
    }
    if (IN(8)) { PHASE_BEGIN(); REP(8) {
        pg8::Gemm g{MIX, WO, S, DM, DM}; pg8::StaticOrder So; So.init(S, DM, F.G, (int)blockIdx.x);
        pg8::EpiBf16 E{Fb, DM};
        pg8::gemm_phase<pg8::EpiBf16, pg8::StaticOrder, PG_ALIGN, PG_SP2>(F.lds + RING_OFF, g, So, E);
        }
        if (BOTH(8)) GRID_BAR();
    }
    if (IN(9)) { PHASE_BEGIN(); REP(9) {
        for (int m = gw; m < S; m += NGW) resid_row<true>(Fb + (size_t)m * DM, H + (size_t)m * DM, 1.0f, args.in[14], args.in[15], H + (size_t)m * DM, XN + (size_t)m * DM, F.lane);
        }
        if (BOTH(9)) GRID_BAR();
    }
    if (IN(10)) { PHASE_BEGIN(); REP(10) {
        pg8::Gemm g{XN, W2GU, S, 2 * DFF, DM}; pg8::StaticOrder So; So.init(S, 2 * DFF, F.G, (int)blockIdx.x);
        pg8::EpiSwiGLU E{ACT, DFF};
        pg8::gemm_phase<pg8::EpiSwiGLU, pg8::StaticOrder, PG_ALIGN, PG_SP2>(F.lds + RING_OFF, g, So, E);
        { constexpr int NFULL = ((S / 256) * (2 * DFF / 256)) % 256;
          if (F.G == 256 && (int)blockIdx.x >= NFULL) convert_items(F, args.in, ws, CV_D2 - CV_TAIL, CV_D2, ((int)blockIdx.x - NFULL) * NWAVES + F.wave, (256 - NFULL) * NWAVES);
          else if (F.G != 256) convert_items(F, args.in, ws, CV_D2 - CV_TAIL, CV_D2, gw, NGW); }
        }
        if (BOTH(10)) GRID_BAR();
    }
    if (IN(11)) { PHASE_BEGIN(); REP(11) {
        { pg8::Gemm g{ACT, W2D, S, DM, DFF}; pg8::StaticOrder So; So.init(S, DM, F.G, (int)blockIdx.x);
          pg8::EpiBf16 E{Fb, DM};
          pg8::gemm_phase<pg8::EpiBf16, pg8::StaticOrder, PG_ALIGN, PG_SP2>(F.lds + RING_OFF, g, So, E); }
        { pg8::Gemm g{PBF, WPP, S, DM, PLE}; pg8::StaticOrder So; So.init(S, DM, F.G, (int)blockIdx.x);
          pg8::EpiBf16 E{ERAW, DM};
          pg8::gemm_phase<pg8::EpiBf16, pg8::StaticOrder, PG_ALIGN, PG_SP2>(F.lds + RING_OFF, g, So, E); }
        }
        if (BOTH(11)) GRID_BAR();
    }
    if (IN(12)) { PHASE_BEGIN(); REP(12) {
        for (int m = gw; m < S; m += NGW) {
            resid_row<false>(Fb + (size_t)m * DM, H + (size_t)m * DM, 0.5f, args.in[19], args.in[19], H + (size_t)m * DM, XN + (size_t)m * DM, F.lane);
            const GAS v4u* er = (const GAS v4u*)(ERAW + (size_t)m * DM) + F.lane; float s = 0.f;
#pragma unroll
            for (int j = 0; j < 8; ++j) { const v4u v = er[64 * j]; s += (bflo(v.x) * bflo(v.x) + bfhi(v.x) * bfhi(v.x)) + (bflo(v.y) * bflo(v.y) + bfhi(v.y) * bfhi(v.y)) + (bflo(v.z) * bflo(v.z) + bfhi(v.z) * bfhi(v.z)) + (bflo(v.w) * bflo(v.w) + bfhi(v.w) * bfhi(v.w)); }
            s = wave_sum(s); if (F.lane == 0) RSTDE[m] = 1.f / sqrtf(s * (1.f / DM) + EPS);
        }
        }
        if (BOTH(12)) GRID_BAR();
    }
    if (IN(13)) { PHASE_BEGIN(); REP(13) {
        pg8::Gemm g{XN, WPG, S, DM, DM}; pg8::StaticOrder So; So.init(S, DM, F.G, (int)blockIdx.x);
        pg8::EpiPleGate E{H, ERAW, RSTDE, args.in[21], args.out, DM};
        pg8::gemm_phase<pg8::EpiPleGate, pg8::StaticOrder, PG_ALIGN, PG_SP2>(F.lds + RING_OFF, g, So, E);
        }
    }
#undef IN
#undef gw
#undef NGW
#undef PHASE_BEGIN
#undef BOTH
#undef GRID_BAR
}

extern "C" void kernel_launch(void* const* d_in, const int* in_sizes, int n_in, void* d_out, int out_size, void* d_ws, size_t ws_size, hipStream_t stream) {
    static int grid = 0;
    if (grid == 0) {
        if (n_in != 23 || in_sizes[0] != S * DM || out_size != S * DM || ws_size < WS_END) {
            fprintf(stderr, "kernel_launch: built for 23 inputs, x/out of %d floats, >= %zu bytes of workspace; got n_in %d, in0 %d, out %d, ws %zu; nothing launched\n", S * DM, (size_t)WS_END, n_in, n_in > 0 ? in_sizes[0] : -1, out_size, ws_size);
            grid = -1; return; }
        int dev = 0, cus = 0, per_cu = 0;
        if (hipGetDevice(&dev) != hipSuccess || hipDeviceGetAttribute(&cus, hipDeviceAttributeMultiprocessorCount, dev) != hipSuccess) { fprintf(stderr, "kernel_launch: device query failed\n"); grid = -1; return; }
        if (hipFuncSetAttribute((const void*)fwd, hipFuncAttributeMaxDynamicSharedMemorySize, LDS_BYTES) != hipSuccess) { fprintf(stderr, "kernel_launch: hipFuncSetAttribute failed\n"); grid = -1; return; }
        if (hipOccupancyMaxActiveBlocksPerMultiprocessor(&per_cu, (const void*)fwd, NWAVES * 64, LDS_BYTES) != hipSuccess || per_cu < 1)
            fprintf(stderr, "kernel_launch: note: occupancy query reports %d workgroups per CU\n", per_cu);
        (void)hipGetLastError();
        grid = cus;
    }
    if (grid < 0) return;
    if (hipMemsetAsync((char*)d_ws + WS_CTL, 0, CTL_ZERO_BYTES, stream) != hipSuccess) { fprintf(stderr, "kernel_launch: hipMemsetAsync failed\n"); return; }
    Args a{};
    for (int i = 0; i < 23; ++i) a.in[i] = (const float*)d_in[i];
    a.out = (float*)d_out; a.ws = (unsigned char*)d_ws;
    if (ONE_LAUNCH) {
        a.ph_lo = 0; a.ph_hi = N_PHASES; a.li = 0;
        hipLaunchKernelGGL(fwd, dim3(grid), dim3(NWAVES * 64), LDS_BYTES, stream, a);
    } else {
        for (int li = 0; li < N_PHASES; ++li) { a.ph_lo = li; a.ph_hi = li + 1; a.li = li;
            hipLaunchKernelGGL(fwd, dim3(grid), dim3(NWAVES * 64), LDS_BYTES, stream, a); }
    }
    const hipError_t le = hipPeekAtLastError();
    if (le != hipSuccess) fprintf(stderr, "kernel_launch: launch failed: %s\n", hipGetErrorName(le));
}
```

```cpp
#include <hip/hip_runtime.h>
#include <cstdio>
#include <cstdint>
namespace pg8 {
#define PG8_LAS __attribute__((address_space(3)))
typedef unsigned short bf16_t;
typedef short bf16x8 __attribute__((ext_vector_type(8)));
typedef float f32x4 __attribute__((ext_vector_type(4)));
typedef unsigned u32x4 __attribute__((ext_vector_type(4)));
constexpr int BM = 256, BK = 64, HALF = 128, HTB = HALF * BK * 2  , STAGE_BYTES = 8 * HTB, NXCD = 8, WGM = 8;

__host__ __device__ __forceinline__ int lds_byte(int r, int c) { const int st = (r >> 4) * 2 + (c >> 5), rr = r & 15, cc = c & 31, ob = rr * 64 + cc * 2; return st * 1024 + (ob ^ (((ob >> 9) & 1) << 5)); }
__host__ __device__ __forceinline__ void stage_rc(int b, int& R, int& C) { const int st = b / 1024, sb = b % 1024, swz = sb ^ (((sb >> 9) & 1) << 5); R = (st >> 1) * 16 + swz / 64; C = (st & 1) * 32 + (swz % 64) / 2; }
__host__ __device__ __forceinline__ int perm32(int rho) { const int n = rho >> 4, i = rho & 15; return 8 * (i >> 2) + 4 * n + (i & 3); }

struct Unit { int pm, pn; };
struct Gemm { const bf16_t* A; const bf16_t* Bt; int M, N, K; };

struct StaticOrder {
    int nM, nN, nwg, G, c;
    __host__ __device__ void init(int M, int N, int G_, int c_) { nM = M / BM; nN = N / BM; nwg = nM * nN; G = G_; c = c_; }
    __host__ __device__ bool next(int i, Unit& u) const {
        const long L = (long)i * G + c; if (L >= nwg) return false;
        int wgid = (int)L; { const int q = nwg / NXCD, r = nwg % NXCD, xcd = wgid % NXCD, off = wgid / NXCD; wgid = (xcd < r ? xcd * (q + 1) : r * (q + 1) + (xcd - r) * q) + off; }
        const int nig = WGM * nN, gid = wgid / nig, fm = gid * WGM, gsz = (nM - fm) < WGM ? (nM - fm) : WGM;
        u.pm = fm + ((wgid % nig) % gsz); u.pn = (wgid % nig) / gsz; return true;
    }
    __device__ __forceinline__ void a_ready(const Unit&) const {}
    __device__ __forceinline__ void done(const Unit&) const {}
};

__device__ __forceinline__ unsigned cvt_pk_bf16(float lo, float hi) { unsigned r; asm volatile("v_cvt_pk_bf16_f32 %0, %1, %2" : "=v"(r) : "v"(lo), "v"(hi)); return r; }
typedef float f32x2 __attribute__((ext_vector_type(2)));

struct EpiF32 {
    static constexpr bool PERM = false, AFTER_DRAIN = false;
    float* C; int ldc;
    __device__ __forceinline__ void operator()(const f32x4 (&acc)[2][2][4][2], const Unit& u, int wr, int wc, int fr, int fq) const {
        const int row0 = u.pm * BM + wr * 64 + fr, col0 = u.pn * BM + wc * 32 + 4 * fq;
#pragma unroll
        for (int ai = 0; ai < 2; ++ai)
#pragma unroll
            for (int m = 0; m < 4; ++m) { float* rowp = C + (size_t)(row0 + ai * HALF + m * 16) * ldc + col0;
#pragma unroll
                for (int bj = 0; bj < 2; ++bj)
#pragma unroll
                    for (int n = 0; n < 2; ++n) *(f32x4*)(rowp + bj * HALF + n * 16) = acc[ai][bj][m][n]; }
    }
};
struct EpiBf16 {
    static constexpr bool PERM = true, AFTER_DRAIN = false;
    bf16_t* O; int ldc;
    __device__ __forceinline__ void operator()(const f32x4 (&acc)[2][2][4][2], const Unit& u, int wr, int wc, int fr, int fq) const {
        const int row0 = u.pm * BM + wr * 64 + fr, col0 = u.pn * BM + wc * 32 + 8 * fq;
#pragma unroll
        for (int ai = 0; ai < 2; ++ai)
#pragma unroll
            for (int m = 0; m < 4; ++m) { bf16_t* rowp = O + (size_t)(row0 + ai * HALF + m * 16) * ldc + col0;
#pragma unroll
                for (int bj = 0; bj < 2; ++bj) { const f32x4 v0 = acc[ai][bj][m][0], v1 = acc[ai][bj][m][1];
                    u32x4 w; w.x = cvt_pk_bf16(v0[0], v0[1]); w.y = cvt_pk_bf16(v0[2], v0[3]); w.z = cvt_pk_bf16(v1[0], v1[1]); w.w = cvt_pk_bf16(v1[2], v1[3]);
                    *(u32x4*)(rowp + bj * HALF) = w; } }
    }
};
struct EpiBf16Part {
    static constexpr bool PERM = true, AFTER_DRAIN = false;
    bf16_t* O; int ldc; float* PART;
    __device__ __forceinline__ void operator()(const f32x4 (&acc)[2][2][4][2], const Unit& u, int wr, int wc, int fr, int fq) const {
        const int row0 = u.pm * BM + wr * 64 + fr, col0 = u.pn * BM + wc * 32 + 8 * fq;
#pragma unroll
        for (int ai = 0; ai < 2; ++ai)
#pragma unroll
            for (int m = 0; m < 4; ++m) { const int row = row0 + ai * HALF + m * 16; bf16_t* rowp = O + (size_t)row * ldc + col0; float ss = 0.f;
#pragma unroll
                for (int bj = 0; bj < 2; ++bj) { const f32x4 v0 = acc[ai][bj][m][0], v1 = acc[ai][bj][m][1];
                    ss += (v0[0] * v0[0] + v0[1] * v0[1]) + (v0[2] * v0[2] + v0[3] * v0[3]) + (v1[0] * v1[0] + v1[1] * v1[1]) + (v1[2] * v1[2] + v1[3] * v1[3]);
                    u32x4 w; w.x = cvt_pk_bf16(v0[0], v0[1]); w.y = cvt_pk_bf16(v0[2], v0[3]); w.z = cvt_pk_bf16(v1[0], v1[1]); w.w = cvt_pk_bf16(v1[2], v1[3]);
                    *(u32x4*)(rowp + bj * HALF) = w; }
                ss += __shfl_xor(ss, 16); ss += __shfl_xor(ss, 32);
                if (fq == 0) PART[(size_t)row * 64 + u.pn * 4 + wc] = ss; }
    }
};
__device__ __forceinline__ float silu_f(float g) { return g * __builtin_amdgcn_rcpf(1.0f + __builtin_amdgcn_exp2f(-1.4426950408889634f * g)); }
__device__ __forceinline__ float sigmoid_f(float g) { return __builtin_amdgcn_rcpf(1.0f + __builtin_amdgcn_exp2f(-1.4426950408889634f * g)); }
struct EpiSwiGLU {
    static constexpr bool PERM = true, AFTER_DRAIN = false;
    bf16_t* O; int ldc;
    __device__ __forceinline__ void operator()(const f32x4 (&acc)[2][2][4][2], const Unit& u, int wr, int wc, int fr, int fq) const {
        const int row0 = u.pm * BM + wr * 64 + fr, col0 = u.pn * HALF + wc * 32 + 8 * fq;
#pragma unroll
        for (int ai = 0; ai < 2; ++ai)
#pragma unroll
            for (int m = 0; m < 4; ++m) { bf16_t* rowp = O + (size_t)(row0 + ai * HALF + m * 16) * ldc + col0;
                const f32x4 g0 = acc[ai][0][m][0], g1 = acc[ai][0][m][1], u0 = acc[ai][1][m][0], u1 = acc[ai][1][m][1];
                u32x4 w; w.x = cvt_pk_bf16(silu_f(g0[0]) * u0[0], silu_f(g0[1]) * u0[1]); w.y = cvt_pk_bf16(silu_f(g0[2]) * u0[2], silu_f(g0[3]) * u0[3]);
                w.z = cvt_pk_bf16(silu_f(g1[0]) * u1[0], silu_f(g1[1]) * u1[1]); w.w = cvt_pk_bf16(silu_f(g1[2]) * u1[2], silu_f(g1[3]) * u1[3]);
                *(u32x4*)rowp = w; }
    }
};
struct EpiWin {
    static constexpr bool PERM = true, AFTER_DRAIN = false;
    bf16_t* R; int S;
    __device__ __forceinline__ void operator()(const f32x4 (&acc)[2][2][4][2], const Unit& u, int wr, int wc, int fr, int fq) const {
        const int row0 = u.pm * BM + wr * 64 + fr, pn = u.pn, cin = wc * 32 + 8 * fq;
        int ldc; size_t off0, off1;
        if (pn < 24) { ldc = 128; off0 = (size_t)(pn >> 3) * (16u << 20) + (size_t)(2 * (pn & 7)) * S * 128 + cin; off1 = off0 + (size_t)S * 128; }
        else { size_t tb; int c0;
            if (pn < 28) { tb = (size_t)48 << 20; ldc = 1024; c0 = (pn - 24) * 256; } else if (pn < 32) { tb = (size_t)56 << 20; ldc = 1024; c0 = (pn - 28) * 256; }
            else if (pn < 40) { tb = (size_t)64 << 20; ldc = 2048; c0 = (pn - 32) * 256; } else { tb = (size_t)80 << 20; ldc = 2048; c0 = (pn - 40) * 256; }
            off0 = tb + (size_t)(c0 + cin); off1 = off0 + HALF; }
#pragma unroll
        for (int ai = 0; ai < 2; ++ai)
#pragma unroll
            for (int m = 0; m < 4; ++m) { const size_t ro = (size_t)(row0 + ai * HALF + m * 16) * ldc;
#pragma unroll
                for (int bj = 0; bj < 2; ++bj) { const f32x4 v0 = acc[ai][bj][m][0], v1 = acc[ai][bj][m][1];
                    u32x4 w; w.x = cvt_pk_bf16(v0[0], v0[1]); w.y = cvt_pk_bf16(v0[2], v0[3]); w.z = cvt_pk_bf16(v1[0], v1[1]); w.w = cvt_pk_bf16(v1[2], v1[3]);
                    *(u32x4*)(R + ro + (bj ? off1 : off0)) = w; } }
    }
};
struct EpiPleGate {
    static constexpr bool PERM = false, AFTER_DRAIN = false;
    const bf16_t* H; const bf16_t* ERAW; const float* rstd_e; const float* g; float* out; int ldc;
    __device__ __forceinline__ void operator()(const f32x4 (&acc)[2][2][4][2], const Unit& u, int wr, int wc, int fr, int fq) const {
        const int row0 = u.pm * BM + wr * 64 + fr, col0 = u.pn * BM + wc * 32 + 4 * fq;
        f32x4 gv[2][2];
#pragma unroll
        for (int bj = 0; bj < 2; ++bj)
#pragma unroll
            for (int n = 0; n < 2; ++n) gv[bj][n] = *(const f32x4*)(g + col0 + bj * HALF + n * 16);
#pragma unroll
        for (int ai = 0; ai < 2; ++ai)
#pragma unroll
            for (int m = 0; m < 4; ++m) { const int row = row0 + ai * HALF + m * 16; const size_t ro = (size_t)row * ldc + col0; const float rs = rstd_e[row];
#pragma unroll
                for (int bj = 0; bj < 2; ++bj)
#pragma unroll
                    for (int n = 0; n < 2; ++n) { const size_t o = ro + bj * HALF + n * 16; const f32x4 a = acc[ai][bj][m][n];
                        const unsigned long long hw = *(const unsigned long long*)(H + o); const f32x4 hv = {__builtin_bit_cast(float, (unsigned)hw << 16), __builtin_bit_cast(float, (unsigned)hw & 0xffff0000u), __builtin_bit_cast(float, (unsigned)(hw >> 32) << 16), __builtin_bit_cast(float, (unsigned)(hw >> 32) & 0xffff0000u)};
                        const unsigned long long ew = __builtin_nontemporal_load((const unsigned long long*)(ERAW + o));
                        const f32x4 ev = {__builtin_bit_cast(float, (unsigned)ew << 16), __builtin_bit_cast(float, (unsigned)ew & 0xffff0000u), __builtin_bit_cast(float, (unsigned)(ew >> 32) << 16), __builtin_bit_cast(float, (unsigned)(ew >> 32) & 0xffff0000u)}; f32x4 r;
#pragma unroll
                        for (int j = 0; j < 4; ++j) r[j] = hv[j] + ev[j] * rs * gv[bj][n][j] * sigmoid_f(a[j]);
                        __builtin_nontemporal_store(r, (f32x4*)(out + o)); }
                asm volatile("" ::: "memory"); }
    }
};
template <class Epi, class Sched, bool ALIGN_EPI = false, bool SP2 = false>
__device__ __forceinline__ void gemm_phase(PG8_LAS unsigned char* lds, const Gemm g, const Sched& S, const Epi& E) {
    int tid_ = threadIdx.x; asm volatile("" : "+v"(tid_));
    const int tid = tid_, wid = __builtin_amdgcn_readfirstlane(tid >> 6), lane = tid & 63, wr = wid >> 2, wc = wid & 3, fr = lane & 15, fq = lane >> 4;
    const int K = g.K, nt = K / BK;
    unsigned voffA[2], voffB[2];
#pragma unroll
    for (int i = 0; i < 2; ++i) { int R, C; stage_rc(tid * 16 + i * 8192, R, C); const int Rb = Epi::PERM ? ((R & ~31) + perm32(R & 31)) : R;
        voffA[i] = (unsigned)(R * K + C) * 2u; voffB[i] = (unsigned)(Rb * K + C) * 2u; }
    const size_t kstep = (size_t)(BK * 2);
    const size_t hstep = (size_t)HALF * K * 2;
    const size_t tstep = 2 * hstep;
    const unsigned ldsw = (unsigned)wid * 1024u;
    const int aoff = lds_byte(wr * 64 + fr, fq * 8), boff = lds_byte(wc * 32 + fr, fq * 8);
#define PG8_SA(b, h) (((b) * 2 + (h)) * HTB)
#define PG8_SB(b, h) ((4 + (b) * 2 + (h)) * HTB)
#define PG8_STAGE(bufoff, gbase, voff) do { _Pragma("unroll") for (int _i = 0; _i < 2; ++_i) \
        __builtin_amdgcn_global_load_lds((const unsigned*)((const char*)(gbase) + (voff)[_i]), (PG8_LAS unsigned*)(lds + (bufoff) + ldsw + _i * 8192), 16, 0, 0); } while (0)
#define PG8_LDA(dst, b, h) do { _Pragma("unroll") for (int m = 0; m < 4; ++m) _Pragma("unroll") for (int k = 0; k < 2; ++k) dst[m][k] = *(const PG8_LAS bf16x8*)(lds + PG8_SA(b, h) + aoff + m * 2048 + k * 1024); } while (0)
#define PG8_LDB(dst, b, h) do { _Pragma("unroll") for (int n = 0; n < 2; ++n) _Pragma("unroll") for (int k = 0; k < 2; ++k) dst[n][k] = *(const PG8_LAS bf16x8*)(lds + PG8_SB(b, h) + boff + n * 2048 + k * 1024); } while (0)
#define PG8_MMA(ai, bj, At, Bt) do { __builtin_amdgcn_s_setprio(1); _Pragma("unroll") for (int m = 0; m < 4; ++m) _Pragma("unroll") for (int n = 0; n < 2; ++n) _Pragma("unroll") for (int k = 0; k < 2; ++k) \
        acc[ai][bj][m][n] = __builtin_amdgcn_mfma_f32_16x16x32_bf16(Bt[n][k], At[m][k], acc[ai][bj][m][n], 0, 0, 0); __builtin_amdgcn_s_setprio(0); } while (0)
#define PG8_WAIT_V(n) asm volatile("s_waitcnt vmcnt(" #n ")" ::: "memory")
#define PG8_WAIT_L(n) asm volatile("s_waitcnt lgkmcnt(" #n ")" ::: "memory")
#define PG8_BAR __builtin_amdgcn_s_barrier()
#define PG8_SCHED __builtin_amdgcn_sched_barrier(0)
    Unit cur, nxt; int ui = 0;
    if (!S.next(0, cur)) return;
    f32x4 acc[2][2][4][2];
#pragma unroll
    for (int a = 0; a < 2; ++a)
#pragma unroll
        for (int b = 0; b < 2; ++b)
#pragma unroll
            for (int m = 0; m < 4; ++m)
#pragma unroll
                for (int n = 0; n < 2; ++n) acc[a][b][m][n] = (f32x4){0.f, 0.f, 0.f, 0.f};
    bf16x8 At[4][2], B0[2][2], B1[2][2];
    const char* cA = (const char*)g.A + (size_t)cur.pm * tstep; const char* cB = (const char*)g.Bt + (size_t)cur.pn * tstep;
    S.a_ready(cur);
    if constexpr (SP2) {
        PG8_STAGE(PG8_SB(0, 0), cB, voffB); PG8_STAGE(PG8_SB(0, 1), cB + hstep, voffB); PG8_STAGE(PG8_SA(0, 0), cA, voffA); PG8_STAGE(PG8_SA(0, 1), cA + hstep, voffA);
        if (wr == 1) PG8_BAR;
        PG8_WAIT_V(2); PG8_BAR;
        PG8_STAGE(PG8_SB(1, 0), cB + kstep, voffB); PG8_STAGE(PG8_SA(1, 0), cA + kstep, voffA); PG8_STAGE(PG8_SB(1, 1), cB + hstep + kstep, voffB);
        PG8_WAIT_V(6); PG8_BAR;
    } else {
        PG8_STAGE(PG8_SB(0, 0), cB, voffB); PG8_STAGE(PG8_SA(0, 0), cA, voffA); PG8_STAGE(PG8_SB(0, 1), cB + hstep, voffB); PG8_STAGE(PG8_SA(0, 1), cA + hstep, voffA);
        if (wr == 1) PG8_BAR;
        PG8_WAIT_V(4); PG8_BAR;
        PG8_STAGE(PG8_SB(1, 0), cB + kstep, voffB); PG8_STAGE(PG8_SA(1, 0), cA + kstep, voffA); PG8_STAGE(PG8_SB(1, 1), cB + hstep + kstep, voffB);
        PG8_WAIT_V(6); PG8_BAR;
    }
    for (;;) {
        const bool has_next = S.next(ui + 1, nxt);
        const char* nA = has_next ? (const char*)g.A + (size_t)nxt.pm * tstep : cA; const char* nB = has_next ? (const char*)g.Bt + (size_t)nxt.pn * tstep : cB;
        for (int t = 0; t < nt; t += 2) {
            const bool last = (t == nt - 2);
            const char* a1 = cA + (size_t)(t + 1) * kstep;
            const char* a2 = last ? nA : cA + (size_t)(t + 2) * kstep; const char* b2 = last ? nB : cB + (size_t)(t + 2) * kstep;
            const char* a3 = a2 + kstep; const char* b3 = b2 + kstep;
            if (last && has_next) S.a_ready(nxt);
            if constexpr (SP2) {
            PG8_LDB(B0, 0, 0); PG8_LDB(B1, 0, 1); PG8_SCHED; PG8_LDA(At, 0, 0); PG8_STAGE(PG8_SA(1, 1), a1 + hstep, voffA);
            PG8_WAIT_V(8); PG8_WAIT_L(0); PG8_BAR; PG8_MMA(0, 0, At, B0); PG8_MMA(0, 1, At, B1); PG8_BAR; PG8_SCHED;
            PG8_LDA(At, 0, 1); PG8_STAGE(PG8_SB(0, 0), b2, voffB); PG8_STAGE(PG8_SB(0, 1), b2 + hstep, voffB); PG8_STAGE(PG8_SA(0, 0), a2, voffA);
            PG8_WAIT_V(8); PG8_WAIT_L(0); PG8_BAR; PG8_MMA(1, 0, At, B0); PG8_MMA(1, 1, At, B1); PG8_BAR; PG8_SCHED;
            PG8_LDB(B0, 1, 0); PG8_LDB(B1, 1, 1); PG8_SCHED; PG8_LDA(At, 1, 0); PG8_STAGE(PG8_SA(0, 1), a2 + hstep, voffA);
            PG8_WAIT_V(8); PG8_WAIT_L(0); PG8_BAR; PG8_MMA(0, 0, At, B0); PG8_MMA(0, 1, At, B1); PG8_BAR; PG8_SCHED;
            PG8_LDA(At, 1, 1); PG8_STAGE(PG8_SB(1, 0), b3, voffB); PG8_STAGE(PG8_SB(1, 1), b3 + hstep, voffB); PG8_STAGE(PG8_SA(1, 0), a3, voffA);
            PG8_WAIT_V(8); PG8_WAIT_L(0); PG8_BAR; PG8_MMA(1, 0, At, B0); PG8_MMA(1, 1, At, B1); PG8_BAR; PG8_SCHED;
            } else {
            PG8_LDB(B0, 0, 0); PG8_SCHED; PG8_LDA(At, 0, 0); PG8_STAGE(PG8_SA(1, 1), a1 + hstep, voffA);
            PG8_WAIT_L(8); PG8_BAR; PG8_WAIT_L(0); PG8_MMA(0, 0, At, B0); PG8_BAR; PG8_SCHED;
            PG8_LDB(B1, 0, 1); PG8_STAGE(PG8_SB(0, 0), b2, voffB);
            PG8_BAR; PG8_WAIT_L(0); PG8_MMA(0, 1, At, B1); PG8_BAR;
            PG8_LDA(At, 0, 1); PG8_STAGE(PG8_SA(0, 0), a2, voffA);
            PG8_BAR; PG8_WAIT_L(0); PG8_MMA(1, 0, At, B0); PG8_BAR; PG8_SCHED;
            PG8_STAGE(PG8_SB(0, 1), b2 + hstep, voffB);
            PG8_WAIT_V(6); PG8_BAR; PG8_MMA(1, 1, At, B1); PG8_BAR;
            PG8_LDB(B0, 1, 0); PG8_SCHED; PG8_LDA(At, 1, 0); PG8_STAGE(PG8_SA(0, 1), a2 + hstep, voffA);
            PG8_WAIT_L(8); PG8_BAR; PG8_WAIT_L(0); PG8_MMA(0, 0, At, B0); PG8_BAR; PG8_SCHED;
            PG8_LDB(B1, 1, 1); PG8_STAGE(PG8_SB(1, 0), b3, voffB);
            PG8_BAR; PG8_WAIT_L(0); PG8_MMA(0, 1, At, B1); PG8_BAR;
            PG8_LDA(At, 1, 1); PG8_STAGE(PG8_SA(1, 0), a3, voffA);
            PG8_BAR; PG8_WAIT_L(0); PG8_MMA(1, 0, At, B0); PG8_BAR; PG8_SCHED;
            PG8_STAGE(PG8_SB(1, 1), b3 + hstep, voffB);
            PG8_WAIT_V(6); PG8_BAR; PG8_MMA(1, 1, At, B1); PG8_BAR;
            }
        }
        if constexpr (ALIGN_EPI) { if (wr == 0) PG8_BAR; }
        if constexpr (!Epi::AFTER_DRAIN) { E(acc, cur, wr, wc, fr, fq); S.done(cur); }
        if (!has_next) break;
#pragma unroll
        for (int a = 0; a < 2; ++a)
#pragma unroll
            for (int b = 0; b < 2; ++b)
#pragma unroll
                for (int m = 0; m < 4; ++m)
#pragma unroll
                    for (int n = 0; n < 2; ++n) acc[a][b][m][n] = (f32x4){0.f, 0.f, 0.f, 0.f};
        cur = nxt; cA = nA; cB = nB; ++ui;
        if constexpr (ALIGN_EPI) { if (wr == 1) PG8_BAR; }
    }
    PG8_WAIT_V(0);
    if constexpr (!ALIGN_EPI) { if (wr == 0) PG8_BAR; }
    PG8_BAR;
    if constexpr (Epi::AFTER_DRAIN) { E.fused(acc, cur, wr, wc, fr, fq, lds, wid, lane); S.done(cur); }
#undef PG8_SA
#undef PG8_SB
#undef PG8_STAGE
#undef PG8_LDA
#undef PG8_LDB
#undef PG8_MMA
#undef PG8_WAIT_V
#undef PG8_WAIT_L
#undef PG8_BAR
#undef PG8_SCHED
}
}

constexpr int NWAVES = 8;
#ifndef MK_N_LAUNCHES
#define MK_N_LAUNCHES 1
#endif
#ifndef SIMPLE_ATTN
#define SIMPLE_ATTN 0
#endif
#ifndef SIMPLE_GLA
#define SIMPLE_GLA 0
#endif
#ifndef PG_SP2
#define PG_SP2 true
#endif
#ifndef PG_ALIGN
#define PG_ALIGN true
#endif
#ifndef PROBE_AMP
#define PROBE_AMP -1
#endif
#ifndef PROBE_REPEAT
#define PROBE_REPEAT -1
#endif
constexpr int N_PHASES = 14;
constexpr bool ONE_LAUNCH = (MK_N_LAUNCHES == 1);

constexpr int S = 8192, DM = 4096, DFF = 11008, PLE = 256;
constexpr int FH = 16, FD = 128, FW = 2048;
constexpr int GH = 4, GDK = 256, GDV = 512, GKW = 1024, GVW = 2048, GRANK = 16, GC = 64, NCH = S / GC;
constexpr int WIN_COLS = 12320, NWIN = 12288;
constexpr float EPS = 1e-6f;
constexpr float FOX_SCALE = 0.08838834764831845f;

constexpr size_t MiB = 1u << 20;
constexpr size_t WS_CTL = 0, CTL_ZERO_BYTES = 1 * MiB;
constexpr size_t WS_WSK = 1 * MiB;
constexpr size_t WS_WPP = 2 * MiB;
constexpr size_t WS_W1GU = 4 * MiB;
constexpr size_t WS_W1D = 176 * MiB;
constexpr size_t WS_W2GU = 262 * MiB;
constexpr size_t WS_W2D = 434 * MiB;
constexpr size_t WS_WIN = 520 * MiB;
constexpr size_t WS_WO = 616 * MiB;
constexpr size_t WS_WPG = 648 * MiB;
constexpr size_t WS_H = 680 * MiB;
constexpr size_t WS_F = 808 * MiB;
constexpr size_t WS_XN = 936 * MiB;
constexpr size_t WS_MIX = 1000 * MiB;
constexpr size_t WS_ACT = 1064 * MiB;
constexpr size_t WS_Q = 1064 * MiB, WS_K = 1096 * MiB, WS_V = 1128 * MiB;
constexpr size_t WS_GQ = 1160 * MiB, WS_GK = 1176 * MiB;
constexpr size_t WS_GV = 1192 * MiB, WS_GR = 1224 * MiB;
constexpr size_t WS_QDEC = 1256 * MiB, WS_KTE = 1272 * MiB, WS_VT = 1288 * MiB, WS_AM = 1320 * MiB;
constexpr size_t WS_MISC = 1324 * MiB;
constexpr size_t WS_OGLA = 1328 * MiB;
constexpr size_t WS_ERAW = 1256 * MiB;
constexpr size_t WS_PBF = 1392 * MiB;
constexpr size_t WS_UG = 1396 * MiB;
constexpr size_t WS_DG = 1402 * MiB;
constexpr size_t WS_EPART = 1403 * MiB;
constexpr size_t WS_END = 1405 * MiB;
static_assert(WS_ERAW + (size_t)S * DM * 4 <= WS_PBF && WS_ACT + (size_t)S * DFF * 2 <= WS_ERAW && WS_OGLA + (size_t)S * GVW * 4 <= WS_PBF, "d_ws map");
constexpr int CW_TMO = 0, CW_CODE = 1;
constexpr int CW_BAR = 4096;
constexpr int CW_NRM = 2048;

constexpr int RING_OFF = 0, RING_BYTES = 131072;
constexpr int LDS_BYTES = 147456;
constexpr int LDSCTL_OFF = LDS_BYTES - 1024, MISC_OFF = LDSCTL_OFF + 320;

#define GAS __attribute__((address_space(1)))
#define LAS __attribute__((address_space(3)))
typedef unsigned short bf16;
typedef unsigned v4u __attribute__((ext_vector_type(4)));
typedef unsigned v2u __attribute__((ext_vector_type(2)));
typedef float f32x4 __attribute__((ext_vector_type(4)));
typedef float f32x16 __attribute__((ext_vector_type(16)));
typedef short bf16x8 __attribute__((ext_vector_type(8)));
typedef GAS unsigned gu32;
typedef GAS unsigned long long gu64;
#define RLX_AGENT __ATOMIC_RELAXED, __HIP_MEMORY_SCOPE_AGENT
#define LDS_WAIT() asm volatile("s_waitcnt lgkmcnt(0)" ::: "memory")
#define VM_WAIT() asm volatile("s_waitcnt vmcnt(0)" ::: "memory")
__device__ __forceinline__ unsigned pk2(float lo, float hi) { unsigned r; asm("v_cvt_pk_bf16_f32 %0, %1, %2" : "=v"(r) : "v"(lo), "v"(hi)); return r; }
__device__ __forceinline__ unsigned f2bf(float f) { return pk2(f, 0.f) & 0xffffu; }
__device__ __forceinline__ float bf2f(unsigned short b) { return __builtin_bit_cast(float, (unsigned)b << 16); }
__device__ __forceinline__ float bflo(unsigned w) { return __builtin_bit_cast(float, w << 16); }
__device__ __forceinline__ float bfhi(unsigned w) { return __builtin_bit_cast(float, w & 0xffff0000u); }
__device__ __forceinline__ float log_sigmoid_f(float z) { return fminf(z, 0.f) - __logf(1.0f + __expf(-fabsf(z))); }
#define XB_TMO      128
#define XB_XCNT(j)  (256  + 64 * (j))
#define XB_XSUB(j)  (1280 + 64 * (j))
#define XB_XGEN(j)  (2304 + 64 * (j))
#define XB_TOP      3328
#define XB_TOPGEN   3392
#define XCD_BAR_WORDS 3456
#define XB_SPIN_CAP (1u << 21)

__device__ __forceinline__ unsigned xb_ld(unsigned* p)              { return __hip_atomic_load(p, __ATOMIC_RELAXED, __HIP_MEMORY_SCOPE_AGENT); }
__device__ __forceinline__ unsigned xb_add(unsigned* p, unsigned v) { return __hip_atomic_fetch_add(p, v, __ATOMIC_RELAXED, __HIP_MEMORY_SCOPE_AGENT); }
__device__ __forceinline__ unsigned xb_xcc_id() { return (unsigned)__builtin_amdgcn_s_getreg((3 << 11) | 20) & 0xFu; }
#define XB_SPIN(cond, bar) do { unsigned _sp = 0; while (cond) { __builtin_amdgcn_s_sleep(1); \
    if ((++_sp & 255u) == 0u) { if (xb_ld(&(bar)[XB_TMO])) break; if (_sp > XB_SPIN_CAP) { atomicAdd(&(bar)[XB_TMO], 1u); break; } } } } while (0)

struct XcdBarrier {
    unsigned* bar; unsigned x;
    volatile LAS unsigned* st;
};

__device__ __forceinline__ XcdBarrier xcd_barrier_post(unsigned* bar, volatile LAS unsigned* st) {
    XcdBarrier b; b.bar = bar; b.x = xb_xcc_id(); b.st = st;
    if (threadIdx.x == 0) (void)xb_add(&bar[XB_XCNT(b.x)], 1u);
    return b;
}
__device__ __forceinline__ void xcd_barrier_complete(unsigned* bar, unsigned x, unsigned& nloc, unsigned& nx) {
    const unsigned G = gridDim.x * gridDim.y * gridDim.z;
    unsigned sum, cnt, mine, sp = 0u;
    for (;;) {
        sum = 0u; cnt = 0u; mine = 0u;
#pragma unroll
        for (unsigned j = 0; j < 16; ++j) { const unsigned c = xb_ld(&bar[XB_XCNT(j)]); sum += c; cnt += (c > 0u) ? 1u : 0u; mine = (j == x) ? c : mine; }
        if (sum == G) break;
        __builtin_amdgcn_s_sleep(1);
        if ((++sp & 255u) == 0u) { if (xb_ld(&bar[XB_TMO])) break; if (sp > XB_SPIN_CAP) { atomicAdd(&bar[XB_TMO], 1u); break; } }
    }
    nloc = mine > 0u ? mine : 1u; nx = cnt > 0u ? cnt : 1u;
}

__device__ __forceinline__ void xcd_barrier(const XcdBarrier& b) {
    asm volatile("s_waitcnt vmcnt(0)" ::: "memory");
    __syncthreads();
    if (threadIdx.x == 0) {
        unsigned* bar = b.bar;
        __builtin_amdgcn_s_waitcnt(0);
        unsigned nloc = b.st[0], nx = b.st[1];
        if (nloc == 0u) { xcd_barrier_complete(bar, b.x, nloc, nx); b.st[0] = nloc; b.st[1] = nx; }
        const unsigned old = xb_add(&bar[XB_XSUB(b.x)], 1u);
        const unsigned gen = old / nloc;
        if (old + 1u == (gen + 1u) * nloc) {
            __builtin_amdgcn_fence(__ATOMIC_RELEASE, "agent");
            asm volatile("s_waitcnt vmcnt(0)" ::: "memory");
            const unsigned og = xb_add(&bar[XB_TOP], 1u);
            const unsigned tg = og / nx;
            if (og + 1u == (tg + 1u) * nx) xb_add(&bar[XB_TOPGEN], 1u);
            else XB_SPIN(xb_ld(&bar[XB_TOPGEN]) == tg, bar);
            __builtin_amdgcn_fence(__ATOMIC_ACQUIRE, "agent");
            xb_add(&bar[XB_XGEN(b.x)], 1u);
            asm volatile("s_waitcnt vmcnt(0)" ::: "memory");
        } else {
            XB_SPIN(xb_ld(&bar[XB_XGEN(b.x)]) == gen, bar);
            __builtin_amdgcn_fence(__ATOMIC_ACQUIRE, "agent");
            asm volatile("s_waitcnt vmcnt(0)" ::: "memory");
        }
    }
    __syncthreads();
}


struct Frame {
    LAS unsigned char* lds;
    volatile LAS unsigned* MISC;
    gu32* ctl;
    int tid, lane, wave;
    int vcu, G;
};
__device__ __forceinline__ float wave_sum(float v) {
#pragma unroll
    for (int o = 1; o < 64; o <<= 1) v += __shfl_xor(v, o);
    return v;
}
template <class RowMap>
__device__ __forceinline__ void p0_transpose_item(const float* W, int N, int K, LAS float* scr, int kb, int nb, int lane, const RowMap& rm) {
    const int k0 = 64 * kb, n0 = 32 * nb;
    float v[32];
#pragma unroll
    for (int i = 0; i < 32; ++i) v[i] = W[(size_t)(k0 + 2 * i + (lane >> 5)) * N + n0 + (lane & 31)];
#pragma unroll
    for (int i = 0; i < 32; ++i) scr[(2 * i + (lane >> 5)) * 33 + (lane & 31)] = v[i];
    LDS_WAIT(); asm volatile("" ::: "memory");
    const int c = lane & 7;
#pragma unroll
    for (int j = 0; j < 4; ++j) { const int n = (lane >> 3) + 8 * j; const LAS float* s = scr + (8 * c) * 33 + n;
        v4u o; o.x = pk2(s[0 * 33], s[1 * 33]); o.y = pk2(s[2 * 33], s[3 * 33]); o.z = pk2(s[4 * 33], s[5 * 33]); o.w = pk2(s[6 * 33], s[7 * 33]);
        *(GAS v4u*)(rm(n0 + n) + k0 + 8 * c) = o; }
    LDS_WAIT(); asm volatile("" ::: "memory");
}
struct RmPlain { bf16* WT; int K; __device__ __forceinline__ bf16* operator()(int n) const { return WT + (size_t)n * K; } };
struct RmGateUp { bf16* WT; int up; __device__ __forceinline__ bf16* operator()(int n) const { return WT + (size_t)(256 * (n >> 7) + 128 * up + (n & 127)) * DM; } };
struct RmWin { bf16* WT; bf16* SK;
    __device__ __forceinline__ bf16* operator()(int n) const {
        if (n < 6144) return WT + (size_t)n * DM;
        if (n < 6160) return SK + (size_t)(n - 6144) * DM;
        if (n < 12304) return WT + (size_t)(n - 16) * DM;
        return SK + (size_t)(16 + n - 12304) * DM; } };

constexpr int NSCAN = GH * 16;
constexpr int CV_GU = (DM / 64) * (DFF / 32), CV_D = (DFF / 64) * (DM / 32), CV_IN = (DM / 64) * (WIN_COLS / 32), CV_SQ = (DM / 64) * (DM / 32), CV_PP = (PLE / 64) * (DM / 32);
constexpr int CV_TAIL = (CV_D * 3) / 4;
constexpr int CV_A = 2 * CV_GU + CV_IN, CV_B = CV_A + CV_D, CV_C = CV_B + 2 * CV_GU + 2 * CV_SQ + CV_PP, CV_D2 = CV_C + CV_D;
struct CvItem { const float* W; int N, k0, n0, seg; };
__device__ __forceinline__ CvItem cv_decode(const float* const* in, int it) {
    int r = it;
    if (r < CV_GU) return CvItem{in[3], DFF, 64 * (r / (DFF / 32)), 32 * (r % (DFF / 32)), 0}; r -= CV_GU;
    if (r < CV_GU) return CvItem{in[4], DFF, 64 * (r / (DFF / 32)), 32 * (r % (DFF / 32)), 1}; r -= CV_GU;
    if (r < CV_IN) return CvItem{in[8], WIN_COLS, 64 * (r / (WIN_COLS / 32)), 32 * (r % (WIN_COLS / 32)), 2}; r -= CV_IN;
    if (r < CV_D) return CvItem{in[5], DM, 64 * (r / (DM / 32)), 32 * (r % (DM / 32)), 3}; r -= CV_D;
    if (r < CV_GU) return CvItem{in[16], DFF, 64 * (r / (DFF / 32)), 32 * (r % (DFF / 32)), 4}; r -= CV_GU;
    if (r < CV_GU) return CvItem{in[17], DFF, 64 * (r / (DFF / 32)), 32 * (r % (DFF / 32)), 5}; r -= CV_GU;
    if (r < CV_SQ) return CvItem{in[13], DM, 64 * (r / (DM / 32)), 32 * (r % (DM / 32)), 6}; r -= CV_SQ;
    if (r < CV_SQ) return CvItem{in[22], DM, 64 * (r / (DM / 32)), 32 * (r % (DM / 32)), 7}; r -= CV_SQ;
    if (r < CV_PP) return CvItem{in[20], DM, 64 * (r / (DM / 32)), 32 * (r % (DM / 32)), 8}; r -= CV_PP;
    return CvItem{in[18], DM, 64 * (r / (DM / 32)), 32 * (r % (DM / 32)), 9};
}
__device__ __forceinline__ void cv_load(f32x4 (&v)[8], const CvItem& c, int lane) {
    const GAS float* src = (const GAS float*)c.W + (size_t)(c.k0 + (lane >> 3)) * c.N + c.n0 + 4 * (lane & 7);
#pragma unroll
    for (int i = 0; i < 8; ++i) v[i] = __builtin_nontemporal_load((const GAS f32x4*)(src + (size_t)(8 * i) * c.N));
}
__device__ __forceinline__ void cv_store(const f32x4 (&v)[8], const CvItem& c, unsigned char* ws, LAS float* scr, int lane) {
#pragma unroll
    for (int i = 0; i < 8; ++i) { LAS float* d = scr + (8 * i + (lane >> 3)) * 33 + 4 * (lane & 7); d[0] = v[i].x; d[1] = v[i].y; d[2] = v[i].z; d[3] = v[i].w; }
    LDS_WAIT(); asm volatile("" ::: "memory");
    const int cc = lane & 7, seg = c.seg;
    size_t base; int K;
    if (seg == 0 || seg == 1) { base = WS_W1GU; K = DM; } else if (seg == 2) { base = WS_WIN; K = DM; } else if (seg == 3) { base = WS_W1D; K = DFF; } else if (seg == 4 || seg == 5) { base = WS_W2GU; K = DM; }
    else if (seg == 6) { base = WS_WO; K = DM; } else if (seg == 7) { base = WS_WPG; K = DM; } else if (seg == 8) { base = WS_WPP; K = PLE; } else { base = WS_W2D; K = DFF; }
#pragma unroll
    for (int j = 0; j < 4; ++j) { const int nl = (lane >> 3) + 8 * j, n = c.n0 + nl; const LAS float* sp = scr + (8 * cc) * 33 + nl;
        v4u o; o.x = pk2(sp[0 * 33], sp[1 * 33]); o.y = pk2(sp[2 * 33], sp[3 * 33]); o.z = pk2(sp[4 * 33], sp[5 * 33]); o.w = pk2(sp[6 * 33], sp[7 * 33]);
        int row = n; size_t bs = base;
        if (seg == 0 || seg == 4) row = 256 * (n >> 7) + (n & 127);
        else if (seg == 1 || seg == 5) row = 256 * (n >> 7) + 128 + (n & 127);
        else if (seg == 2) {
            if (n < 6144) row = n; else if (n < 6160) { row = n - 6144; bs = WS_WSK; } else if (n < 12304) row = n - 16; else { row = 16 + n - 12304; bs = WS_WSK; } }
        *(GAS v4u*)((GAS char*)ws + bs + ((size_t)row * K + c.k0 + 8 * cc) * 2) = o; }
    LDS_WAIT(); asm volatile("" ::: "memory");
}
__device__ __forceinline__ void convert_items(Frame& F, const float* const* in, unsigned char* ws, int first, int last, int wv, int nwv) {
    LAS float* scr = (LAS float*)(F.lds + RING_OFF + F.wave * 16384);
    int it = first + wv;
    if (it >= last) return;
    f32x4 v0[8], v1[8], v2[8], v3[8];
    CvItem c0 = cv_decode(in, it), c1 = c0, c2 = c0, c3 = c0;
#define CV_LD(j, idx) do { if ((idx) < last) { c##j = cv_decode(in, (idx)); cv_load(v##j, c##j, F.lane); } } while (0)
    cv_load(v0, c0, F.lane); CV_LD(1, it + nwv); CV_LD(2, it + 2 * nwv);
    for (;;) {
        CV_LD(3, it + 3 * nwv); cv_store(v0, c0, ws, scr, F.lane); if (it + nwv >= last) break;
        CV_LD(0, it + 4 * nwv); cv_store(v1, c1, ws, scr, F.lane); if (it + 2 * nwv >= last) break;
        CV_LD(1, it + 5 * nwv); cv_store(v2, c2, ws, scr, F.lane); if (it + 3 * nwv >= last) break;
        CV_LD(2, it + 6 * nwv); cv_store(v3, c3, ws, scr, F.lane); if (it + 4 * nwv >= last) break;
        it += 4 * nwv;
    }
#undef CV_LD
}

constexpr int CV_CLAIM = 16 * NWAVES, CW_CVQ = 3072;
__device__ __forceinline__ void convert_dynamic(Frame& F, const float* const* in, unsigned char* ws, int first, int last) {
    for (;;) {
        __syncthreads();
        if (F.tid == 0) F.MISC[12] = __hip_atomic_fetch_add(F.ctl + CW_CVQ, (unsigned)CV_CLAIM, RLX_AGENT);
        __syncthreads();
        const int b0 = first + (int)F.MISC[12];
        if (b0 >= last) break;
        convert_items(F, in, ws, b0, min(last, b0 + CV_CLAIM), F.wave, NWAVES);
    }
}

__device__ __forceinline__ void norm_row_to_bf16(const float* xrow, const f32x4 (&gq)[16], bf16* orow, int lane) {
    const GAS f32x4* xr = (const GAS f32x4*)xrow + lane;
    f32x4 v[16]; float s = 0.f;
#pragma unroll
    for (int j = 0; j < 16; ++j) { v[j] = __builtin_nontemporal_load(xr + 64 * j); s += (v[j].x * v[j].x + v[j].y * v[j].y) + (v[j].z * v[j].z + v[j].w * v[j].w); }
    const float rstd = 1.f / sqrtf(wave_sum(s) * (1.f / DM) + EPS);
    GAS v2u* o8 = (GAS v2u*)orow + lane;
#pragma unroll
    for (int j = 0; j < 16; ++j) { const f32x4 gg = gq[j]; v2u w; w.x = pk2(v[j].x * rstd * gg.x, v[j].y * rstd * gg.y); w.y = pk2(v[j].z * rstd * gg.z, v[j].w * rstd * gg.w); o8[64 * j] = w; }
}
__device__ __forceinline__ void stage_gains(Frame& F, const float* g1, const float* g2) {
    LAS f32x4* gl = (LAS f32x4*)(F.lds + RING_OFF);
    __syncthreads();
    for (int i = F.tid; i < DM / 4; i += NWAVES * 64) { gl[i] = ((const GAS f32x4*)g1)[i]; gl[DM / 4 + i] = ((const GAS f32x4*)g2)[i]; }
    __syncthreads();
}
template <bool NORM2, bool BASE_BF16>
__device__ __forceinline__ void resid_row(Frame& F, const bf16* frow, const void* baserow, float wgt, bf16* hout, bf16* bout, int lane) {
    const GAS v2u* fr = (const GAS v2u*)frow + lane; const GAS f32x4* br = (const GAS f32x4*)baserow + lane; const GAS v2u* bb = (const GAS v2u*)baserow + lane;
    const LAS f32x4* g1l = (const LAS f32x4*)(F.lds + RING_OFF) + lane; const LAS f32x4* g2l = g1l + DM / 4;
    v2u fw[16], bwv[16]; f32x4 v[16]; float s = 0.f;
#pragma unroll
    for (int j = 0; j < 16; ++j) fw[j] = __builtin_nontemporal_load(fr + 64 * j);
    if (BASE_BF16) {
#pragma unroll
        for (int j = 0; j < 16; ++j) bwv[j] = __builtin_nontemporal_load(bb + 64 * j);
    } else {
#pragma unroll
        for (int j = 0; j < 16; ++j) v[j] = __builtin_nontemporal_load(br + 64 * j);
    }
#pragma unroll
    for (int j = 0; j < 16; ++j) { const float a0 = bflo(fw[j].x), a1 = bfhi(fw[j].x), a2 = bflo(fw[j].y), a3 = bfhi(fw[j].y); s += (a0 * a0 + a1 * a1) + (a2 * a2 + a3 * a3); }
    const float rw = wgt / sqrtf(wave_sum(s) * (1.f / DM) + EPS);
    float s2 = 0.f; GAS v2u* ho = (GAS v2u*)hout + lane;
#pragma unroll
    for (int j = 0; j < 16; ++j) { f32x4 b;
        if (BASE_BF16) b = (f32x4){bflo(bwv[j].x), bfhi(bwv[j].x), bflo(bwv[j].y), bfhi(bwv[j].y)}; else b = v[j];
        const f32x4 gg = g1l[64 * j]; const f32x4 f = {bflo(fw[j].x), bfhi(fw[j].x), bflo(fw[j].y), bfhi(fw[j].y)};
        v[j] = b + f * rw * gg;
        if (NORM2) { v2u w; w.x = pk2(v[j].x, v[j].y); w.y = pk2(v[j].z, v[j].w); __builtin_nontemporal_store(w, ho + 64 * j); }
        s2 += (v[j].x * v[j].x + v[j].y * v[j].y) + (v[j].z * v[j].z + v[j].w * v[j].w);
        if ((j & 7) == 7) asm volatile("" ::: "memory"); }
    GAS v2u* o8 = (GAS v2u*)bout + lane;
    if (NORM2) { const float r2 = 1.f / sqrtf(wave_sum(s2) * (1.f / DM) + EPS);
#pragma unroll
        for (int j = 0; j < 16; ++j) { const f32x4 gg = g2l[64 * j]; v2u w; w.x = pk2(v[j].x * r2 * gg.x, v[j].y * r2 * gg.y); w.y = pk2(v[j].z * r2 * gg.z, v[j].w * r2 * gg.w); o8[64 * j] = w;
            if ((j & 7) == 7) asm volatile("" ::: "memory"); } }
    else {
#pragma unroll
        for (int j = 0; j < 16; ++j) { v2u w; w.x = pk2(v[j].x, v[j].y); w.y = pk2(v[j].z, v[j].w); o8[64 * j] = w; } }
}

__device__ __forceinline__ void skinny_gemm(Frame& F, const bf16* XN, const bf16* WSK, float* FFGLR) {
    LAS float* red = (LAS float*)(F.lds + RING_OFF);
    const int r = F.lane & 31, h = F.lane >> 5;
    for (int blk = F.vcu; blk < S / 32; blk += F.G) {
        const bf16* ap = XN + (size_t)(blk * 32 + r) * DM + F.wave * 512 + 8 * h; const bf16* bp = WSK + (size_t)r * DM + F.wave * 512 + 8 * h;
        f32x16 acc = {};
#pragma unroll 16
        for (int ks = 0; ks < 32; ++ks) { const bf16x8 a = *(const GAS bf16x8*)(ap + ks * 16), b = *(const GAS bf16x8*)(bp + ks * 16);
            acc = __builtin_amdgcn_mfma_f32_32x32x16_bf16(a, b, acc, 0, 0, 0); }
        __syncthreads();
#pragma unroll
        for (int i = 0; i < 16; ++i) red[(F.wave * 32 + ((i & 3) + 8 * (i >> 2) + 4 * h)) * 33 + r] = acc[i];
        __syncthreads();
        for (int e = F.tid; e < 1024; e += NWAVES * 64) { const int row = e >> 5, col = e & 31; float s = 0.f;
#pragma unroll
            for (int w = 0; w < 8; ++w) s += red[(w * 32 + row) * 33 + col];
            FFGLR[(size_t)(blk * 32 + row) * 32 + col] = s; }
    }
    __syncthreads();
}


__device__ __forceinline__ void fox_norms(Frame& F, const bf16* Q, const bf16* K, float* NRMP) {
    LAS float* red = (LAS float*)(F.lds + RING_OFF);
    const int gw_ = F.vcu * NWAVES + F.wave, ngw = F.G * NWAVES, sub = F.lane >> 4, l16 = F.lane & 15;
    __syncthreads();
    float mq[FH], mk[FH];
#pragma unroll
    for (int hd = 0; hd < FH; ++hd) { mq[hd] = 0.f; mk[hd] = 0.f; }
    for (int r0 = gw_ * 4; r0 < S; r0 += ngw * 4) {
#pragma unroll
        for (int h0 = 0; h0 < FH; h0 += 8) {
            v4u qa[8], kb[8];
#pragma unroll
            for (int i = 0; i < 8; ++i) { const size_t o = ((size_t)(h0 + i) * S + r0 + sub) * FD + l16 * 8; qa[i] = *(const GAS v4u*)(Q + o); kb[i] = *(const GAS v4u*)(K + o); }
#pragma unroll
            for (int i = 0; i < 8; ++i) { const v4u a = qa[i], b = kb[i];
                float sq = bflo(a.x) * bflo(a.x) + bfhi(a.x) * bfhi(a.x) + bflo(a.y) * bflo(a.y) + bfhi(a.y) * bfhi(a.y) + bflo(a.z) * bflo(a.z) + bfhi(a.z) * bfhi(a.z) + bflo(a.w) * bflo(a.w) + bfhi(a.w) * bfhi(a.w);
                float sk = bflo(b.x) * bflo(b.x) + bfhi(b.x) * bfhi(b.x) + bflo(b.y) * bflo(b.y) + bfhi(b.y) * bfhi(b.y) + bflo(b.z) * bflo(b.z) + bfhi(b.z) * bfhi(b.z) + bflo(b.w) * bflo(b.w) + bfhi(b.w) * bfhi(b.w);
#pragma unroll
                for (int o2 = 1; o2 < 16; o2 <<= 1) { sq += __shfl_xor(sq, o2); sk += __shfl_xor(sk, o2); }
                mq[h0 + i] = fmaxf(mq[h0 + i], sq); mk[h0 + i] = fmaxf(mk[h0 + i], sk); } } }
#pragma unroll
    for (int hd = 0; hd < FH; ++hd) { float q = mq[hd], k = mk[hd];
        q = fmaxf(q, __shfl_xor(q, 16)); q = fmaxf(q, __shfl_xor(q, 32)); k = fmaxf(k, __shfl_xor(k, 16)); k = fmaxf(k, __shfl_xor(k, 32));
        if (F.lane == 0) { red[F.wave * 32 + 2 * hd] = q; red[F.wave * 32 + 2 * hd + 1] = k; } }
    __syncthreads();
    if (F.tid < 32) { float m = red[F.tid];
#pragma unroll
        for (int w = 1; w < NWAVES; ++w) m = fmaxf(m, red[w * 32 + F.tid]);
        NRMP[(size_t)F.vcu * 32 + F.tid] = m; }
    __syncthreads();
}
constexpr float CF_SCALE = SIMPLE_ATTN ? 1.0f : 11.313708498984761f;
__device__ __forceinline__ void fox_prep(Frame& F, const float* FFGLR, const float* bfv, float* cf) {
    LAS float* sc = (LAS float*)(F.lds + RING_OFF);
    const bool spread = F.G >= 16 * FH;
    for (int hd = spread ? ((F.vcu & 15) == 0 ? (F.vcu >> 4) : FH) : F.vcu; hd < FH; hd += F.G) {
        const float b = bfv[hd]; const int t0 = F.tid * 16; float v[16]; float run = 0.f;
#pragma unroll
        for (int j = 0; j < 16; ++j) { run += log_sigmoid_f(FFGLR[(size_t)(t0 + j) * 32 + hd] + b); v[j] = run; }
        float inc = run;
#pragma unroll
        for (int o = 1; o < 64; o <<= 1) { const float n = __shfl_up(inc, o); if (F.lane >= o) inc += n; }
        __syncthreads();
        if (F.lane == 63) sc[512 + F.wave] = inc;
        __syncthreads();
        float woff = 0.f;
        for (int w = 0; w < F.wave; ++w) woff += sc[512 + w];
        const float excl = woff + inc - run;
#pragma unroll
        for (int j = 0; j < 16; ++j) cf[(size_t)hd * S + t0 + j] = (v[j] + excl) * CF_SCALE;
    }
    __syncthreads();
}

#if SIMPLE_ATTN
__device__ __forceinline__ void attn_simple(Frame& F, const bf16* Q, const bf16* K, const bf16* V, const float* cf, bf16* MIX) {
    LAS unsigned char* kt = F.lds + RING_OFF; LAS unsigned char* vt = kt + 16384; LAS float* ck = (LAS float*)(vt + 16384);
    const int row = F.tid >> 3, part = F.tid & 7;
    for (int item = F.vcu; item < FH * (S / 64); item += F.G) {
        const int hd = item & 15, qb = (S / 64 - 1) - (item >> 4), qrow = qb * 64 + row;
        float q[16], o[16]; float m = -1e30f, l = 0.f;
        { const GAS v4u* qp = (const GAS v4u*)(Q + ((size_t)hd * S + qrow) * FD + part * 16); const v4u a = qp[0], b = qp[1];
          const unsigned w[8] = {a.x, a.y, a.z, a.w, b.x, b.y, b.z, b.w};
#pragma unroll
          for (int j = 0; j < 8; ++j) { q[2 * j] = bflo(w[j]) * FOX_SCALE; q[2 * j + 1] = bfhi(w[j]) * FOX_SCALE; } }
#pragma unroll
        for (int j = 0; j < 16; ++j) o[j] = 0.f;
        const float cq = cf[(size_t)hd * S + qrow];
        for (int ktile = 0; ktile <= qb; ++ktile) {
            __syncthreads();
            for (int e = F.tid; e < 1024; e += NWAVES * 64) { const int key = e >> 4, ch = e & 15;
                *(LAS v4u*)(kt + key * 256 + ch * 16) = *(const GAS v4u*)(K + ((size_t)hd * S + ktile * 64 + key) * FD + ch * 8);
                *(LAS v4u*)(vt + key * 256 + ch * 16) = *(const GAS v4u*)(V + ((size_t)hd * S + ktile * 64 + key) * FD + ch * 8); }
            if (F.tid < 64) ck[F.tid] = cf[(size_t)hd * S + ktile * 64 + F.tid];
            __syncthreads();
#pragma unroll 1
            for (int kb = 0; kb < 4; ++kb) {
                float s[16]; float mx = -__builtin_inff();
#pragma unroll
                for (int kk = 0; kk < 16; ++kk) { const int key = kb * 16 + kk;
                    const v4u a = *(const LAS v4u*)(kt + key * 256 + part * 32), b = *(const LAS v4u*)(kt + key * 256 + part * 32 + 16);
                    const unsigned w[8] = {a.x, a.y, a.z, a.w, b.x, b.y, b.z, b.w}; float d = 0.f;
#pragma unroll
                    for (int j = 0; j < 8; ++j) d += q[2 * j] * bflo(w[j]) + q[2 * j + 1] * bfhi(w[j]);
                    d += __shfl_xor(d, 1); d += __shfl_xor(d, 2); d += __shfl_xor(d, 4);
                    d += cq - ck[key];
                    if (ktile * 64 + key > qrow) d = -__builtin_inff();
                    s[kk] = d; mx = fmaxf(mx, d); }
                const float mn = fmaxf(m, mx), alpha = __expf(m - mn); l *= alpha; m = mn;
#pragma unroll
                for (int j = 0; j < 16; ++j) o[j] *= alpha;
#pragma unroll
                for (int kk = 0; kk < 16; ++kk) { const int key = kb * 16 + kk; const float p = __expf(s[kk] - mn); l += p;
                    const v4u a = *(const LAS v4u*)(vt + key * 256 + part * 32), b = *(const LAS v4u*)(vt + key * 256 + part * 32 + 16);
                    const unsigned w[8] = {a.x, a.y, a.z, a.w, b.x, b.y, b.z, b.w};
#pragma unroll
                    for (int j = 0; j < 8; ++j) { o[2 * j] += p * bflo(w[j]); o[2 * j + 1] += p * bfhi(w[j]); } }
            }
        }
        const float il = 1.f / l; v4u w0, w1;
        w0.x = pk2(o[0] * il, o[1] * il); w0.y = pk2(o[2] * il, o[3] * il); w0.z = pk2(o[4] * il, o[5] * il); w0.w = pk2(o[6] * il, o[7] * il);
        w1.x = pk2(o[8] * il, o[9] * il); w1.y = pk2(o[10] * il, o[11] * il); w1.z = pk2(o[12] * il, o[13] * il); w1.w = pk2(o[14] * il, o[15] * il);
        GAS v4u* op = (GAS v4u*)(MIX + (size_t)qrow * DM + hd * FD + part * 16); op[0] = w0; op[1] = w1;
    }
    __syncthreads();
}
#endif

#if SIMPLE_GLA
__device__ __forceinline__ void gla_simple(Frame& F, const bf16* GQ, const bf16* GK, const bf16* GV, const float* FFGLR, const float* Wg, const float* bg, float* OGLA) {
    constexpr int TB = 16;
    LAS float* qs = (LAS float*)(F.lds + RING_OFF);
    LAS float* ks = qs + TB * 256;
    LAS float* vs = ks + TB * 256;
    LAS float* gs = vs + TB * 32;
    LAS float* red = gs + TB * 16;
    const int dk = F.tid & 255, half = F.tid >> 8;
    for (int item = F.vcu; item < GH * 16; item += F.G) {
        const int hd = item >> 4, sl = item & 15, col = hd * GDK + dk;
        float wg[16];
#pragma unroll
        for (int r = 0; r < 16; ++r) wg[r] = Wg[r * GKW + col];
        const float bgv = bg[col];
        float st[16];
#pragma unroll
        for (int j = 0; j < 16; ++j) st[j] = 0.f;
        for (int t0 = 0; t0 < S; t0 += TB) {
            __syncthreads();
            for (int e = F.tid; e < TB * 256; e += NWAVES * 64) { const int tt = e >> 8, d = e & 255;
                qs[e] = bf2f(GQ[(size_t)(t0 + tt) * GKW + hd * GDK + d]) * 0.0625f; ks[e] = bf2f(GK[(size_t)(t0 + tt) * GKW + hd * GDK + d]); }
            { const int tt = F.tid >> 5, c = F.tid & 31; vs[F.tid] = bf2f(GV[(size_t)(t0 + tt) * GVW + hd * GDV + sl * 32 + c]); }
            if (F.tid < TB * 16) { const int tt = F.tid >> 4, r = F.tid & 15; gs[F.tid] = FFGLR[(size_t)(t0 + tt) * 32 + 16 + r]; }
            __syncthreads();
#pragma unroll 1
            for (int tt = 0; tt < TB; ++tt) {
                float z = bgv;
#pragma unroll
                for (int r = 0; r < 16; ++r) z += gs[tt * 16 + r] * wg[r];
                const float a = expf(log_sigmoid_f(z) * 0.0625f), kv = ks[tt * 256 + dk], qv = qs[tt * 256 + dk];
                float part[16];
#pragma unroll
                for (int j = 0; j < 16; ++j) { st[j] = a * st[j] + kv * vs[tt * 32 + half * 16 + j]; part[j] = qv * st[j]; }
#pragma unroll
                for (int j = 0; j < 16; ++j) {
#pragma unroll
                    for (int o = 1; o < 64; o <<= 1) part[j] += __shfl_xor(part[j], o); }
                float mine = part[0];
#pragma unroll
                for (int j = 1; j < 16; ++j) mine = (F.lane == j) ? part[j] : mine;
                if (F.lane < 16) red[(tt * 8 + F.wave) * 16 + F.lane] = mine;
            }
            __syncthreads();
            { const int tt = F.tid >> 5, c = F.tid & 31, hw = c >> 4, j = c & 15; float s = 0.f;
#pragma unroll
              for (int w = 0; w < 4; ++w) s += red[(tt * 8 + hw * 4 + w) * 16 + j];
              OGLA[(size_t)(t0 + tt) * GVW + hd * GDV + sl * 32 + c] = s; }
        }
    }
    __syncthreads();
}
#endif

__device__ __forceinline__ void gla_post(Frame& F, const float* OGLA, const bf16* GR, const float* g, bf16* MIX) {
    const int gw = F.vcu * NWAVES + F.wave, NGW = F.G * NWAVES;
    const GAS f32x4* gp = (const GAS f32x4*)(g) + 2 * F.lane; const f32x4 g0 = gp[0], g1 = gp[1];
    for (int it = gw; it < S * GH; it += 4 * NGW) {
        f32x4 a[4], b[4]; v4u rw[4];
#pragma unroll
        for (int u = 0; u < 4; ++u) { const int iu = it + u * NGW; if (iu < S * GH) { const int row = iu >> 2, hd = iu & 3;
            const v4u ow = __builtin_nontemporal_load((const GAS v4u*)((const bf16*)OGLA + (size_t)row * GVW + hd * GDV + 8 * F.lane));
            a[u] = (f32x4){bflo(ow.x), bfhi(ow.x), bflo(ow.y), bfhi(ow.y)}; b[u] = (f32x4){bflo(ow.z), bfhi(ow.z), bflo(ow.w), bfhi(ow.w)};
            rw[u] = __builtin_nontemporal_load((const GAS v4u*)(GR + (size_t)row * GVW + hd * GDV + 8 * F.lane)); } }
#pragma unroll
        for (int u = 0; u < 4; ++u) { const int iu = it + u * NGW; if (iu < S * GH) { const int row = iu >> 2, hd = iu & 3;
            const float ss = (a[u].x * a[u].x + a[u].y * a[u].y) + (a[u].z * a[u].z + a[u].w * a[u].w) + (b[u].x * b[u].x + b[u].y * b[u].y) + (b[u].z * b[u].z + b[u].w * b[u].w);
            const float rstd = 1.f / sqrtf(wave_sum(ss) * (1.f / GDV) + EPS);
            v4u w;
            w.x = pk2(a[u].x * rstd * g0.x * pg8::silu_f(bflo(rw[u].x)), a[u].y * rstd * g0.y * pg8::silu_f(bfhi(rw[u].x)));
            w.y = pk2(a[u].z * rstd * g0.z * pg8::silu_f(bflo(rw[u].y)), a[u].w * rstd * g0.w * pg8::silu_f(bfhi(rw[u].y)));
            w.z = pk2(b[u].x * rstd * g1.x * pg8::silu_f(bflo(rw[u].z)), b[u].y * rstd * g1.y * pg8::silu_f(bfhi(rw[u].z)));
            w.w = pk2(b[u].z * rstd * g1.z * pg8::silu_f(bflo(rw[u].w)), b[u].w * rstd * g1.w * pg8::silu_f(bfhi(rw[u].w)));
            *(GAS v4u*)(MIX + (size_t)row * DM + FW + hd * GDV + 8 * F.lane) = w; } }
    }
}

#if !SIMPLE_ATTN
namespace fa {
constexpr int D = 128, NW = 8, QBLK = 32, KVBLK = 64, QB = NW * QBLK, LDO = 4096;
constexpr int SHM_V = KVBLK * D * 2, SHM_K = KVBLK * D * 2;
constexpr int OFF_Q = 2 * SHM_V + 2 * SHM_K, OFF_CK = 131072 + 1024, OFF_WS = OFF_CK + 512, ATT_LDS_END = OFF_WS + NW * 64 * 4;
constexpr float SCALE = 0.08838834764831845f, THR = 8.f;
typedef short s16x4 __attribute__((ext_vector_type(4)));
typedef unsigned u32x4 __attribute__((ext_vector_type(4)));
#define KSWZ(row, colB) ((row) * 256 + ((colB) ^ (((row) & 7) << 4)))
#define SBAR() __builtin_amdgcn_sched_barrier(0)
__device__ __forceinline__ int v_st(int k, int c) { const int kk = (k & ~0xC) | ((k & 4) << 1) | ((k & 8) >> 1); return ((kk >> 3) * 4 + (c >> 5)) * 512 + ((kk & 7) * 32 + (c & 31)) * 2; }
__device__ __forceinline__ int v_rd_base(int lane) { return ((lane & 3) << 3) | (((lane >> 2) & 3) << 6) | (((lane >> 4) & 1) << 5) | (((lane >> 5) & 1) << 8); }
constexpr int v_rd_off(int d0, int ks, int half) { return d0 * 512 + ks * 4096 + half * 2048; }
__device__ __forceinline__ int crow(int r, int hi) { return (r & 3) + 8 * (r >> 2) + 4 * hi; }
__device__ __forceinline__ unsigned cvtpk(float lo, float hi) { unsigned r; asm volatile("v_cvt_pk_bf16_f32 %0, %1, %2" : "=v"(r) : "v"(lo), "v"(hi)); return r; }
__device__ __forceinline__ bf16x8 ld8(const bf16* p) { return *reinterpret_cast<const bf16x8*>(p); }
__device__ __forceinline__ void mask_tile(f32x16& p0, f32x16& p1, int dq) {
    const float NEG = -__builtin_inff();
#pragma unroll
    for (int r = 0; r < 16; ++r) { const int c = (r & 3) + 8 * (r >> 2);
        if (dq - c < 0) p0[r] = NEG;
        if (dq - c - 32 < 0) p1[r] = NEG; }
}
__device__ __forceinline__ void partialSM(f32x16& p0, f32x16& p1, float& m_reg, float& mn, float& alpha) {
    float pmax = p0[0]; for (int r = 1; r < 16; ++r) pmax = fmaxf(pmax, p0[r]); for (int r = 0; r < 16; ++r) pmax = fmaxf(pmax, p1[r]);
    { auto rr = __builtin_amdgcn_permlane32_swap(__float_as_uint(pmax), __float_as_uint(pmax), false, false);
      pmax = fmaxf(__uint_as_float(rr[0]), __uint_as_float(rr[1])); }
    constexpr float C2 = 1.4426950408889634f * SCALE;
    if (__builtin_expect(__all((pmax - m_reg) * SCALE <= THR), 1)) { mn = m_reg; alpha = 1.f; }
    else { mn = fmaxf(m_reg, pmax); alpha = __builtin_amdgcn_exp2f((m_reg - mn) * C2); m_reg = mn; }
    const float mnL = -mn * C2;
    for (int r = 0; r < 16; ++r) p0[r] = fmaf(p0[r], C2, mnL); for (int r = 0; r < 16; ++r) p1[r] = fmaf(p1[r], C2, mnL);
    for (int r = 0; r < 16; ++r) p0[r] = __builtin_amdgcn_exp2f(p0[r]);
}
__device__ __forceinline__ void finishSM(f32x16& p0, f32x16& p1, float alpha, float& l_reg, bf16x8& pa0, bf16x8& pa1, bf16x8& pa2, bf16x8& pa3) {
    for (int r = 0; r < 16; ++r) p1[r] = __builtin_amdgcn_exp2f(p1[r]);
    float ps = 0; for (int r = 0; r < 16; ++r) ps += p0[r]; for (int r = 0; r < 16; ++r) ps += p1[r];
    { auto rr = __builtin_amdgcn_permlane32_swap(__float_as_uint(ps), __float_as_uint(ps), false, false);
      ps = __uint_as_float(rr[0]) + __uint_as_float(rr[1]); }
    l_reg = l_reg * alpha + ps;
#define PK4(P, B_, OUT) do { unsigned a0 = cvtpk(P[B_+0], P[B_+1]), a1 = cvtpk(P[B_+2], P[B_+3]);                          \
        unsigned b0 = cvtpk(P[B_+4], P[B_+5]), b1 = cvtpk(P[B_+6], P[B_+7]);                                             \
        auto r0 = __builtin_amdgcn_permlane32_swap(a0, b0, false, false); auto r1 = __builtin_amdgcn_permlane32_swap(a1, b1, false, false); \
        u32x4 w = {r0[0], r1[0], r0[1], r1[1]}; OUT = *reinterpret_cast<bf16x8*>(&w); } while (0)
    PK4(p0, 0, pa0); PK4(p0, 8, pa1); PK4(p1, 0, pa2); PK4(p1, 8, pa3);
#undef PK4
}
template <int KB>
__device__ __forceinline__ void qkt(f32x16& p0, f32x16& p1, const char* K_lds, const char* CK_lds, int r32, int hi, const char* Qw, float cq) {
#pragma unroll
    for (int g = 0; g < 4; ++g) { const f32x4 c0 = *(const f32x4*)(CK_lds + KB * 256 + (8 * g + 4 * hi) * 4), c1 = *(const f32x4*)(CK_lds + KB * 256 + (32 + 8 * g + 4 * hi) * 4);
#pragma unroll
        for (int i = 0; i < 4; ++i) { p0[4 * g + i] = cq - c0[i]; p1[4 * g + i] = cq - c1[i]; } }
    const char* kb[4];
#pragma unroll
    for (int dd = 0; dd < 4; ++dd) kb[dd] = K_lds + KB * SHM_K + KSWZ(r32, (dd * 16 + hi * 8) * 2);
#pragma unroll
    for (int d0 = 0; d0 < 8; ++d0) { const char* a = kb[d0 & 3] + (d0 >> 2) * 128;
        bf16x8 b0 = *reinterpret_cast<const bf16x8*>(a);
        bf16x8 b1 = *reinterpret_cast<const bf16x8*>(a + 32 * 256);
        bf16x8 qv = *reinterpret_cast<const bf16x8*>(Qw + KSWZ(r32, ((d0 & 3) * 16 + hi * 8) * 2) + (d0 >> 2) * 128);
        p0 = __builtin_amdgcn_mfma_f32_32x32x16_bf16(b0, qv, p0, 0, 0, 0);
        p1 = __builtin_amdgcn_mfma_f32_32x32x16_bf16(b1, qv, p1, 0, 0, 0); }
}
template <int VB>
__device__ __forceinline__ void pv_tile(f32x16* o, int vb0, bf16x8 pa0, bf16x8 pa1, bf16x8 pa2, bf16x8 pa3) {
#define TRRD(dst, off) asm volatile("ds_read_b64_tr_b16 %0, %1 offset:%2" : "=&v"(dst) : "v"(vb0), "i"(off) : "memory")
#define PV_D0(d0) do { s16x4 l0, l1, l2, l3, h0, h1, h2, h3; constexpr int b_ = VB * SHM_V + v_rd_off(d0, 0, 0); \
        TRRD(l0, b_); TRRD(h0, b_ + 2048); TRRD(l1, b_ + 4096); TRRD(h1, b_ + 6144); TRRD(l2, b_ + 8192); TRRD(h2, b_ + 10240); TRRD(l3, b_ + 12288); TRRD(h3, b_ + 14336); \
        asm volatile("s_waitcnt lgkmcnt(0)" ::: "memory"); SBAR();   \
        o[d0] = __builtin_amdgcn_mfma_f32_32x32x16_bf16(pa0, (bf16x8){l0[0], l0[1], l0[2], l0[3], h0[0], h0[1], h0[2], h0[3]}, o[d0], 0, 0, 0);   \
        o[d0] = __builtin_amdgcn_mfma_f32_32x32x16_bf16(pa1, (bf16x8){l1[0], l1[1], l1[2], l1[3], h1[0], h1[1], h1[2], h1[3]}, o[d0], 0, 0, 0);   \
        o[d0] = __builtin_amdgcn_mfma_f32_32x32x16_bf16(pa2, (bf16x8){l2[0], l2[1], l2[2], l2[3], h2[0], h2[1], h2[2], h2[3]}, o[d0], 0, 0, 0);   \
        o[d0] = __builtin_amdgcn_mfma_f32_32x32x16_bf16(pa3, (bf16x8){l3[0], l3[1], l3[2], l3[3], h3[0], h3[1], h3[2], h3[3]}, o[d0], 0, 0, 0); } while (0)
    PV_D0(0); PV_D0(1); PV_D0(2); PV_D0(3);
#undef PV_D0
#undef TRRD
}
struct Bases { const bf16* Q; const bf16* K; const bf16* V; const float* C; bf16* O; };
struct BlockRef { int hd, P0, jlo; };
constexpr int SEQ = 8192;
struct Seam { bf16x8 st_v0, st_v1, st_k0, st_k1; float cq; };
#define ROW(p, k0, rr) ((p) + (size_t)((k0) + (rr)) * D + sc)
#define VMW() asm volatile("s_waitcnt vmcnt(0)" ::: "memory")
#define VMWN(n) asm volatile("s_waitcnt vmcnt(%0)" :: "i"(n) : "memory")
#define SLOAD_H(Kp, Vp, Cp, k0) do { S.st_v0 = ld8(ROW(Vp, k0, sr)); S.st_v1 = ld8(ROW(Vp, k0, 32 + sr));              \
                         S.st_k0 = ld8(ROW(Kp, k0, sr)); S.st_k1 = ld8(ROW(Kp, k0, 32 + sr)); } while (0)
#define CLOAD(Cp, k0, bf) do { if (wid == 0) { int ln_ = lane; asm volatile("" : "+v"(ln_));   __builtin_amdgcn_global_load_lds((const unsigned*)((Cp) + (k0) + ln_), (LAS unsigned*)(CK_lds + (bf) * 256), 4, 0, 0); } } while (0)
#define SWRITE_HK(bf) do { *(bf16x8*)(K_lds + (bf) * SHM_K + kws) = S.st_k0; *(bf16x8*)(K_lds + (bf) * SHM_K + kws + 32 * 256) = S.st_k1; } while (0)
#define SWRITE_HV(bf) do { *(bf16x8*)(V_lds + (bf) * SHM_V + vst0) = S.st_v0; *(bf16x8*)(V_lds + (bf) * SHM_V + vst1) = S.st_v1; } while (0)
#define SWRITE_H(bf) do { SWRITE_HV(bf); SWRITE_HK(bf); } while (0)
__device__ __forceinline__ void fox_prime(const Bases& B, const BlockRef& cur, char* lds, Seam& S) {
    const int tid = threadIdx.x, wid = __builtin_amdgcn_readfirstlane(tid >> 6), lane = tid & 63, r32 = lane & 31, hi = lane >> 5;
    const int sr = tid >> 4, sc = (tid & 15) * 8, kws = KSWZ(sr, sc * 2); char* K_lds = lds + 2 * SHM_V; char* CK_lds = lds + OFF_CK;
    const int kb0 = cur.jlo * KVBLK;
    const bf16* curQ = B.Q + (size_t)cur.hd * SEQ * D; const bf16* curK = B.K + (size_t)cur.hd * SEQ * D; const bf16* curV = B.V + (size_t)cur.hd * SEQ * D; const float* curC = B.C + (size_t)cur.hd * SEQ;
    { char* Qw = lds + OFF_Q + wid * (QBLK * 256); bf16x8 qt[8];
#pragma unroll
      for (int d0 = 0; d0 < 8; ++d0) qt[d0] = ld8(curQ + (size_t)(cur.P0 + wid * QBLK + r32) * D + d0 * 16 + hi * 8);
#pragma unroll
      for (int d0 = 0; d0 < 8; ++d0) *(bf16x8*)(Qw + KSWZ(r32, ((d0 & 3) * 16 + hi * 8) * 2) + (d0 >> 2) * 128) = qt[d0]; }
    S.cq = curC[cur.P0 + wid * QBLK + r32];
    SLOAD_H(curK, curV, curC, kb0); CLOAD(curC, kb0, 0); VMW(); SWRITE_HK(0);
    __syncthreads();
}
__device__ __forceinline__ void fox_block(const Bases& B, const BlockRef& cur, const BlockRef& nxt, char* lds, Seam& S) {
    const int tid = threadIdx.x, wid = __builtin_amdgcn_readfirstlane(tid >> 6), lane = tid & 63, r32 = lane & 31, hi = lane >> 5;
    const int j_lo = cur.jlo, j_hi = (cur.P0 + QB - 1) / KVBLK + 1;
    const int NT = j_hi - j_lo;
    const int kbn = nxt.jlo * KVBLK;
    const int qlo = cur.P0 + wid * QBLK, qm = qlo + r32 - 4 * hi;
    char* V_lds = lds; char* K_lds = lds + 2 * SHM_V; char* CK_lds = lds + OFF_CK; char* Qw = lds + OFF_Q + wid * (QBLK * 256);
    float* ws = (float*)(lds + OFF_WS) + wid * 64; float* li_l = ws, * al_l = ws + 32;
    float m_reg = -1e30f, l_reg = 0; f32x16 o[4] = {};
    const float cq = S.cq;
    const int sr = tid >> 4, sc = (tid & 15) * 8, vst0 = v_st(sr, sc), vst1 = v_st(32 + sr, sc), kws = KSWZ(sr, sc * 2);
    const int vb0 = (int)(uintptr_t)V_lds + v_rd_base(lane);
    const bf16* Kh = B.K + (size_t)cur.hd * SEQ * D; const bf16* Vh = B.V + (size_t)cur.hd * SEQ * D; const float* Ch = B.C + (size_t)cur.hd * SEQ;
#define RESC(a) do { if (__any((a) < 1.f)) { if (hi == 0) al_l[r32] = (a); asm volatile("s_waitcnt lgkmcnt(0)" ::: "memory");              \
                     for (int d_ = 0; d_ < 4; ++d_) for (int r = 0; r < 16; ++r) o[d_][r] *= al_l[crow(r, hi)]; } } while (0)
#define KBASE(t) ((j_lo + (t)) * KVBLK)
#define MASKT(P0_, P1_, t) do { const int kb_ = KBASE(t); if (kb_ + KVBLK - 1 > qlo) mask_tile(P0_, P1_, qm - kb_); } while (0)
    constexpr int NQL = 9;
#define SEAM_K0() do { VMWN(NQL); SWRITE_HK(0); SBAR(); } while (0)
    f32x16 pA0, pA1, pB0, pB1; float mnA, mnB, alA, alB; bf16x8 pa0, pa1, pa2, pa3;
    SWRITE_HV(0); SBAR();
    if (NT > 1) { SLOAD_H(Kh, Vh, Ch, KBASE(1)); CLOAD(Ch, KBASE(1), 1); }
    SBAR(); qkt<0>(pA0, pA1, K_lds, CK_lds, r32, hi, Qw, cq);
    MASKT(pA0, pA1, 0); partialSM(pA0, pA1, m_reg, mnA, alA);
    if (NT > 1) { VMW(); SWRITE_H(1); }
    __syncthreads();
#define HALF_STEP(PX0, PX1, mnX, alX, PY0, PY1, alY, t, KB, VB, SB) do {                                                      \
        SBAR(); qkt<KB>(PX0, PX1, K_lds, CK_lds, r32, hi, Qw, cq);                                             \
        finishSM(PY0, PY1, alY, l_reg, pa0, pa1, pa2, pa3); SBAR();                                                           \
        if ((t) + 1 < NT) { SLOAD_H(Kh, Vh, Ch, KBASE((t) + 1)); CLOAD(Ch, KBASE((t) + 1), SB); SBAR(); }                                               \
        pv_tile<VB>(o, vb0, pa0, pa1, pa2, pa3); MASKT(PX0, PX1, (t)); partialSM(PX0, PX1, m_reg, mnX, alX);                                        \
        __syncthreads();                                                                                                      \
        if ((t) + 1 < NT) { VMW(); SWRITE_H(SB); }                                                                          \
        RESC(alX); __syncthreads(); } while (0)
    for (int t = 1; t + 1 < NT; t += 2) {
        HALF_STEP(pB0, pB1, mnB, alB, pA0, pA1, alA, t, 1, 0, 0);
        HALF_STEP(pA0, pA1, mnA, alA, pB0, pB1, alB, t + 1, 0, 1, 1);
    }
    const bool even = (NT & 1) == 0;
    if (even) { SBAR(); qkt<1>(pB0, pB1, K_lds, CK_lds, r32, hi, Qw, cq); SBAR(); }
    { const bf16* nK = B.K + (size_t)nxt.hd * SEQ * D; const bf16* nV = B.V + (size_t)nxt.hd * SEQ * D; const float* nC = B.C + (size_t)nxt.hd * SEQ;
      SLOAD_H(nK, nV, nC, kbn); CLOAD(nC, kbn, 0); } SBAR();
    finishSM(pA0, pA1, alA, l_reg, pa0, pa1, pa2, pa3); SBAR();
    pv_tile<0>(o, vb0, pa0, pa1, pa2, pa3);
    if (even) { MASKT(pB0, pB1, NT - 1); partialSM(pB0, pB1, m_reg, mnB, alB); __syncthreads(); RESC(alB);
        finishSM(pB0, pB1, alB, l_reg, pa0, pa1, pa2, pa3); SBAR(); pv_tile<1>(o, vb0, pa0, pa1, pa2, pa3); }
    SBAR();
    bf16x8 qt[8];
#pragma unroll
    for (int d0 = 0; d0 < 8; ++d0) qt[d0] = ld8(B.Q + (size_t)nxt.hd * SEQ * D + (size_t)(nxt.P0 + wid * QBLK + r32) * D + d0 * 16 + hi * 8);
    S.cq = (B.C + (size_t)nxt.hd * SEQ)[nxt.P0 + wid * QBLK + r32];
    SBAR(); SEAM_K0();
    if (hi == 0) li_l[r32] = l_reg; asm volatile("s_waitcnt lgkmcnt(0)" ::: "memory");
    float rli[16];
#pragma unroll
    for (int r = 0; r < 16; ++r) rli[r] = __builtin_amdgcn_rcpf(li_l[crow(r, hi)]);
    bf16* Ow = B.O + cur.hd * D + (size_t)(cur.P0 + wid * QBLK) * LDO;
#pragma unroll
    for (int r = 0; r < 16; ++r) { const int orow = crow(r, hi);
#pragma unroll
        for (int d0 = 0; d0 < 4; ++d0) { const float v = o[d0][r] * rli[r];
            const float vn = __shfl_xor(v, 1);
            if ((r32 & 1) == 0) *(unsigned*)(Ow + (size_t)orow * LDO + d0 * 32 + r32) = cvtpk(v, vn); } }
    SBAR();
#pragma unroll
    for (int d0 = 0; d0 < 8; ++d0) *(bf16x8*)(Qw + KSWZ(r32, ((d0 & 3) * 16 + hi * 8) * 2) + (d0 >> 2) * 128) = qt[d0];
    __syncthreads();
#undef RESC
#undef KBASE
#undef MASKT
#undef SEAM_K0
#undef HALF_STEP
}
#undef ROW
#undef VMW
#undef VMWN
#undef SLOAD_H
#undef CLOAD
#undef SWRITE_HK
#undef SWRITE_HV
#undef SWRITE_H
#undef KSWZ
#undef SBAR
}
#endif

#if !SIMPLE_ATTN
__device__ __forceinline__ int fox_jlo(const float* CS, const float* NRMP, int nwg, int hd, int P0, int lane) {
    float qm2 = 0.f, km2 = 0.f;
    for (int g = lane; g < nwg; g += 64) { qm2 = fmaxf(qm2, NRMP[(size_t)g * 32 + 2 * hd]); km2 = fmaxf(km2, NRMP[(size_t)g * 32 + 2 * hd + 1]); }
#pragma unroll
    for (int o = 1; o < 64; o <<= 1) { qm2 = fmaxf(qm2, __shfl_xor(qm2, o)); km2 = fmaxf(km2, __shfl_xor(km2, o)); }
    const float braw = 30.0f * 11.313708498984761f + 2.0f * sqrtf(qm2 * km2) * 1.0001f + 1.0f;
    const float* c = CS + (size_t)hd * S; const float c0 = c[P0]; const int jd = P0 >> 6;
    const int j0 = lane, j1 = lane + 64;
    const bool p0 = j0 <= jd && (c0 - c[64 * (j0 <= jd ? j0 : jd) + 63] > -braw), p1 = j1 <= jd && (c0 - c[64 * (j1 <= jd ? j1 : jd) + 63] > -braw);
    const unsigned long long b0 = __ballot(p0), b1 = __ballot(p1);
    int jl = b0 ? __builtin_ctzll(b0) : (b1 ? 64 + __builtin_ctzll(b1) : jd);
    return __builtin_amdgcn_readfirstlane(jl < jd ? jl : jd);
}
__device__ __forceinline__ fa::BlockRef fox_ref(int item, int pass, int jl0, int jl1) {
    const int y = item & 15, qb = pass ? 31 - y : y; fa::BlockRef r; r.hd = (item >> 4) & 15; r.P0 = qb * fa::QB; r.jlo = pass ? jl1 : jl0;
    return r;
}
__device__ __forceinline__ void fox_phase(Frame& F, char* lds, const bf16* Q, const bf16* K, const bf16* V, const float* CS, const float* NRM, bf16* MIX) {
    constexpr int NITEMS = FH * 16 * (PROBE_REPEAT == 61 ? 2 : 1);
    const int nw = F.G; int item = F.vcu; if (item >= NITEMS) return;
    int pass = 0;
    const fa::Bases B{Q, K, V, CS, MIX};
    int jl0 = fox_jlo(CS, NRM, F.G, (item >> 4) & 15, (item & 15) * fa::QB, F.lane), jl1 = fox_jlo(CS, NRM, F.G, (item >> 4) & 15, (31 - (item & 15)) * fa::QB, F.lane);
    fa::BlockRef cur = fox_ref(item, 0, jl0, jl1);
    fa::Seam Sm;
    fa::fox_prime(B, cur, lds, Sm);
    for (;;) {
        const bool more_pass = pass == 0, more_item = item + nw < NITEMS, last = !more_pass && !more_item;
        int itn = item, passn = pass + 1;
        if (!more_pass) { passn = 0; itn = more_item ? item + nw : item;
            if (more_item) { jl0 = fox_jlo(CS, NRM, F.G, (itn >> 4) & 15, (itn & 15) * fa::QB, F.lane); jl1 = fox_jlo(CS, NRM, F.G, (itn >> 4) & 15, (31 - (itn & 15)) * fa::QB, F.lane); } }
        const fa::BlockRef nxt = last ? cur : fox_ref(itn, passn, jl0, jl1);
        fa::fox_block(B, cur, nxt, lds, Sm);
        if (last) break;
        cur = nxt; item = itn; pass = passn;
    }
}
#endif

#if !SIMPLE_GLA
constexpr int GP_GLR = 0, GP_TOT = 4096, GP_QD = 6144, GP_KI = GP_QD + 64 * 528, GP_KET = GP_KI + 64 * 528, GP_AS = GP_KET + 256 * 144, GP_END = GP_AS + 64 * 144;
static_assert(GP_END <= 131072, "gla prep LDS");
__device__ __forceinline__ void gla_prep(Frame& F, const bf16* GQ, const bf16* GK, const bf16* GV, const float* FFGLR, const float* Wg, const float* bg,
                                         bf16* QDF, bf16* KEF, bf16* AMF, bf16* VTF, float* DL) {
    LAS float* glr = (LAS float*)(F.lds + GP_GLR); LAS float* tot = (LAS float*)(F.lds + GP_TOT);
    LAS unsigned char* QD = F.lds + GP_QD; LAS unsigned char* KI = F.lds + GP_KI; LAS unsigned char* KET = F.lds + GP_KET; LAS unsigned char* AS = F.lds + GP_AS;
    const int tid = F.tid, lane = F.lane, r = lane & 31, hh = lane >> 5;
    for (int job = F.vcu; job < NCH * GH; job += F.G) {
        const int n = job >> 2, h = job & 3, t0 = n * GC;
        __syncthreads();
        const int d = tid & 255, th = tid >> 8, col = h * GDK + d;
        unsigned short qraw[32], kraw[32]; float wg[16];
        {   const bf16* qp = GQ + (size_t)(t0 + th * 32) * GKW + col; const bf16* kp = GK + (size_t)(t0 + th * 32) * GKW + col;
#pragma unroll
            for (int i = 0; i < 32; ++i) { qraw[i] = qp[(size_t)i * GKW]; kraw[i] = kp[(size_t)i * GKW]; }
#pragma unroll
            for (int q = 0; q < 16; ++q) wg[q] = Wg[q * GKW + col]; }
        const float bgv = bg[col];
        for (int e = tid; e < 1024; e += NWAVES * 64) glr[e] = FFGLR[(size_t)(t0 + (e >> 4)) * 32 + 16 + (e & 15)];
        {
            const int c = tid, slice = c >> 5, cr = c & 31; const bf16* vp = GV + (size_t)t0 * GVW + h * GDV + c;
            bf16* vo = VTF + ((size_t)((n * 4 + h) * 16 + slice) * 4) * 512 + cr * 8;
#pragma unroll
            for (int ks = 0; ks < 4; ++ks)
#pragma unroll
                for (int half = 0; half < 2; ++half) { unsigned short e[8];
#pragma unroll
                    for (int j = 0; j < 8; ++j) e[j] = vp[(size_t)(16 * ks + 8 * half + j) * GVW];
                    v4u o; o.x = e[0] | ((unsigned)e[1] << 16); o.y = e[2] | ((unsigned)e[3] << 16); o.z = e[4] | ((unsigned)e[5] << 16); o.w = e[6] | ((unsigned)e[7] << 16);
                    *(GAS v4u*)(vo + ks * 512 + half * 256) = o; }
        }
        __syncthreads();
        float bcum[32];
        {   float run = 0.f;
#pragma unroll
            for (int i = 0; i < 32; ++i) { const int t = th * 32 + i; float z = bgv;
#pragma unroll
                for (int q = 0; q < 16; ++q) z += glr[t * 16 + q] * wg[q];
                run += log_sigmoid_f(z) * 0.0625f; bcum[i] = run; }
            tot[th * 256 + d] = run; }
        __syncthreads();
        const float tot0 = tot[d], blast = tot0 + tot[256 + d], boff = th ? tot0 : 0.f;
        if (th == 1) DL[(size_t)(n * 4 + h) * 256 + d] = __expf(blast);
        {   unsigned kew[4];
#pragma unroll
            for (int i = 0; i < 32; ++i) { const int t = th * 32 + i; const float bb = bcum[i] + boff, qv = bf2f(qraw[i]), kv = bf2f(kraw[i]);
                const float eb = __expf(bb), qd = qv * 0.0625f * eb, ki = kv * __expf(-bb), ke = kv * __expf(blast - bb);
                *(LAS unsigned short*)(QD + t * 528 + d * 2) = (unsigned short)f2bf(qd);
                *(LAS unsigned short*)(KI + t * 528 + d * 2) = (unsigned short)f2bf(ki);
                const unsigned kb = f2bf(ke);
                if (i & 1) kew[(i >> 1) & 3] |= kb << 16; else kew[(i >> 1) & 3] = kb;
                if ((i & 7) == 7) { v4u o; o.x = kew[0]; o.y = kew[1]; o.z = kew[2]; o.w = kew[3]; *(LAS v4u*)(KET + d * 144 + (t - 7) * 2) = o; } }
        }
        __syncthreads();
        {
            const int r16 = lane & 15, g = lane >> 4;
#pragma unroll
            for (int tt = 0; tt < 2; ++tt) { const int T = 2 * F.wave + tt, mti = T >> 2, nti = T & 3;
                f32x4 acc = {0.f, 0.f, 0.f, 0.f};
#pragma unroll
                for (int ks = 0; ks < 8; ++ks) { const bf16x8 a = *(const LAS bf16x8*)(QD + (mti * 16 + r16) * 528 + (ks * 32 + 8 * g) * 2), b = *(const LAS bf16x8*)(KI + (nti * 16 + r16) * 528 + (ks * 32 + 8 * g) * 2);
                    acc = __builtin_amdgcn_mfma_f32_16x16x32_bf16(a, b, acc, 0, 0, 0); }
#pragma unroll
                for (int i = 0; i < 4; ++i) { const int tq = mti * 16 + 4 * g + i, tk = nti * 16 + r16;
                    *(LAS unsigned short*)(AS + tq * 144 + tk * 2) = (unsigned short)f2bf(tk <= tq ? acc[i] : 0.f); } }
        }
        __syncthreads();
        {   const size_t jb = (size_t)(n * 4 + h);
            { const int f = tid >> 6, mt = f >> 2, ks = f & 3;
              *(GAS v4u*)(AMF + (jb * 8 + f) * 512 + lane * 8) = *(const LAS v4u*)(AS + (32 * mt + r) * 144 + (16 * ks + 8 * hh) * 2); }
#pragma unroll
            for (int i = 0; i < 4; ++i) { const int f = (tid >> 6) + 8 * i;
                { const int w = f >> 2, mt = (f >> 1) & 1, s = f & 1; const LAS unsigned char* src = QD + (32 * mt + r) * 528 + (32 * w + 16 * s + 4 * hh) * 2;
                  const v2u lo = *(const LAS v2u*)src, hi = *(const LAS v2u*)(src + 16); v4u o; o.x = lo.x; o.y = lo.y; o.z = hi.x; o.w = hi.y;
                  *(GAS v4u*)(QDF + (jb * 32 + f) * 512 + lane * 8) = o; }
                { const int w = f >> 2, ks = f & 3;
                  *(GAS v4u*)(KEF + (jb * 32 + f) * 512 + lane * 8) = *(const LAS v4u*)(KET + (32 * w + r) * 144 + (16 * ks + 8 * hh) * 2); } }
        }
    }
    __syncthreads();
}

struct GlaSet { bf16x8 qd[4], ke[4], vt[4], am, vx; f32x4 dl[4]; };
constexpr int GS_PW = 32 * 68, GS_PB = 8 * GS_PW;
__device__ __forceinline__ bf16x8 pack_bf8(const f32x16& x, int s) {
    v4u p; p.x = pk2(x[8 * s], x[8 * s + 1]); p.y = pk2(x[8 * s + 2], x[8 * s + 3]); p.z = pk2(x[8 * s + 4], x[8 * s + 5]); p.w = pk2(x[8 * s + 6], x[8 * s + 7]);
    return __builtin_bit_cast(bf16x8, p);
}

constexpr int GG = 4, GN = NCH / GG;
static_assert(GN == 32, "pass-1 unroll");
struct GlaSet1 { bf16x8 ke[4], vt[4]; f32x4 dl[4]; };
__device__ __forceinline__ void gla_pass1(Frame& F, const bf16* KEF, const bf16* VTF, const float* DL, float* UG, float* DG) {
    const int lane = F.lane, w = F.wave, hh = lane >> 5;
    for (int job = F.vcu; job < GH * 16 * (GG - 1); job += F.G) {
        const int h = (job >> 4) & 3, sl = job & 15, gq = job >> 6, n0 = gq * GN;
        const GAS char* kb = (const GAS char*)KEF + ((size_t)h * 32 + w * 4) * 1024;
        const GAS char* vb = (const GAS char*)VTF + (((size_t)h * 16 + sl) * 4) * 1024;
        const GAS char* db = (const GAS char*)DL + (h * 256 + 32 * w) * 4;
        unsigned lo16 = lane * 16, lod = hh * 16;
        asm volatile("" : "+v"(lo16), "+v"(lod));
        f32x16 St = {}; f32x4 dp[4];
#pragma unroll
        for (int g_ = 0; g_ < 4; ++g_) dp[g_] = (f32x4){1.f, 1.f, 1.f, 1.f};
        GlaSet1 A, B, C;
#define G1_LOAD(X, n_) do { const size_t n__ = (size_t)(n_); const GAS char* k__ = kb + n__ * 131072; const GAS char* v__ = vb + n__ * 262144; const GAS char* d__ = db + n__ * 4096; \
            _Pragma("unroll") for (int i_ = 0; i_ < 4; ++i_) { X.ke[i_] = *(const GAS bf16x8*)(k__ + i_ * 1024 + lo16); X.vt[i_] = *(const GAS bf16x8*)(v__ + i_ * 1024 + lo16); X.dl[i_] = *(const GAS f32x4*)(d__ + 32 * i_ + lod); } } while (0)
#define G1_STEP(X) do { _Pragma("unroll") for (int g_ = 0; g_ < 4; ++g_) { dp[g_] = dp[g_] * X.dl[g_]; _Pragma("unroll") for (int i_ = 0; i_ < 4; ++i_) St[4 * g_ + i_] *= X.dl[g_][i_]; } \
            _Pragma("unroll") for (int ks_ = 0; ks_ < 4; ++ks_) St = __builtin_amdgcn_mfma_f32_32x32x16_bf16(X.ke[ks_], X.vt[ks_], St, 0, 0, 0); } while (0)
        G1_LOAD(A, n0); G1_LOAD(B, n0 + 1);
        for (int n = n0; n < n0 + GN - 2; n += 3) {
            G1_LOAD(C, n + 2); G1_STEP(A);
            G1_LOAD(A, n + 3); G1_STEP(B);
            G1_LOAD(B, n + 4); G1_STEP(C);
        }
        G1_STEP(A); G1_STEP(B);
#undef G1_LOAD
#undef G1_STEP
        GAS char* ub = (GAS char*)UG + ((((size_t)h * 16 + sl) * (GG - 1) + gq) * 8 + w) * 4096;
#pragma unroll
        for (int g_ = 0; g_ < 4; ++g_) *(GAS f32x4*)(ub + g_ * 1024 + lo16) = (f32x4){St[4 * g_], St[4 * g_ + 1], St[4 * g_ + 2], St[4 * g_ + 3]};
        if (sl == 0 && (lane & 31) == 0) { GAS char* dgb = (GAS char*)DG + (((size_t)h * (GG - 1) + gq) * 256 + 32 * w) * 4;
#pragma unroll
            for (int g_ = 0; g_ < 4; ++g_) *(GAS f32x4*)(dgb + 32 * g_ + lod) = dp[g_]; }
    }
}
__device__ __forceinline__ void gla_scan(Frame& F, const bf16* QDF, const bf16* KEF, const bf16* AMF, const bf16* VTF, const float* DL, const float* UG, const float* DG, float* OGLA, int jfirst, int jstride) {
    LAS float* P = (LAS float*)(F.lds + RING_OFF);
    const int tid = F.tid, lane = F.lane, w = F.wave, r = lane & 31, hh = lane >> 5;
    for (int job = jfirst; job < GH * 16 * GG; job += jstride) {
        const int h = (job >> 4) & 3, sl = job & 15, gq = job >> 6, n0 = gq * GN;
        const GAS char* qb = (const GAS char*)QDF + ((size_t)h * 32 + w * 4) * 1024;
        const GAS char* kb = (const GAS char*)KEF + ((size_t)h * 32 + w * 4) * 1024;
        const GAS char* ab = (const GAS char*)AMF + ((size_t)h * 8 + (w & 1) * 4 + (w >> 1)) * 1024;
        const GAS char* vb = (const GAS char*)VTF + (((size_t)h * 16 + sl) * 4) * 1024;
        const GAS char* db = (const GAS char*)DL + (h * 256 + 32 * w) * 4;
        GAS char* ob = (GAS char*)OGLA + ((size_t)h * GDV + sl * 32) * 2;
        unsigned lo16 = lane * 16, lod = hh * 16, loo = ((tid >> 5) * 4 * GVW + (tid & 31)) * 2;
        asm volatile("" : "+v"(lo16), "+v"(lod), "+v"(loo));
        f32x16 St = {};
        for (int j = 0; j < gq; ++j) {
            const GAS char* ub = (const GAS char*)UG + ((((size_t)h * 16 + sl) * (GG - 1) + j) * 8 + w) * 4096; const GAS char* dgb = (const GAS char*)DG + (((size_t)h * (GG - 1) + j) * 256 + 32 * w) * 4;
#pragma unroll
            for (int g_ = 0; g_ < 4; ++g_) { const f32x4 u_ = *(const GAS f32x4*)(ub + g_ * 1024 + lo16), d_ = *(const GAS f32x4*)(dgb + 32 * g_ + lod);
#pragma unroll
                for (int i_ = 0; i_ < 4; ++i_) St[4 * g_ + i_] = St[4 * g_ + i_] * d_[i_] + u_[i_]; } }
        GlaSet A, B;
#define GLA_LOAD(X, n_) do { const size_t n__ = (size_t)(n_); \
            const GAS char* q__ = qb + n__ * 131072; const GAS char* k__ = kb + n__ * 131072; const GAS char* v__ = vb + n__ * 262144; const GAS char* d__ = db + n__ * 4096; \
            _Pragma("unroll") for (int i_ = 0; i_ < 4; ++i_) { X.qd[i_] = *(const GAS bf16x8*)(q__ + i_ * 1024 + lo16); X.ke[i_] = *(const GAS bf16x8*)(k__ + i_ * 1024 + lo16); \
                X.vt[i_] = *(const GAS bf16x8*)(v__ + i_ * 1024 + lo16); X.dl[i_] = *(const GAS f32x4*)(d__ + 32 * i_ + lod); } \
            X.am = *(const GAS bf16x8*)(ab + n__ * 32768 + lo16); X.vx = *(const GAS bf16x8*)(v__ + (w >> 1) * 1024 + lo16); } while (0)
#define GLA_COMPUTE(X) do { \
            const bf16x8 xs0 = pack_bf8(St, 0), xs1 = pack_bf8(St, 1); O0 = (f32x16){}; O1 = (f32x16){}; \
            O0 = __builtin_amdgcn_mfma_f32_32x32x16_bf16(X.qd[0], xs0, O0, 0, 0, 0); O1 = __builtin_amdgcn_mfma_f32_32x32x16_bf16(X.qd[2], xs0, O1, 0, 0, 0); \
            O0 = __builtin_amdgcn_mfma_f32_32x32x16_bf16(X.qd[1], xs1, O0, 0, 0, 0); O1 = __builtin_amdgcn_mfma_f32_32x32x16_bf16(X.qd[3], xs1, O1, 0, 0, 0); \
            if (w & 1) O1 = __builtin_amdgcn_mfma_f32_32x32x16_bf16(X.am, X.vx, O1, 0, 0, 0); else O0 = __builtin_amdgcn_mfma_f32_32x32x16_bf16(X.am, X.vx, O0, 0, 0, 0); \
            _Pragma("unroll") for (int g_ = 0; g_ < 4; ++g_) _Pragma("unroll") for (int i_ = 0; i_ < 4; ++i_) St[4 * g_ + i_] *= X.dl[g_][i_]; \
            _Pragma("unroll") for (int ks_ = 0; ks_ < 4; ++ks_) St = __builtin_amdgcn_mfma_f32_32x32x16_bf16(X.ke[ks_], X.vt[ks_], St, 0, 0, 0); } while (0)
#define GLA_WRITE(buf_) do { LAS float* Pw = P + (buf_) * GS_PB + w * GS_PW + r * 68 + 4 * hh; \
              _Pragma("unroll") for (int g_ = 0; g_ < 4; ++g_) { *(LAS f32x4*)(Pw + 8 * g_) = (f32x4){O0[4 * g_], O0[4 * g_ + 1], O0[4 * g_ + 2], O0[4 * g_ + 3]}; \
                  *(LAS f32x4*)(Pw + 32 + 8 * g_) = (f32x4){O1[4 * g_], O1[4 * g_ + 1], O1[4 * g_ + 2], O1[4 * g_ + 3]}; } } while (0)
#define GLA_REDUCE(n_) do { const LAS float* Pr = P + ((n_) & 1) * GS_PB + (tid & 31) * 68 + (tid >> 5) * 4; f32x4 s_ = *(const LAS f32x4*)Pr; \
              _Pragma("unroll") for (int w_ = 1; w_ < 8; ++w_) s_ += *(const LAS f32x4*)(Pr + w_ * GS_PW); \
              GAS char* o_ = ob + (size_t)(n_) * (GC * GVW * 2); const unsigned p01_ = pk2(s_[0], s_[1]), p23_ = pk2(s_[2], s_[3]); \
              *(GAS unsigned short*)(o_ + loo) = (unsigned short)p01_; *(GAS unsigned short*)(o_ + GVW * 2 + loo) = (unsigned short)(p01_ >> 16); \
              *(GAS unsigned short*)(o_ + 2 * GVW * 2 + loo) = (unsigned short)p23_; *(GAS unsigned short*)(o_ + 3 * GVW * 2 + loo) = (unsigned short)(p23_ >> 16); } while (0)
#define GLA_BAR() do { asm volatile("s_waitcnt lgkmcnt(0)" ::: "memory"); __builtin_amdgcn_s_barrier(); asm volatile("" ::: "memory"); } while (0)
        f32x16 O0, O1;
        __syncthreads();
        GLA_LOAD(A, n0); GLA_LOAD(B, n0 + 1);
        GLA_COMPUTE(A); GLA_WRITE(0);
        for (int n = n0; n < n0 + GN; n += 2) {
            if (n + 2 < n0 + GN) GLA_LOAD(A, n + 2);
            GLA_COMPUTE(B);
            GLA_BAR(); GLA_REDUCE(n); GLA_WRITE(1);
            if (n + 3 < n0 + GN) GLA_LOAD(B, n + 3);
            if (n + 2 < n0 + GN) GLA_COMPUTE(A);
            GLA_BAR(); GLA_REDUCE(n + 1); if (n + 2 < n0 + GN) GLA_WRITE(0);
        }
#undef GLA_COMPUTE
#undef GLA_BAR
#undef GLA_WRITE
#undef GLA_REDUCE
#undef GLA_LOAD
    }
    __syncthreads();
}
#endif

struct Args { const float* in[23]; float* out; unsigned char* ws; int ph_lo, ph_hi, li, pad; };
__global__ void __launch_bounds__(NWAVES * 64, 2) fwd(Args args) {
    extern __shared__ __attribute__((aligned(16))) unsigned char lds[];
    Frame F;
    F.lds = (LAS unsigned char*)lds;
    F.MISC = (volatile LAS unsigned*)(F.lds + MISC_OFF);
    F.tid = threadIdx.x; F.lane = F.tid & 63; F.wave = __builtin_amdgcn_readfirstlane(F.tid >> 6);
    F.G = gridDim.x; { const int bx = blockIdx.x; F.vcu = (F.G % 8 == 0) ? (bx % 8) * (F.G / 8) + bx / 8 : bx; }
    unsigned char* ws = args.ws;
    F.ctl = (gu32*)(ws + WS_CTL);
    for (int u = F.tid; u < (LDS_BYTES - LDSCTL_OFF) / 4; u += NWAVES * 64) ((LAS unsigned*)(F.lds + LDSCTL_OFF))[u] = 0u;
    __syncthreads();
    XcdBarrier bar; bar.bar = (unsigned*)(F.ctl + CW_BAR); bar.x = 0; bar.st = nullptr;
    if (ONE_LAUNCH) bar = xcd_barrier_post((unsigned*)(F.ctl + CW_BAR), F.MISC + 8);
#define GRID_BAR() do { if (ONE_LAUNCH) xcd_barrier(bar); } while (0)
    const int lo = args.ph_lo, hi = args.ph_hi; long long amp_t0 = 0; (void)amp_t0;
#define IN(k) (lo <= (k) && (k) < hi)
#define PHASE_BEGIN() do { int t_ = threadIdx.x; asm volatile("" : "+v"(t_)); F.tid = t_; F.lane = t_ & 63; F.wave = __builtin_amdgcn_readfirstlane(t_ >> 6); } while (0)
#define BOTH(k) (IN(k) && IN((k) + 1))
#define AMP_T0(k) do { if ((PROBE_AMP) == (k)) amp_t0 = wall_clock64(); } while (0)
#define AMP_SPIN(k) do { if ((PROBE_AMP) == (k) && blockIdx.x == 0) { if (threadIdx.x == 0) { const long long t1_ = wall_clock64(), d_ = 4 * (t1_ - amp_t0); while (wall_clock64() - t1_ < d_) __builtin_amdgcn_s_sleep(8); } __syncthreads(); } } while (0)
#define REP(k) for (int rep_ = 0; rep_ < ((PROBE_REPEAT) == (k) ? 2 : 1); ++rep_)
#define gw (F.vcu * NWAVES + F.wave)
#define NGW (F.G * NWAVES)
    const float* x = args.in[0];
    bf16* W1GU = (bf16*)(ws + WS_W1GU); bf16* W1D = (bf16*)(ws + WS_W1D); bf16* W2GU = (bf16*)(ws + WS_W2GU); bf16* W2D = (bf16*)(ws + WS_W2D);
    bf16* WIN = (bf16*)(ws + WS_WIN); bf16* WSK = (bf16*)(ws + WS_WSK); bf16* WO = (bf16*)(ws + WS_WO); bf16* WPG = (bf16*)(ws + WS_WPG); bf16* WPP = (bf16*)(ws + WS_WPP);
    bf16* Hb = (bf16*)(ws + WS_H); bf16* Fb = (bf16*)(ws + WS_F); bf16* XN = (bf16*)(ws + WS_XN); bf16* MIX = (bf16*)(ws + WS_MIX); bf16* ACT = (bf16*)(ws + WS_ACT);
    bf16* Qb = (bf16*)(ws + WS_Q); bf16* Kb = (bf16*)(ws + WS_K); bf16* Vb = (bf16*)(ws + WS_V);
    bf16* GQ = (bf16*)(ws + WS_GQ); bf16* GK = (bf16*)(ws + WS_GK); bf16* GV = (bf16*)(ws + WS_GV); bf16* GR = (bf16*)(ws + WS_GR);
    float* CF = (float*)(ws + WS_MISC); float* FFGLR = (float*)(ws + WS_MISC + 1 * MiB); float* RSTDE = (float*)(ws + WS_WSK + 512 * 1024);
    float* OGLA = (float*)(ws + WS_OGLA); bf16* ERAW = (bf16*)(ws + WS_ERAW); bf16* PBF = (bf16*)(ws + WS_PBF);

    if (IN(0)) { PHASE_BEGIN(); AMP_T0(0); REP(0) {
        convert_items(F, args.in, ws, 0, CV_B - CV_TAIL, gw, NGW);
        { f32x4 gq[16];
#pragma unroll
          for (int j = 0; j < 16; ++j) gq[j] = ((const GAS f32x4*)args.in[2])[F.lane + 64 * j];
          for (int m = gw; m < S; m += NGW) norm_row_to_bf16(x + (size_t)m * DM, gq, XN + (size_t)m * DM, F.lane); }
        { const float* p = args.in[1]; const int gt = F.vcu * NWAVES * 64 + F.tid, NT = F.G * NWAVES * 64;
          for (int i = gt; i < S * PLE / 4; i += 4 * NT) { f32x4 v[4];
#pragma unroll
              for (int u = 0; u < 4; ++u) if (i + u * NT < S * PLE / 4) v[u] = ((const GAS f32x4*)p)[i + u * NT];
#pragma unroll
              for (int u = 0; u < 4; ++u) if (i + u * NT < S * PLE / 4) { v2u w; w.x = pk2(v[u].x, v[u].y); w.y = pk2(v[u].z, v[u].w); ((GAS v2u*)PBF)[i + u * NT] = w; } } }
        }
        if (BOTH(0)) { GRID_BAR(); AMP_SPIN(0); }
    }
    if (IN(1)) { PHASE_BEGIN(); AMP_T0(1); REP(1) {
        pg8::Gemm g{XN, W1GU, S, 2 * DFF, DM}; pg8::StaticOrder So; So.init(S, 2 * DFF, F.G, (int)blockIdx.x);
        pg8::EpiSwiGLU E{ACT, DFF};
        pg8::gemm_phase<pg8::EpiSwiGLU, pg8::StaticOrder, PG_ALIGN, PG_SP2>(F.lds + RING_OFF, g, So, E);
        { constexpr int NFULL = ((S / 256) * (2 * DFF / 256)) % 256;
          if (F.G == 256 && (int)blockIdx.x >= NFULL) convert_items(F, args.in, ws, CV_B - CV_TAIL, CV_B, ((int)blockIdx.x - NFULL) * NWAVES + F.wave, (256 - NFULL) * NWAVES);
          else if (F.G != 256) convert_items(F, args.in, ws, CV_B - CV_TAIL, CV_B, gw, NGW); }
        }
        if (BOTH(1)) { GRID_BAR(); AMP_SPIN(1); }
    }
    if (IN(2)) { PHASE_BEGIN(); AMP_T0(2); REP(2) {
        pg8::Gemm g{ACT, W1D, S, DM, DFF}; pg8::StaticOrder So; So.init(S, DM, F.G, (int)blockIdx.x);
        pg8::EpiBf16 E{Fb, DM};
        pg8::gemm_phase<pg8::EpiBf16, pg8::StaticOrder, PG_ALIGN, PG_SP2>(F.lds + RING_OFF, g, So, E);
        }
        if (BOTH(2)) { GRID_BAR(); AMP_SPIN(2); }
    }
    if (IN(3)) { PHASE_BEGIN(); AMP_T0(3); REP(3) {
        stage_gains(F, args.in[6], args.in[7]);
        for (int m = gw; m < S; m += NGW) resid_row<true, false>(F, Fb + (size_t)m * DM, x + (size_t)m * DM, 0.5f, Hb + (size_t)m * DM, XN + (size_t)m * DM, F.lane);
        }
        if (BOTH(3)) { GRID_BAR(); AMP_SPIN(3); }
    }
    if (IN(4)) { PHASE_BEGIN(); AMP_T0(4); REP(4) {
        pg8::Gemm g{XN, WIN, S, NWIN, DM}; pg8::StaticOrder So; So.init(S, NWIN, F.G, (int)blockIdx.x);
        pg8::EpiWin E{Qb, S};
        pg8::gemm_phase<pg8::EpiWin, pg8::StaticOrder, PG_ALIGN, PG_SP2>(F.lds + RING_OFF, g, So, E);
        skinny_gemm(F, XN, WSK, FFGLR);
        }
        if (BOTH(4)) { GRID_BAR(); AMP_SPIN(4); }
    }
    if (IN(5)) { PHASE_BEGIN(); AMP_T0(5); REP(5) {
        fox_prep(F, FFGLR, args.in[9], CF);
#if !SIMPLE_ATTN
        fox_norms(F, Qb, Kb, (float*)(ws + WS_MISC + 3 * MiB));
#endif
#if !SIMPLE_GLA
        gla_prep(F, GQ, GK, GV, FFGLR, args.in[10], args.in[11], (bf16*)(ws + WS_QDEC), (bf16*)(ws + WS_KTE), (bf16*)(ws + WS_AM), (bf16*)(ws + WS_VT), (float*)(ws + WS_MISC + 2560 * 1024));
#endif
        }
        if (BOTH(5)) { GRID_BAR(); AMP_SPIN(5); }
    }
    if (IN(6)) { PHASE_BEGIN(); AMP_T0(6); REP(6) {
#if SIMPLE_GLA || SIMPLE_ATTN
#error "the two-level scan build needs the MFMA attention and GLA bodies"
#endif
        gla_pass1(F, (const bf16*)(ws + WS_KTE), (const bf16*)(ws + WS_VT), (const float*)(ws + WS_MISC + 2560 * 1024), (float*)(ws + WS_UG), (float*)(ws + WS_DG));
        __syncthreads();
        fox_phase(F, (char*)lds + RING_OFF, Qb, Kb, Vb, CF, (const float*)(ws + WS_MISC + 3 * MiB), MIX);
        GRID_BAR();
        __syncthreads();
        if ((F.vcu & 1) == 0) gla_scan(F, (const bf16*)(ws + WS_QDEC), (const bf16*)(ws + WS_KTE), (const bf16*)(ws + WS_AM), (const bf16*)(ws + WS_VT), (const float*)(ws + WS_MISC + 2560 * 1024), (const float*)(ws + WS_UG), (const float*)(ws + WS_DG), OGLA, F.vcu >> 1, (F.G + 1) >> 1);
        __syncthreads();
        convert_dynamic(F, args.in, ws, CV_B, CV_D2 - CV_TAIL);
        }
        if (BOTH(6)) { GRID_BAR(); AMP_SPIN(6); }
    }
    if (IN(7)) { PHASE_BEGIN(); AMP_T0(7); REP(7) {
        gla_post(F, OGLA, GR, args.in[12], MIX);
        __syncthreads();
        { pg8::Gemm g{PBF, WPP, S, DM, PLE}; pg8::StaticOrder So; So.init(S, DM, F.G, (int)blockIdx.x);
          pg8::EpiBf16Part E{ERAW, DM, (float*)(ws + WS_EPART)};
          pg8::gemm_phase<pg8::EpiBf16Part, pg8::StaticOrder, PG_ALIGN, PG_SP2>(F.lds + RING_OFF, g, So, E); }
        }
        if (BOTH(7)) { GRID_BAR(); AMP_SPIN(7); }
    }
    if (IN(8)) { PHASE_BEGIN(); AMP_T0(8); REP(8) {
        pg8::Gemm g{MIX, WO, S, DM, DM}; pg8::StaticOrder So; So.init(S, DM, F.G, (int)blockIdx.x);
        pg8::EpiBf16 E{Fb, DM};
        pg8::gemm_phase<pg8::EpiBf16, pg8::StaticOrder, PG_ALIGN, PG_SP2>(F.lds + RING_OFF, g, So, E);
        }
        if (BOTH(8)) { GRID_BAR(); AMP_SPIN(8); }
    }
    if (IN(9)) { PHASE_BEGIN(); AMP_T0(9); REP(9) {
        stage_gains(F, args.in[14], args.in[15]);
        for (int m = gw; m < S; m += NGW) resid_row<true, true>(F, Fb + (size_t)m * DM, Hb + (size_t)m * DM, 1.0f, Hb + (size_t)m * DM, XN + (size_t)m * DM, F.lane);
        }
        if (BOTH(9)) { GRID_BAR(); AMP_SPIN(9); }
    }
    if (IN(10)) { PHASE_BEGIN(); AMP_T0(10); REP(10) {
        pg8::Gemm g{XN, W2GU, S, 2 * DFF, DM}; pg8::StaticOrder So; So.init(S, 2 * DFF, F.G, (int)blockIdx.x);
        pg8::EpiSwiGLU E{ACT, DFF};
        pg8::gemm_phase<pg8::EpiSwiGLU, pg8::StaticOrder, PG_ALIGN, PG_SP2>(F.lds + RING_OFF, g, So, E);
        { constexpr int NFULL = ((S / 256) * (2 * DFF / 256)) % 256;
          if (F.G == 256 && (int)blockIdx.x >= NFULL) convert_items(F, args.in, ws, CV_D2 - CV_TAIL, CV_D2, ((int)blockIdx.x - NFULL) * NWAVES + F.wave, (256 - NFULL) * NWAVES);
          else if (F.G != 256) convert_items(F, args.in, ws, CV_D2 - CV_TAIL, CV_D2, gw, NGW); }
        }
        if (BOTH(10)) { GRID_BAR(); AMP_SPIN(10); }
    }
    if (IN(11)) { PHASE_BEGIN(); AMP_T0(11); REP(11) {
        { pg8::Gemm g{ACT, W2D, S, DM, DFF}; pg8::StaticOrder So; So.init(S, DM, F.G, (int)blockIdx.x);
          pg8::EpiBf16 E{Fb, DM};
          pg8::gemm_phase<pg8::EpiBf16, pg8::StaticOrder, PG_ALIGN, PG_SP2>(F.lds + RING_OFF, g, So, E); }
        }
        if (BOTH(11)) { GRID_BAR(); AMP_SPIN(11); }
    }
    if (IN(12)) { PHASE_BEGIN(); AMP_T0(12); REP(12) {
        stage_gains(F, args.in[19], args.in[19]);
        for (int m = gw; m < S; m += NGW) {
            const float ep = ((const GAS float*)(ws + WS_EPART))[(size_t)m * 64 + F.lane];
            resid_row<false, true>(F, Fb + (size_t)m * DM, Hb + (size_t)m * DM, 0.5f, Hb + (size_t)m * DM, XN + (size_t)m * DM, F.lane);
            float s = ep;
            s = wave_sum(s); if (F.lane == 0) RSTDE[m] = 1.f / sqrtf(s * (1.f / DM) + EPS);
        }
        }
        if (BOTH(12)) { GRID_BAR(); AMP_SPIN(12); }
    }
    if (IN(13)) { PHASE_BEGIN(); AMP_T0(13); REP(13) {
        pg8::Gemm g{XN, WPG, S, DM, DM}; pg8::StaticOrder So; So.init(S, DM, F.G, (int)blockIdx.x);
        pg8::EpiPleGate E{(const pg8::bf16_t*)XN, ERAW, RSTDE, args.in[21], args.out, DM};
        pg8::gemm_phase<pg8::EpiPleGate, pg8::StaticOrder, PG_ALIGN, PG_SP2>(F.lds + RING_OFF, g, So, E);
        }
        if ((PROBE_AMP) == 13) { GRID_BAR(); AMP_SPIN(13); }
    }
#undef IN
#undef gw
#undef NGW
#undef PHASE_BEGIN
#undef BOTH
#undef GRID_BAR
}

extern "C" void kernel_launch(void* const* d_in, const int* in_sizes, int n_in, void* d_out, int out_size, void* d_ws, size_t ws_size, hipStream_t stream) {
    static int grid = 0;
    if (grid == 0) {
        if (n_in != 23 || in_sizes[0] != S * DM || out_size != S * DM || ws_size < WS_END) {
            fprintf(stderr, "kernel_launch: built for 23 inputs, x/out of %d floats, >= %zu bytes of workspace; got n_in %d, in0 %d, out %d, ws %zu; nothing launched\n", S * DM, (size_t)WS_END, n_in, n_in > 0 ? in_sizes[0] : -1, out_size, ws_size);
            grid = -1; return; }
        int dev = 0, cus = 0, per_cu = 0;
        if (hipGetDevice(&dev) != hipSuccess || hipDeviceGetAttribute(&cus, hipDeviceAttributeMultiprocessorCount, dev) != hipSuccess) { fprintf(stderr, "kernel_launch: device query failed\n"); grid = -1; return; }
        if (hipFuncSetAttribute((const void*)fwd, hipFuncAttributeMaxDynamicSharedMemorySize, LDS_BYTES) != hipSuccess) { fprintf(stderr, "kernel_launch: hipFuncSetAttribute failed\n"); grid = -1; return; }
        if (hipOccupancyMaxActiveBlocksPerMultiprocessor(&per_cu, (const void*)fwd, NWAVES * 64, LDS_BYTES) != hipSuccess || per_cu < 1)
            fprintf(stderr, "kernel_launch: note: occupancy query reports %d workgroups per CU\n", per_cu);
        (void)hipGetLastError();
        grid = cus;
    }
    if (grid < 0) return;
    if (hipMemsetAsync((char*)d_ws + WS_CTL, 0, CTL_ZERO_BYTES, stream) != hipSuccess) { fprintf(stderr, "kernel_launch: hipMemsetAsync failed\n"); return; }
    Args a{};
    for (int i = 0; i < 23; ++i) a.in[i] = (const float*)d_in[i];
    a.out = (float*)d_out; a.ws = (unsigned char*)d_ws;
    if (ONE_LAUNCH) {
        a.ph_lo = 0; a.ph_hi = N_PHASES; a.li = 0;
        hipLaunchKernelGGL(fwd, dim3(grid), dim3(NWAVES * 64), LDS_BYTES, stream, a);
    } else {
        for (int li = 0; li < N_PHASES; ++li) { a.ph_lo = li; a.ph_hi = li + 1; a.li = li;
            hipLaunchKernelGGL(fwd, dim3(grid), dim3(NWAVES * 64), LDS_BYTES, stream, a); }
    }
    const hipError_t le = hipPeekAtLastError();
    if (le != hipSuccess) fprintf(stderr, "kernel_launch: launch failed: %s\n", hipGetErrorName(le));
}
```

```cpp
#include <hip/hip_runtime.h>
#include <cstdio>
#include <cstdint>
namespace pg8 {
#define PG8_LAS __attribute__((address_space(3)))
typedef unsigned short bf16_t;
typedef short bf16x8 __attribute__((ext_vector_type(8)));
typedef float f32x4 __attribute__((ext_vector_type(4)));
typedef unsigned u32x4 __attribute__((ext_vector_type(4)));
constexpr int BM = 256, BK = 64, HALF = 128, HTB = HALF * BK * 2  , STAGE_BYTES = 8 * HTB, NXCD = 8, WGM = 8;

__host__ __device__ __forceinline__ int lds_byte(int r, int c) { const int st = (r >> 4) * 2 + (c >> 5), rr = r & 15, cc = c & 31, ob = rr * 64 + cc * 2; return st * 1024 + (ob ^ (((ob >> 9) & 1) << 5)); }
__host__ __device__ __forceinline__ void stage_rc(int b, int& R, int& C) { const int st = b / 1024, sb = b % 1024, swz = sb ^ (((sb >> 9) & 1) << 5); R = (st >> 1) * 16 + swz / 64; C = (st & 1) * 32 + (swz % 64) / 2; }
__host__ __device__ __forceinline__ int perm32(int rho) { const int n = rho >> 4, i = rho & 15; return 8 * (i >> 2) + 4 * n + (i & 3); }

struct Unit { int pm, pn; };
struct Gemm { const bf16_t* A; const bf16_t* Bt; int M, N, K; };

struct StaticOrder {
    int nM, nN, nwg, G, c;
    __host__ __device__ void init(int M, int N, int G_, int c_) { nM = M / BM; nN = N / BM; nwg = nM * nN; G = G_; c = c_; }
    __host__ __device__ bool next(int i, Unit& u) const {
        const long L = (long)i * G + c; if (L >= nwg) return false;
        int wgid = (int)L; { const int q = nwg / NXCD, r = nwg % NXCD, xcd = wgid % NXCD, off = wgid / NXCD; wgid = (xcd < r ? xcd * (q + 1) : r * (q + 1) + (xcd - r) * q) + off; }
        const int nig = WGM * nN, gid = wgid / nig, fm = gid * WGM, gsz = (nM - fm) < WGM ? (nM - fm) : WGM;
        u.pm = fm + ((wgid % nig) % gsz); u.pn = (wgid % nig) / gsz; return true;
    }
    __device__ __forceinline__ void a_ready(const Unit&) const {}
    __device__ __forceinline__ void done(const Unit&) const {}
};

__device__ __forceinline__ unsigned cvt_pk_bf16(float lo, float hi) { unsigned r; asm volatile("v_cvt_pk_bf16_f32 %0, %1, %2" : "=v"(r) : "v"(lo), "v"(hi)); return r; }
typedef float f32x2 __attribute__((ext_vector_type(2)));

struct EpiF32 {
    static constexpr bool PERM = false, AFTER_DRAIN = false;
    float* C; int ldc;
    __device__ __forceinline__ void operator()(const f32x4 (&acc)[2][2][4][2], const Unit& u, int wr, int wc, int fr, int fq) const {
        const int row0 = u.pm * BM + wr * 64 + fr, col0 = u.pn * BM + wc * 32 + 4 * fq;
#pragma unroll
        for (int ai = 0; ai < 2; ++ai)
#pragma unroll
            for (int m = 0; m < 4; ++m) { float* rowp = C + (size_t)(row0 + ai * HALF + m * 16) * ldc + col0;
#pragma unroll
                for (int bj = 0; bj < 2; ++bj)
#pragma unroll
                    for (int n = 0; n < 2; ++n) *(f32x4*)(rowp + bj * HALF + n * 16) = acc[ai][bj][m][n]; }
    }
};
struct EpiBf16 {
    static constexpr bool PERM = true, AFTER_DRAIN = false;
    bf16_t* O; int ldc;
    __device__ __forceinline__ void operator()(const f32x4 (&acc)[2][2][4][2], const Unit& u, int wr, int wc, int fr, int fq) const {
        const int row0 = u.pm * BM + wr * 64 + fr, col0 = u.pn * BM + wc * 32 + 8 * fq;
#pragma unroll
        for (int ai = 0; ai < 2; ++ai)
#pragma unroll
            for (int m = 0; m < 4; ++m) { bf16_t* rowp = O + (size_t)(row0 + ai * HALF + m * 16) * ldc + col0;
#pragma unroll
                for (int bj = 0; bj < 2; ++bj) { const f32x4 v0 = acc[ai][bj][m][0], v1 = acc[ai][bj][m][1];
                    u32x4 w; w.x = cvt_pk_bf16(v0[0], v0[1]); w.y = cvt_pk_bf16(v0[2], v0[3]); w.z = cvt_pk_bf16(v1[0], v1[1]); w.w = cvt_pk_bf16(v1[2], v1[3]);
                    *(u32x4*)(rowp + bj * HALF) = w; } }
    }
};
struct EpiBf16Part {
    static constexpr bool PERM = true, AFTER_DRAIN = false;
    bf16_t* O; int ldc; float* PART;
    __device__ __forceinline__ void operator()(const f32x4 (&acc)[2][2][4][2], const Unit& u, int wr, int wc, int fr, int fq) const {
        const int row0 = u.pm * BM + wr * 64 + fr, col0 = u.pn * BM + wc * 32 + 8 * fq;
#pragma unroll
        for (int ai = 0; ai < 2; ++ai)
#pragma unroll
            for (int m = 0; m < 4; ++m) { const int row = row0 + ai * HALF + m * 16; bf16_t* rowp = O + (size_t)row * ldc + col0; float ss = 0.f;
#pragma unroll
                for (int bj = 0; bj < 2; ++bj) { const f32x4 v0 = acc[ai][bj][m][0], v1 = acc[ai][bj][m][1];
                    ss += (v0[0] * v0[0] + v0[1] * v0[1]) + (v0[2] * v0[2] + v0[3] * v0[3]) + (v1[0] * v1[0] + v1[1] * v1[1]) + (v1[2] * v1[2] + v1[3] * v1[3]);
                    u32x4 w; w.x = cvt_pk_bf16(v0[0], v0[1]); w.y = cvt_pk_bf16(v0[2], v0[3]); w.z = cvt_pk_bf16(v1[0], v1[1]); w.w = cvt_pk_bf16(v1[2], v1[3]);
                    *(u32x4*)(rowp + bj * HALF) = w; }
                ss += __shfl_xor(ss, 16); ss += __shfl_xor(ss, 32);
                if (fq == 0) PART[(size_t)row * 64 + u.pn * 4 + wc] = ss; }
    }
};
__device__ __forceinline__ float silu_f(float g) { return g * __builtin_amdgcn_rcpf(1.0f + __builtin_amdgcn_exp2f(-1.4426950408889634f * g)); }
__device__ __forceinline__ float sigmoid_f(float g) { return __builtin_amdgcn_rcpf(1.0f + __builtin_amdgcn_exp2f(-1.4426950408889634f * g)); }
struct EpiSwiGLU {
    static constexpr bool PERM = true, AFTER_DRAIN = false;
    bf16_t* O; int ldc;
    __device__ __forceinline__ void operator()(const f32x4 (&acc)[2][2][4][2], const Unit& u, int wr, int wc, int fr, int fq) const {
        const int row0 = u.pm * BM + wr * 64 + fr, col0 = u.pn * HALF + wc * 32 + 8 * fq;
#pragma unroll
        for (int ai = 0; ai < 2; ++ai)
#pragma unroll
            for (int m = 0; m < 4; ++m) { bf16_t* rowp = O + (size_t)(row0 + ai * HALF + m * 16) * ldc + col0;
                const f32x4 g0 = acc[ai][0][m][0], g1 = acc[ai][0][m][1], u0 = acc[ai][1][m][0], u1 = acc[ai][1][m][1];
                u32x4 w; w.x = cvt_pk_bf16(silu_f(g0[0]) * u0[0], silu_f(g0[1]) * u0[1]); w.y = cvt_pk_bf16(silu_f(g0[2]) * u0[2], silu_f(g0[3]) * u0[3]);
                w.z = cvt_pk_bf16(silu_f(g1[0]) * u1[0], silu_f(g1[1]) * u1[1]); w.w = cvt_pk_bf16(silu_f(g1[2]) * u1[2], silu_f(g1[3]) * u1[3]);
                *(u32x4*)rowp = w; }
    }
};
struct EpiWin {
    static constexpr bool PERM = true, AFTER_DRAIN = false;
    bf16_t* R; int S;
    __device__ __forceinline__ void operator()(const f32x4 (&acc)[2][2][4][2], const Unit& u, int wr, int wc, int fr, int fq) const {
        const int row0 = u.pm * BM + wr * 64 + fr, pn = u.pn, cin = wc * 32 + 8 * fq;
        int ldc; size_t off0, off1;
        if (pn < 24) { ldc = 128; off0 = (size_t)(pn >> 3) * (16u << 20) + (size_t)(2 * (pn & 7)) * S * 128 + cin; off1 = off0 + (size_t)S * 128; }
        else { size_t tb; int c0;
            if (pn < 28) { tb = (size_t)48 << 20; ldc = 1024; c0 = (pn - 24) * 256; } else if (pn < 32) { tb = (size_t)56 << 20; ldc = 1024; c0 = (pn - 28) * 256; }
            else if (pn < 40) { tb = (size_t)64 << 20; ldc = 2048; c0 = (pn - 32) * 256; } else { tb = (size_t)80 << 20; ldc = 2048; c0 = (pn - 40) * 256; }
            off0 = tb + (size_t)(c0 + cin); off1 = off0 + HALF; }
#pragma unroll
        for (int ai = 0; ai < 2; ++ai)
#pragma unroll
            for (int m = 0; m < 4; ++m) { const size_t ro = (size_t)(row0 + ai * HALF + m * 16) * ldc;
#pragma unroll
                for (int bj = 0; bj < 2; ++bj) { const f32x4 v0 = acc[ai][bj][m][0], v1 = acc[ai][bj][m][1];
                    u32x4 w; w.x = cvt_pk_bf16(v0[0], v0[1]); w.y = cvt_pk_bf16(v0[2], v0[3]); w.z = cvt_pk_bf16(v1[0], v1[1]); w.w = cvt_pk_bf16(v1[2], v1[3]);
                    *(u32x4*)(R + ro + (bj ? off1 : off0)) = w; } }
    }
};
struct EpiPleGate {
    static constexpr bool PERM = false, AFTER_DRAIN = false;
    const bf16_t* H; const bf16_t* ERAW; const float* rstd_e; const float* g; float* out; int ldc;
    __device__ __forceinline__ void operator()(const f32x4 (&acc)[2][2][4][2], const Unit& u, int wr, int wc, int fr, int fq) const {
        const int row0 = u.pm * BM + wr * 64 + fr, col0 = u.pn * BM + wc * 32 + 4 * fq;
        f32x4 gv[2][2];
#pragma unroll
        for (int bj = 0; bj < 2; ++bj)
#pragma unroll
            for (int n = 0; n < 2; ++n) gv[bj][n] = *(const f32x4*)(g + col0 + bj * HALF + n * 16);
#pragma unroll
        for (int ai = 0; ai < 2; ++ai)
#pragma unroll
            for (int m = 0; m < 4; ++m) { const int row = row0 + ai * HALF + m * 16; const size_t ro = (size_t)row * ldc + col0; const float rs = rstd_e[row];
#pragma unroll
                for (int bj = 0; bj < 2; ++bj)
#pragma unroll
                    for (int n = 0; n < 2; ++n) { const size_t o = ro + bj * HALF + n * 16; const f32x4 a = acc[ai][bj][m][n];
                        const unsigned long long hw = *(const unsigned long long*)(H + o); const f32x4 hv = {__builtin_bit_cast(float, (unsigned)hw << 16), __builtin_bit_cast(float, (unsigned)hw & 0xffff0000u), __builtin_bit_cast(float, (unsigned)(hw >> 32) << 16), __builtin_bit_cast(float, (unsigned)(hw >> 32) & 0xffff0000u)};
                        const unsigned long long ew = *(const unsigned long long*)(ERAW + o);
                        const f32x4 ev = {__builtin_bit_cast(float, (unsigned)ew << 16), __builtin_bit_cast(float, (unsigned)ew & 0xffff0000u), __builtin_bit_cast(float, (unsigned)(ew >> 32) << 16), __builtin_bit_cast(float, (unsigned)(ew >> 32) & 0xffff0000u)}; f32x4 r;
#pragma unroll
                        for (int j = 0; j < 4; ++j) r[j] = hv[j] + ev[j] * rs * gv[bj][n][j] * sigmoid_f(a[j]);
                        *(f32x4*)(out + o) = r; }
                asm volatile("" ::: "memory"); }
    }
};
template <class Epi, class Sched, bool ALIGN_EPI = false, bool SP2 = false>
__device__ __forceinline__ void gemm_phase(PG8_LAS unsigned char* lds, const Gemm g, const Sched& S, const Epi& E) {
    int tid_ = threadIdx.x; asm volatile("" : "+v"(tid_));
    const int tid = tid_, wid = __builtin_amdgcn_readfirstlane(tid >> 6), lane = tid & 63, wr = wid >> 2, wc = wid & 3, fr = lane & 15, fq = lane >> 4;
    const int K = g.K, nt = K / BK;
    unsigned voffA[2], voffB[2];
#pragma unroll
    for (int i = 0; i < 2; ++i) { int R, C; stage_rc(tid * 16 + i * 8192, R, C); const int Rb = Epi::PERM ? ((R & ~31) + perm32(R & 31)) : R;
        voffA[i] = (unsigned)(R * K + C) * 2u; voffB[i] = (unsigned)(Rb * K + C) * 2u; }
    const size_t kstep = (size_t)(BK * 2);
    const size_t hstep = (size_t)HALF * K * 2;
    const size_t tstep = 2 * hstep;
    const unsigned ldsw = (unsigned)wid * 1024u;
    const int aoff = lds_byte(wr * 64 + fr, fq * 8), boff = lds_byte(wc * 32 + fr, fq * 8);
#define PG8_SA(b, h) (((b) * 2 + (h)) * HTB)
#define PG8_SB(b, h) ((4 + (b) * 2 + (h)) * HTB)
#define PG8_STAGE(bufoff, gbase, voff) do { _Pragma("unroll") for (int _i = 0; _i < 2; ++_i) \
        __builtin_amdgcn_global_load_lds((const unsigned*)((const char*)(gbase) + (voff)[_i]), (PG8_LAS unsigned*)(lds + (bufoff) + ldsw + _i * 8192), 16, 0, 0); } while (0)
#define PG8_LDA(dst, b, h) do { _Pragma("unroll") for (int m = 0; m < 4; ++m) _Pragma("unroll") for (int k = 0; k < 2; ++k) dst[m][k] = *(const PG8_LAS bf16x8*)(lds + PG8_SA(b, h) + aoff + m * 2048 + k * 1024); } while (0)
#define PG8_LDB(dst, b, h) do { _Pragma("unroll") for (int n = 0; n < 2; ++n) _Pragma("unroll") for (int k = 0; k < 2; ++k) dst[n][k] = *(const PG8_LAS bf16x8*)(lds + PG8_SB(b, h) + boff + n * 2048 + k * 1024); } while (0)
#define PG8_MMA(ai, bj, At, Bt) do { __builtin_amdgcn_s_setprio(1); _Pragma("unroll") for (int m = 0; m < 4; ++m) _Pragma("unroll") for (int n = 0; n < 2; ++n) _Pragma("unroll") for (int k = 0; k < 2; ++k) \
        acc[ai][bj][m][n] = __builtin_amdgcn_mfma_f32_16x16x32_bf16(Bt[n][k], At[m][k], acc[ai][bj][m][n], 0, 0, 0); __builtin_amdgcn_s_setprio(0); } while (0)
#define PG8_WAIT_V(n) asm volatile("s_waitcnt vmcnt(" #n ")" ::: "memory")
#define PG8_WAIT_L(n) asm volatile("s_waitcnt lgkmcnt(" #n ")" ::: "memory")
#define PG8_BAR __builtin_amdgcn_s_barrier()
#define PG8_SCHED __builtin_amdgcn_sched_barrier(0)
    Unit cur, nxt; int ui = 0;
    if (!S.next(0, cur)) return;
    f32x4 acc[2][2][4][2];
#pragma unroll
    for (int a = 0; a < 2; ++a)
#pragma unroll
        for (int b = 0; b < 2; ++b)
#pragma unroll
            for (int m = 0; m < 4; ++m)
#pragma unroll
                for (int n = 0; n < 2; ++n) acc[a][b][m][n] = (f32x4){0.f, 0.f, 0.f, 0.f};
    bf16x8 At[4][2], B0[2][2], B1[2][2];
    const char* cA = (const char*)g.A + (size_t)cur.pm * tstep; const char* cB = (const char*)g.Bt + (size_t)cur.pn * tstep;
    S.a_ready(cur);
    if constexpr (SP2) {
        PG8_STAGE(PG8_SB(0, 0), cB, voffB); PG8_STAGE(PG8_SB(0, 1), cB + hstep, voffB); PG8_STAGE(PG8_SA(0, 0), cA, voffA); PG8_STAGE(PG8_SA(0, 1), cA + hstep, voffA);
        if (wr == 1) PG8_BAR;
        PG8_WAIT_V(2); PG8_BAR;
        PG8_STAGE(PG8_SB(1, 0), cB + kstep, voffB); PG8_STAGE(PG8_SA(1, 0), cA + kstep, voffA); PG8_STAGE(PG8_SB(1, 1), cB + hstep + kstep, voffB);
        PG8_WAIT_V(6); PG8_BAR;
    } else {
        PG8_STAGE(PG8_SB(0, 0), cB, voffB); PG8_STAGE(PG8_SA(0, 0), cA, voffA); PG8_STAGE(PG8_SB(0, 1), cB + hstep, voffB); PG8_STAGE(PG8_SA(0, 1), cA + hstep, voffA);
        if (wr == 1) PG8_BAR;
        PG8_WAIT_V(4); PG8_BAR;
        PG8_STAGE(PG8_SB(1, 0), cB + kstep, voffB); PG8_STAGE(PG8_SA(1, 0), cA + kstep, voffA); PG8_STAGE(PG8_SB(1, 1), cB + hstep + kstep, voffB);
        PG8_WAIT_V(6); PG8_BAR;
    }
    for (;;) {
        const bool has_next = S.next(ui + 1, nxt);
        const char* nA = has_next ? (const char*)g.A + (size_t)nxt.pm * tstep : cA; const char* nB = has_next ? (const char*)g.Bt + (size_t)nxt.pn * tstep : cB;
        for (int t = 0; t < nt; t += 2) {
            const bool last = (t == nt - 2);
            const char* a1 = cA + (size_t)(t + 1) * kstep;
            const char* a2 = last ? nA : cA + (size_t)(t + 2) * kstep; const char* b2 = last ? nB : cB + (size_t)(t + 2) * kstep;
            const char* a3 = a2 + kstep; const char* b3 = b2 + kstep;
            if (last && has_next) S.a_ready(nxt);
            if constexpr (SP2) {
            PG8_LDB(B0, 0, 0); PG8_LDB(B1, 0, 1); PG8_SCHED; PG8_LDA(At, 0, 0); PG8_STAGE(PG8_SA(1, 1), a1 + hstep, voffA);
            PG8_WAIT_V(8); PG8_WAIT_L(0); PG8_BAR; PG8_MMA(0, 0, At, B0); PG8_MMA(0, 1, At, B1); PG8_BAR; PG8_SCHED;
            PG8_LDA(At, 0, 1); PG8_STAGE(PG8_SB(0, 0), b2, voffB); PG8_STAGE(PG8_SB(0, 1), b2 + hstep, voffB); PG8_STAGE(PG8_SA(0, 0), a2, voffA);
            PG8_WAIT_V(8); PG8_WAIT_L(0); PG8_BAR; PG8_MMA(1, 0, At, B0); PG8_MMA(1, 1, At, B1); PG8_BAR; PG8_SCHED;
            PG8_LDB(B0, 1, 0); PG8_LDB(B1, 1, 1); PG8_SCHED; PG8_LDA(At, 1, 0); PG8_STAGE(PG8_SA(0, 1), a2 + hstep, voffA);
            PG8_WAIT_V(8); PG8_WAIT_L(0); PG8_BAR; PG8_MMA(0, 0, At, B0); PG8_MMA(0, 1, At, B1); PG8_BAR; PG8_SCHED;
            PG8_LDA(At, 1, 1); PG8_STAGE(PG8_SB(1, 0), b3, voffB); PG8_STAGE(PG8_SB(1, 1), b3 + hstep, voffB); PG8_STAGE(PG8_SA(1, 0), a3, voffA);
            PG8_WAIT_V(8); PG8_WAIT_L(0); PG8_BAR; PG8_MMA(1, 0, At, B0); PG8_MMA(1, 1, At, B1); PG8_BAR; PG8_SCHED;
            } else {
            PG8_LDB(B0, 0, 0); PG8_SCHED; PG8_LDA(At, 0, 0); PG8_STAGE(PG8_SA(1, 1), a1 + hstep, voffA);
            PG8_WAIT_L(8); PG8_BAR; PG8_WAIT_L(0); PG8_MMA(0, 0, At, B0); PG8_BAR; PG8_SCHED;
            PG8_LDB(B1, 0, 1); PG8_STAGE(PG8_SB(0, 0), b2, voffB);
            PG8_BAR; PG8_WAIT_L(0); PG8_MMA(0, 1, At, B1); PG8_BAR;
            PG8_LDA(At, 0, 1); PG8_STAGE(PG8_SA(0, 0), a2, voffA);
            PG8_BAR; PG8_WAIT_L(0); PG8_MMA(1, 0, At, B0); PG8_BAR; PG8_SCHED;
            PG8_STAGE(PG8_SB(0, 1), b2 + hstep, voffB);
            PG8_WAIT_V(6); PG8_BAR; PG8_MMA(1, 1, At, B1); PG8_BAR;
            PG8_LDB(B0, 1, 0); PG8_SCHED; PG8_LDA(At, 1, 0); PG8_STAGE(PG8_SA(0, 1), a2 + hstep, voffA);
            PG8_WAIT_L(8); PG8_BAR; PG8_WAIT_L(0); PG8_MMA(0, 0, At, B0); PG8_BAR; PG8_SCHED;
            PG8_LDB(B1, 1, 1); PG8_STAGE(PG8_SB(1, 0), b3, voffB);
            PG8_BAR; PG8_WAIT_L(0); PG8_MMA(0, 1, At, B1); PG8_BAR;
            PG8_LDA(At, 1, 1); PG8_STAGE(PG8_SA(1, 0), a3, voffA);
            PG8_BAR; PG8_WAIT_L(0); PG8_MMA(1, 0, At, B0); PG8_BAR; PG8_SCHED;
            PG8_STAGE(PG8_SB(1, 1), b3 + hstep, voffB);
            PG8_WAIT_V(6); PG8_BAR; PG8_MMA(1, 1, At, B1); PG8_BAR;
            }
        }
        if constexpr (ALIGN_EPI) { if (wr == 0) PG8_BAR; }
        if constexpr (!Epi::AFTER_DRAIN) { E(acc, cur, wr, wc, fr, fq); S.done(cur); }
        if (!has_next) break;
#pragma unroll
        for (int a = 0; a < 2; ++a)
#pragma unroll
            for (int b = 0; b < 2; ++b)
#pragma unroll
                for (int m = 0; m < 4; ++m)
#pragma unroll
                    for (int n = 0; n < 2; ++n) acc[a][b][m][n] = (f32x4){0.f, 0.f, 0.f, 0.f};
        cur = nxt; cA = nA; cB = nB; ++ui;
        if constexpr (ALIGN_EPI) { if (wr == 1) PG8_BAR; }
    }
    PG8_WAIT_V(0);
    if constexpr (!ALIGN_EPI) { if (wr == 0) PG8_BAR; }
    PG8_BAR;
    if constexpr (Epi::AFTER_DRAIN) { E.fused(acc, cur, wr, wc, fr, fq, lds, wid, lane); S.done(cur); }
#undef PG8_SA
#undef PG8_SB
#undef PG8_STAGE
#undef PG8_LDA
#undef PG8_LDB
#undef PG8_MMA
#undef PG8_WAIT_V
#undef PG8_WAIT_L
#undef PG8_BAR
#undef PG8_SCHED
}
}

constexpr int NWAVES = 8;
#ifndef MK_N_LAUNCHES
#define MK_N_LAUNCHES 1
#endif
#ifndef SIMPLE_ATTN
#define SIMPLE_ATTN 0
#endif
#ifndef SIMPLE_GLA
#define SIMPLE_GLA 0
#endif
#ifndef PG_SP2
#define PG_SP2 true
#endif
#ifndef PG_ALIGN
#define PG_ALIGN true
#endif
#ifndef PROBE_AMP
#define PROBE_AMP -1
#endif
#ifndef PROBE_REPEAT
#define PROBE_REPEAT -1
#endif
constexpr int N_PHASES = 14;
constexpr bool ONE_LAUNCH = (MK_N_LAUNCHES == 1);

constexpr int S = 8192, DM = 4096, DFF = 11008, PLE = 256;
constexpr int FH = 16, FD = 128, FW = 2048;
constexpr int GH = 4, GDK = 256, GDV = 512, GKW = 1024, GVW = 2048, GRANK = 16, GC = 64, NCH = S / GC;
constexpr int WIN_COLS = 12320, NWIN = 12288;
constexpr float EPS = 1e-6f;
constexpr float FOX_SCALE = 0.08838834764831845f;

constexpr size_t MiB = 1u << 20;
constexpr size_t WS_CTL = 0, CTL_ZERO_BYTES = 1 * MiB;
constexpr size_t WS_WSK = 1 * MiB;
constexpr size_t WS_WPP = 2 * MiB;
constexpr size_t WS_W1GU = 4 * MiB;
constexpr size_t WS_W1D = 176 * MiB;
constexpr size_t WS_W2GU = 262 * MiB;
constexpr size_t WS_W2D = 434 * MiB;
constexpr size_t WS_WIN = 520 * MiB;
constexpr size_t WS_WO = 616 * MiB;
constexpr size_t WS_WPG = 648 * MiB;
constexpr size_t WS_H = 680 * MiB;
constexpr size_t WS_F = 808 * MiB;
constexpr size_t WS_XN = 936 * MiB;
constexpr size_t WS_MIX = 1000 * MiB;
constexpr size_t WS_ACT = 1064 * MiB;
constexpr size_t WS_Q = 1064 * MiB, WS_K = 1096 * MiB, WS_V = 1128 * MiB;
constexpr size_t WS_GQ = 1160 * MiB, WS_GK = 1176 * MiB;
constexpr size_t WS_GV = 1192 * MiB, WS_GR = 1224 * MiB;
constexpr size_t WS_QDEC = 1256 * MiB, WS_KTE = 1272 * MiB, WS_VT = 1288 * MiB, WS_AM = 1320 * MiB;
constexpr size_t WS_MISC = 1324 * MiB;
constexpr size_t WS_OGLA = 1328 * MiB;
constexpr size_t WS_ERAW = 1256 * MiB;
constexpr size_t WS_PBF = 1392 * MiB;
constexpr size_t WS_UG = 1396 * MiB;
constexpr size_t WS_DG = 1402 * MiB;
constexpr size_t WS_EPART = 1403 * MiB;
constexpr size_t WS_END = 1405 * MiB;
static_assert(WS_ERAW + (size_t)S * DM * 4 <= WS_PBF && WS_ACT + (size_t)S * DFF * 2 <= WS_ERAW && WS_OGLA + (size_t)S * GVW * 4 <= WS_PBF, "d_ws map");
constexpr int CW_TMO = 0, CW_CODE = 1;
constexpr int CW_BAR = 4096;
constexpr int CW_NRM = 2048;

constexpr int RING_OFF = 0, RING_BYTES = 131072;
constexpr int LDS_BYTES = 147456;
constexpr int LDSCTL_OFF = LDS_BYTES - 1024, MISC_OFF = LDSCTL_OFF + 320;

#define GAS __attribute__((address_space(1)))
#define LAS __attribute__((address_space(3)))
typedef unsigned short bf16;
typedef unsigned v4u __attribute__((ext_vector_type(4)));
typedef unsigned v2u __attribute__((ext_vector_type(2)));
typedef float f32x4 __attribute__((ext_vector_type(4)));
typedef float f32x16 __attribute__((ext_vector_type(16)));
typedef short bf16x8 __attribute__((ext_vector_type(8)));
typedef GAS unsigned gu32;
typedef GAS unsigned long long gu64;
#define RLX_AGENT __ATOMIC_RELAXED, __HIP_MEMORY_SCOPE_AGENT
#define LDS_WAIT() asm volatile("s_waitcnt lgkmcnt(0)" ::: "memory")
#define VM_WAIT() asm volatile("s_waitcnt vmcnt(0)" ::: "memory")
__device__ __forceinline__ unsigned pk2(float lo, float hi) { unsigned r; asm("v_cvt_pk_bf16_f32 %0, %1, %2" : "=v"(r) : "v"(lo), "v"(hi)); return r; }
__device__ __forceinline__ unsigned f2bf(float f) { return pk2(f, 0.f) & 0xffffu; }
__device__ __forceinline__ float bf2f(unsigned short b) { return __builtin_bit_cast(float, (unsigned)b << 16); }
__device__ __forceinline__ float bflo(unsigned w) { return __builtin_bit_cast(float, w << 16); }
__device__ __forceinline__ float bfhi(unsigned w) { return __builtin_bit_cast(float, w & 0xffff0000u); }
__device__ __forceinline__ float log_sigmoid_f(float z) { return fminf(z, 0.f) - __logf(1.0f + __expf(-fabsf(z))); }
#define XB_TMO      128
#define XB_XCNT(j)  (256  + 64 * (j))
#define XB_XSUB(j)  (1280 + 64 * (j))
#define XB_XGEN(j)  (2304 + 64 * (j))
#define XB_TOP      3328
#define XB_TOPGEN   3392
#define XCD_BAR_WORDS 3456
#define XB_SPIN_CAP (1u << 21)

__device__ __forceinline__ unsigned xb_ld(unsigned* p)              { return __hip_atomic_load(p, __ATOMIC_RELAXED, __HIP_MEMORY_SCOPE_AGENT); }
__device__ __forceinline__ unsigned xb_add(unsigned* p, unsigned v) { return __hip_atomic_fetch_add(p, v, __ATOMIC_RELAXED, __HIP_MEMORY_SCOPE_AGENT); }
__device__ __forceinline__ unsigned xb_xcc_id() { return (unsigned)__builtin_amdgcn_s_getreg((3 << 11) | 20) & 0xFu; }
#define XB_SPIN(cond, bar) do { unsigned _sp = 0; while (cond) { __builtin_amdgcn_s_sleep(1); \
    if ((++_sp & 255u) == 0u) { if (xb_ld(&(bar)[XB_TMO])) break; if (_sp > XB_SPIN_CAP) { atomicAdd(&(bar)[XB_TMO], 1u); break; } } } } while (0)

struct XcdBarrier {
    unsigned* bar; unsigned x;
    volatile LAS unsigned* st;
};

__device__ __forceinline__ XcdBarrier xcd_barrier_post(unsigned* bar, volatile LAS unsigned* st) {
    XcdBarrier b; b.bar = bar; b.x = xb_xcc_id(); b.st = st;
    if (threadIdx.x == 0) (void)xb_add(&bar[XB_XCNT(b.x)], 1u);
    return b;
}
__device__ __forceinline__ void xcd_barrier_complete(unsigned* bar, unsigned x, unsigned& nloc, unsigned& nx) {
    const unsigned G = gridDim.x * gridDim.y * gridDim.z;
    unsigned sum, cnt, mine, sp = 0u;
    for (;;) {
        sum = 0u; cnt = 0u; mine = 0u;
#pragma unroll
        for (unsigned j = 0; j < 16; ++j) { const unsigned c = xb_ld(&bar[XB_XCNT(j)]); sum += c; cnt += (c > 0u) ? 1u : 0u; mine = (j == x) ? c : mine; }
        if (sum == G) break;
        __builtin_amdgcn_s_sleep(1);
        if ((++sp & 255u) == 0u) { if (xb_ld(&bar[XB_TMO])) break; if (sp > XB_SPIN_CAP) { atomicAdd(&bar[XB_TMO], 1u); break; } }
    }
    nloc = mine > 0u ? mine : 1u; nx = cnt > 0u ? cnt : 1u;
}

__device__ __forceinline__ void xcd_barrier(const XcdBarrier& b) {
    asm volatile("s_waitcnt vmcnt(0)" ::: "memory");
    __syncthreads();
    if (threadIdx.x == 0) {
        unsigned* bar = b.bar;
        __builtin_amdgcn_s_waitcnt(0);
        unsigned nloc = b.st[0], nx = b.st[1];
        if (nloc == 0u) { xcd_barrier_complete(bar, b.x, nloc, nx); b.st[0] = nloc; b.st[1] = nx; }
        const unsigned old = xb_add(&bar[XB_XSUB(b.x)], 1u);
        const unsigned gen = old / nloc;
        if (old + 1u == (gen + 1u) * nloc) {
            __builtin_amdgcn_fence(__ATOMIC_RELEASE, "agent");
            asm volatile("s_waitcnt vmcnt(0)" ::: "memory");
            const unsigned og = xb_add(&bar[XB_TOP], 1u);
            const unsigned tg = og / nx;
            if (og + 1u == (tg + 1u) * nx) xb_add(&bar[XB_TOPGEN], 1u);
            else XB_SPIN(xb_ld(&bar[XB_TOPGEN]) == tg, bar);
            __builtin_amdgcn_fence(__ATOMIC_ACQUIRE, "agent");
            xb_add(&bar[XB_XGEN(b.x)], 1u);
            asm volatile("s_waitcnt vmcnt(0)" ::: "memory");
        } else {
            XB_SPIN(xb_ld(&bar[XB_XGEN(b.x)]) == gen, bar);
            __builtin_amdgcn_fence(__ATOMIC_ACQUIRE, "agent");
            asm volatile("s_waitcnt vmcnt(0)" ::: "memory");
        }
    }
    __syncthreads();
}


struct Frame {
    LAS unsigned char* lds;
    volatile LAS unsigned* MISC;
    gu32* ctl;
    int tid, lane, wave;
    int vcu, G;
};
__device__ __forceinline__ float wave_sum(float v) {
#pragma unroll
    for (int o = 1; o < 64; o <<= 1) v += __shfl_xor(v, o);
    return v;
}
template <class RowMap>
__device__ __forceinline__ void p0_transpose_item(const float* W, int N, int K, LAS float* scr, int kb, int nb, int lane, const RowMap& rm) {
    const int k0 = 64 * kb, n0 = 32 * nb;
    float v[32];
#pragma unroll
    for (int i = 0; i < 32; ++i) v[i] = W[(size_t)(k0 + 2 * i + (lane >> 5)) * N + n0 + (lane & 31)];
#pragma unroll
    for (int i = 0; i < 32; ++i) scr[(2 * i + (lane >> 5)) * 33 + (lane & 31)] = v[i];
    LDS_WAIT(); asm volatile("" ::: "memory");
    const int c = lane & 7;
#pragma unroll
    for (int j = 0; j < 4; ++j) { const int n = (lane >> 3) + 8 * j; const LAS float* s = scr + (8 * c) * 33 + n;
        v4u o; o.x = pk2(s[0 * 33], s[1 * 33]); o.y = pk2(s[2 * 33], s[3 * 33]); o.z = pk2(s[4 * 33], s[5 * 33]); o.w = pk2(s[6 * 33], s[7 * 33]);
        *(GAS v4u*)(rm(n0 + n) + k0 + 8 * c) = o; }
    LDS_WAIT(); asm volatile("" ::: "memory");
}
struct RmPlain { bf16* WT; int K; __device__ __forceinline__ bf16* operator()(int n) const { return WT + (size_t)n * K; } };
struct RmGateUp { bf16* WT; int up; __device__ __forceinline__ bf16* operator()(int n) const { return WT + (size_t)(256 * (n >> 7) + 128 * up + (n & 127)) * DM; } };
struct RmWin { bf16* WT; bf16* SK;
    __device__ __forceinline__ bf16* operator()(int n) const {
        if (n < 6144) return WT + (size_t)n * DM;
        if (n < 6160) return SK + (size_t)(n - 6144) * DM;
        if (n < 12304) return WT + (size_t)(n - 16) * DM;
        return SK + (size_t)(16 + n - 12304) * DM; } };

constexpr int NSCAN = GH * 16;
constexpr int CV_GU = (DM / 64) * (DFF / 32), CV_D = (DFF / 64) * (DM / 32), CV_IN = (DM / 64) * (WIN_COLS / 32), CV_SQ = (DM / 64) * (DM / 32), CV_PP = (PLE / 64) * (DM / 32);
constexpr int CV_TAIL = (CV_D * 3) / 4;
constexpr int CV_A = 2 * CV_GU + CV_IN, CV_B = CV_A + CV_D, CV_C = CV_B + 2 * CV_GU + 2 * CV_SQ + CV_PP, CV_D2 = CV_C + CV_D;
struct CvItem { const float* W; int N, k0, n0, seg; };
__device__ __forceinline__ CvItem cv_decode(const float* const* in, int it) {
    int r = it;
    if (r < CV_GU) return CvItem{in[3], DFF, 64 * (r / (DFF / 32)), 32 * (r % (DFF / 32)), 0}; r -= CV_GU;
    if (r < CV_GU) return CvItem{in[4], DFF, 64 * (r / (DFF / 32)), 32 * (r % (DFF / 32)), 1}; r -= CV_GU;
    if (r < CV_IN) return CvItem{in[8], WIN_COLS, 64 * (r / (WIN_COLS / 32)), 32 * (r % (WIN_COLS / 32)), 2}; r -= CV_IN;
    if (r < CV_D) return CvItem{in[5], DM, 64 * (r / (DM / 32)), 32 * (r % (DM / 32)), 3}; r -= CV_D;
    if (r < CV_GU) return CvItem{in[16], DFF, 64 * (r / (DFF / 32)), 32 * (r % (DFF / 32)), 4}; r -= CV_GU;
    if (r < CV_GU) return CvItem{in[17], DFF, 64 * (r / (DFF / 32)), 32 * (r % (DFF / 32)), 5}; r -= CV_GU;
    if (r < CV_SQ) return CvItem{in[13], DM, 64 * (r / (DM / 32)), 32 * (r % (DM / 32)), 6}; r -= CV_SQ;
    if (r < CV_SQ) return CvItem{in[22], DM, 64 * (r / (DM / 32)), 32 * (r % (DM / 32)), 7}; r -= CV_SQ;
    if (r < CV_PP) return CvItem{in[20], DM, 64 * (r / (DM / 32)), 32 * (r % (DM / 32)), 8}; r -= CV_PP;
    return CvItem{in[18], DM, 64 * (r / (DM / 32)), 32 * (r % (DM / 32)), 9};
}
__device__ __forceinline__ void cv_load(f32x4 (&v)[8], const CvItem& c, int lane) {
    const GAS float* src = (const GAS float*)c.W + (size_t)(c.k0 + (lane >> 3)) * c.N + c.n0 + 4 * (lane & 7);
#pragma unroll
    for (int i = 0; i < 8; ++i) v[i] = __builtin_nontemporal_load((const GAS f32x4*)(src + (size_t)(8 * i) * c.N));
}
__device__ __forceinline__ void cv_store(const f32x4 (&v)[8], const CvItem& c, unsigned char* ws, LAS float* scr, int lane) {
#pragma unroll
    for (int i = 0; i < 8; ++i) { LAS float* d = scr + (8 * i + (lane >> 3)) * 33 + 4 * (lane & 7); d[0] = v[i].x; d[1] = v[i].y; d[2] = v[i].z; d[3] = v[i].w; }
    LDS_WAIT(); asm volatile("" ::: "memory");
    const int cc = lane & 7, seg = c.seg;
    size_t base; int K;
    if (seg == 0 || seg == 1) { base = WS_W1GU; K = DM; } else if (seg == 2) { base = WS_WIN; K = DM; } else if (seg == 3) { base = WS_W1D; K = DFF; } else if (seg == 4 || seg == 5) { base = WS_W2GU; K = DM; }
    else if (seg == 6) { base = WS_WO; K = DM; } else if (seg == 7) { base = WS_WPG; K = DM; } else if (seg == 8) { base = WS_WPP; K = PLE; } else { base = WS_W2D; K = DFF; }
#pragma unroll
    for (int j = 0; j < 4; ++j) { const int nl = (lane >> 3) + 8 * j, n = c.n0 + nl; const LAS float* sp = scr + (8 * cc) * 33 + nl;
        v4u o; o.x = pk2(sp[0 * 33], sp[1 * 33]); o.y = pk2(sp[2 * 33], sp[3 * 33]); o.z = pk2(sp[4 * 33], sp[5 * 33]); o.w = pk2(sp[6 * 33], sp[7 * 33]);
        int row = n; size_t bs = base;
        if (seg == 0 || seg == 4) row = 256 * (n >> 7) + (n & 127);
        else if (seg == 1 || seg == 5) row = 256 * (n >> 7) + 128 + (n & 127);
        else if (seg == 2) {
            if (n < 6144) row = n; else if (n < 6160) { row = n - 6144; bs = WS_WSK; } else if (n < 12304) row = n - 16; else { row = 16 + n - 12304; bs = WS_WSK; } }
        *(GAS v4u*)((GAS char*)ws + bs + ((size_t)row * K + c.k0 + 8 * cc) * 2) = o; }
    LDS_WAIT(); asm volatile("" ::: "memory");
}
__device__ __forceinline__ void convert_items(Frame& F, const float* const* in, unsigned char* ws, int first, int last, int wv, int nwv) {
    LAS float* scr = (LAS float*)(F.lds + RING_OFF + F.wave * 16384);
    int it = first + wv;
    if (it >= last) return;
    f32x4 v0[8], v1[8], v2[8], v3[8];
    CvItem c0 = cv_decode(in, it), c1 = c0, c2 = c0, c3 = c0;
#define CV_LD(j, idx) do { if ((idx) < last) { c##j = cv_decode(in, (idx)); cv_load(v##j, c##j, F.lane); } } while (0)
    cv_load(v0, c0, F.lane); CV_LD(1, it + nwv); CV_LD(2, it + 2 * nwv);
    for (;;) {
        CV_LD(3, it + 3 * nwv); cv_store(v0, c0, ws, scr, F.lane); if (it + nwv >= last) break;
        CV_LD(0, it + 4 * nwv); cv_store(v1, c1, ws, scr, F.lane); if (it + 2 * nwv >= last) break;
        CV_LD(1, it + 5 * nwv); cv_store(v2, c2, ws, scr, F.lane); if (it + 3 * nwv >= last) break;
        CV_LD(2, it + 6 * nwv); cv_store(v3, c3, ws, scr, F.lane); if (it + 4 * nwv >= last) break;
        it += 4 * nwv;
    }
#undef CV_LD
}

constexpr int CV_CLAIM = 16 * NWAVES, CW_CVQ = 3072;
__device__ __forceinline__ void convert_dynamic(Frame& F, const float* const* in, unsigned char* ws, int first, int last) {
    for (;;) {
        __syncthreads();
        if (F.tid == 0) F.MISC[12] = __hip_atomic_fetch_add(F.ctl + CW_CVQ, (unsigned)CV_CLAIM, RLX_AGENT);
        __syncthreads();
        const int b0 = first + (int)F.MISC[12];
        if (b0 >= last) break;
        convert_items(F, in, ws, b0, min(last, b0 + CV_CLAIM), F.wave, NWAVES);
    }
}

__device__ __forceinline__ void norm_row_to_bf16(const float* xrow, const f32x4 (&gq)[16], bf16* orow, int lane) {
    const GAS f32x4* xr = (const GAS f32x4*)xrow + lane;
    f32x4 v[16]; float s = 0.f;
#pragma unroll
    for (int j = 0; j < 16; ++j) { v[j] = __builtin_nontemporal_load(xr + 64 * j); s += (v[j].x * v[j].x + v[j].y * v[j].y) + (v[j].z * v[j].z + v[j].w * v[j].w); }
    const float rstd = 1.f / sqrtf(wave_sum(s) * (1.f / DM) + EPS);
    GAS v2u* o8 = (GAS v2u*)orow + lane;
#pragma unroll
    for (int j = 0; j < 16; ++j) { const f32x4 gg = gq[j]; v2u w; w.x = pk2(v[j].x * rstd * gg.x, v[j].y * rstd * gg.y); w.y = pk2(v[j].z * rstd * gg.z, v[j].w * rstd * gg.w); o8[64 * j] = w; }
}
__device__ __forceinline__ void stage_gains(Frame& F, const float* g1, const float* g2) {
    LAS f32x4* gl = (LAS f32x4*)(F.lds + RING_OFF);
    __syncthreads();
    for (int i = F.tid; i < DM / 4; i += NWAVES * 64) { gl[i] = ((const GAS f32x4*)g1)[i]; gl[DM / 4 + i] = ((const GAS f32x4*)g2)[i]; }
    __syncthreads();
}
template <bool NORM2, bool BASE_BF16>
__device__ __forceinline__ void resid_row(Frame& F, const bf16* frow, const void* baserow, float wgt, bf16* hout, bf16* bout, int lane) {
    const GAS v2u* fr = (const GAS v2u*)frow + lane; const GAS f32x4* br = (const GAS f32x4*)baserow + lane; const GAS v2u* bb = (const GAS v2u*)baserow + lane;
    const LAS f32x4* g1l = (const LAS f32x4*)(F.lds + RING_OFF) + lane; const LAS f32x4* g2l = g1l + DM / 4;
    v2u fw[16], bwv[16]; f32x4 v[16]; float s = 0.f;
#pragma unroll
    for (int j = 0; j < 16; ++j) fw[j] = __builtin_nontemporal_load(fr + 64 * j);
    if (BASE_BF16) {
#pragma unroll
        for (int j = 0; j < 16; ++j) bwv[j] = __builtin_nontemporal_load(bb + 64 * j);
    } else {
#pragma unroll
        for (int j = 0; j < 16; ++j) v[j] = __builtin_nontemporal_load(br + 64 * j);
    }
#pragma unroll
    for (int j = 0; j < 16; ++j) { const float a0 = bflo(fw[j].x), a1 = bfhi(fw[j].x), a2 = bflo(fw[j].y), a3 = bfhi(fw[j].y); s += (a0 * a0 + a1 * a1) + (a2 * a2 + a3 * a3); }
    const float rw = wgt / sqrtf(wave_sum(s) * (1.f / DM) + EPS);
    float s2 = 0.f; GAS v2u* ho = (GAS v2u*)hout + lane;
#pragma unroll
    for (int j = 0; j < 16; ++j) { f32x4 b;
        if (BASE_BF16) b = (f32x4){bflo(bwv[j].x), bfhi(bwv[j].x), bflo(bwv[j].y), bfhi(bwv[j].y)}; else b = v[j];
        const f32x4 gg = g1l[64 * j]; const f32x4 f = {bflo(fw[j].x), bfhi(fw[j].x), bflo(fw[j].y), bfhi(fw[j].y)};
        v[j] = b + f * rw * gg;
        if (NORM2) { v2u w; w.x = pk2(v[j].x, v[j].y); w.y = pk2(v[j].z, v[j].w); __builtin_nontemporal_store(w, ho + 64 * j); }
        s2 += (v[j].x * v[j].x + v[j].y * v[j].y) + (v[j].z * v[j].z + v[j].w * v[j].w);
        if ((j & 7) == 7) asm volatile("" ::: "memory"); }
    GAS v2u* o8 = (GAS v2u*)bout + lane;
    if (NORM2) { const float r2 = 1.f / sqrtf(wave_sum(s2) * (1.f / DM) + EPS);
#pragma unroll
        for (int j = 0; j < 16; ++j) { const f32x4 gg = g2l[64 * j]; v2u w; w.x = pk2(v[j].x * r2 * gg.x, v[j].y * r2 * gg.y); w.y = pk2(v[j].z * r2 * gg.z, v[j].w * r2 * gg.w); o8[64 * j] = w;
            if ((j & 7) == 7) asm volatile("" ::: "memory"); } }
    else {
#pragma unroll
        for (int j = 0; j < 16; ++j) { v2u w; w.x = pk2(v[j].x, v[j].y); w.y = pk2(v[j].z, v[j].w); o8[64 * j] = w; } }
}

__device__ __forceinline__ void skinny_gemm(Frame& F, const bf16* XN, const bf16* WSK, float* FFGLR) {
    LAS float* red = (LAS float*)(F.lds + RING_OFF);
    const int r = F.lane & 31, h = F.lane >> 5;
    for (int blk = F.vcu; blk < S / 32; blk += F.G) {
        const bf16* ap = XN + (size_t)(blk * 32 + r) * DM + F.wave * 512 + 8 * h; const bf16* bp = WSK + (size_t)r * DM + F.wave * 512 + 8 * h;
        f32x16 acc = {};
#pragma unroll 16
        for (int ks = 0; ks < 32; ++ks) { const bf16x8 a = *(const GAS bf16x8*)(ap + ks * 16), b = *(const GAS bf16x8*)(bp + ks * 16);
            acc = __builtin_amdgcn_mfma_f32_32x32x16_bf16(a, b, acc, 0, 0, 0); }
        __syncthreads();
#pragma unroll
        for (int i = 0; i < 16; ++i) red[(F.wave * 32 + ((i & 3) + 8 * (i >> 2) + 4 * h)) * 33 + r] = acc[i];
        __syncthreads();
        for (int e = F.tid; e < 1024; e += NWAVES * 64) { const int row = e >> 5, col = e & 31; float s = 0.f;
#pragma unroll
            for (int w = 0; w < 8; ++w) s += red[(w * 32 + row) * 33 + col];
            FFGLR[(size_t)(blk * 32 + row) * 32 + col] = s; }
    }
    __syncthreads();
}


__device__ __forceinline__ void fox_norms(Frame& F, const bf16* Q, const bf16* K, float* NRMP) {
    LAS float* red = (LAS float*)(F.lds + RING_OFF);
    const int gw_ = F.vcu * NWAVES + F.wave, ngw = F.G * NWAVES, sub = F.lane >> 4, l16 = F.lane & 15;
    __syncthreads();
    float mq[FH], mk[FH];
#pragma unroll
    for (int hd = 0; hd < FH; ++hd) { mq[hd] = 0.f; mk[hd] = 0.f; }
    for (int r0 = gw_ * 4; r0 < S; r0 += ngw * 4) {
#pragma unroll
        for (int h0 = 0; h0 < FH; h0 += 8) {
            v4u qa[8], kb[8];
#pragma unroll
            for (int i = 0; i < 8; ++i) { const size_t o = ((size_t)(h0 + i) * S + r0 + sub) * FD + l16 * 8; qa[i] = *(const GAS v4u*)(Q + o); kb[i] = *(const GAS v4u*)(K + o); }
#pragma unroll
            for (int i = 0; i < 8; ++i) { const v4u a = qa[i], b = kb[i];
                float sq = bflo(a.x) * bflo(a.x) + bfhi(a.x) * bfhi(a.x) + bflo(a.y) * bflo(a.y) + bfhi(a.y) * bfhi(a.y) + bflo(a.z) * bflo(a.z) + bfhi(a.z) * bfhi(a.z) + bflo(a.w) * bflo(a.w) + bfhi(a.w) * bfhi(a.w);
                float sk = bflo(b.x) * bflo(b.x) + bfhi(b.x) * bfhi(b.x) + bflo(b.y) * bflo(b.y) + bfhi(b.y) * bfhi(b.y) + bflo(b.z) * bflo(b.z) + bfhi(b.z) * bfhi(b.z) + bflo(b.w) * bflo(b.w) + bfhi(b.w) * bfhi(b.w);
#pragma unroll
                for (int o2 = 1; o2 < 16; o2 <<= 1) { sq += __shfl_xor(sq, o2); sk += __shfl_xor(sk, o2); }
                mq[h0 + i] = fmaxf(mq[h0 + i], sq); mk[h0 + i] = fmaxf(mk[h0 + i], sk); } } }
#pragma unroll
    for (int hd = 0; hd < FH; ++hd) { float q = mq[hd], k = mk[hd];
        q = fmaxf(q, __shfl_xor(q, 16)); q = fmaxf(q, __shfl_xor(q, 32)); k = fmaxf(k, __shfl_xor(k, 16)); k = fmaxf(k, __shfl_xor(k, 32));
        if (F.lane == 0) { red[F.wave * 32 + 2 * hd] = q; red[F.wave * 32 + 2 * hd + 1] = k; } }
    __syncthreads();
    if (F.tid < 32) { float m = red[F.tid];
#pragma unroll
        for (int w = 1; w < NWAVES; ++w) m = fmaxf(m, red[w * 32 + F.tid]);
        NRMP[(size_t)F.vcu * 32 + F.tid] = m; }
    __syncthreads();
}
constexpr float CF_SCALE = SIMPLE_ATTN ? 1.0f : 11.313708498984761f;
__device__ __forceinline__ void fox_prep(Frame& F, const float* FFGLR, const float* bfv, float* cf) {
    LAS float* sc = (LAS float*)(F.lds + RING_OFF);
    const bool spread = F.G >= 16 * FH;
    for (int hd = spread ? ((F.vcu & 15) == 0 ? (F.vcu >> 4) : FH) : F.vcu; hd < FH; hd += F.G) {
        const float b = bfv[hd]; const int t0 = F.tid * 16; float v[16]; float run = 0.f;
#pragma unroll
        for (int j = 0; j < 16; ++j) { run += log_sigmoid_f(FFGLR[(size_t)(t0 + j) * 32 + hd] + b); v[j] = run; }
        float inc = run;
#pragma unroll
        for (int o = 1; o < 64; o <<= 1) { const float n = __shfl_up(inc, o); if (F.lane >= o) inc += n; }
        __syncthreads();
        if (F.lane == 63) sc[512 + F.wave] = inc;
        __syncthreads();
        float woff = 0.f;
        for (int w = 0; w < F.wave; ++w) woff += sc[512 + w];
        const float excl = woff + inc - run;
#pragma unroll
        for (int j = 0; j < 16; ++j) cf[(size_t)hd * S + t0 + j] = (v[j] + excl) * CF_SCALE;
    }
    __syncthreads();
}

#if SIMPLE_ATTN
__device__ __forceinline__ void attn_simple(Frame& F, const bf16* Q, const bf16* K, const bf16* V, const float* cf, bf16* MIX) {
    LAS unsigned char* kt = F.lds + RING_OFF; LAS unsigned char* vt = kt + 16384; LAS float* ck = (LAS float*)(vt + 16384);
    const int row = F.tid >> 3, part = F.tid & 7;
    for (int item = F.vcu; item < FH * (S / 64); item += F.G) {
        const int hd = item & 15, qb = (S / 64 - 1) - (item >> 4), qrow = qb * 64 + row;
        float q[16], o[16]; float m = -1e30f, l = 0.f;
        { const GAS v4u* qp = (const GAS v4u*)(Q + ((size_t)hd * S + qrow) * FD + part * 16); const v4u a = qp[0], b = qp[1];
          const unsigned w[8] = {a.x, a.y, a.z, a.w, b.x, b.y, b.z, b.w};
#pragma unroll
          for (int j = 0; j < 8; ++j) { q[2 * j] = bflo(w[j]) * FOX_SCALE; q[2 * j + 1] = bfhi(w[j]) * FOX_SCALE; } }
#pragma unroll
        for (int j = 0; j < 16; ++j) o[j] = 0.f;
        const float cq = cf[(size_t)hd * S + qrow];
        for (int ktile = 0; ktile <= qb; ++ktile) {
            __syncthreads();
            for (int e = F.tid; e < 1024; e += NWAVES * 64) { const int key = e >> 4, ch = e & 15;
                *(LAS v4u*)(kt + key * 256 + ch * 16) = *(const GAS v4u*)(K + ((size_t)hd * S + ktile * 64 + key) * FD + ch * 8);
                *(LAS v4u*)(vt + key * 256 + ch * 16) = *(const GAS v4u*)(V + ((size_t)hd * S + ktile * 64 + key) * FD + ch * 8); }
            if (F.tid < 64) ck[F.tid] = cf[(size_t)hd * S + ktile * 64 + F.tid];
            __syncthreads();
#pragma unroll 1
            for (int kb = 0; kb < 4; ++kb) {
                float s[16]; float mx = -__builtin_inff();
#pragma unroll
                for (int kk = 0; kk < 16; ++kk) { const int key = kb * 16 + kk;
                    const v4u a = *(const LAS v4u*)(kt + key * 256 + part * 32), b = *(const LAS v4u*)(kt + key * 256 + part * 32 + 16);
                    const unsigned w[8] = {a.x, a.y, a.z, a.w, b.x, b.y, b.z, b.w}; float d = 0.f;
#pragma unroll
                    for (int j = 0; j < 8; ++j) d += q[2 * j] * bflo(w[j]) + q[2 * j + 1] * bfhi(w[j]);
                    d += __shfl_xor(d, 1); d += __shfl_xor(d, 2); d += __shfl_xor(d, 4);
                    d += cq - ck[key];
                    if (ktile * 64 + key > qrow) d = -__builtin_inff();
                    s[kk] = d; mx = fmaxf(mx, d); }
                const float mn = fmaxf(m, mx), alpha = __expf(m - mn); l *= alpha; m = mn;
#pragma unroll
                for (int j = 0; j < 16; ++j) o[j] *= alpha;
#pragma unroll
                for (int kk = 0; kk < 16; ++kk) { const int key = kb * 16 + kk; const float p = __expf(s[kk] - mn); l += p;
                    const v4u a = *(const LAS v4u*)(vt + key * 256 + part * 32), b = *(const LAS v4u*)(vt + key * 256 + part * 32 + 16);
                    const unsigned w[8] = {a.x, a.y, a.z, a.w, b.x, b.y, b.z, b.w};
#pragma unroll
                    for (int j = 0; j < 8; ++j) { o[2 * j] += p * bflo(w[j]); o[2 * j + 1] += p * bfhi(w[j]); } }
            }
        }
        const float il = 1.f / l; v4u w0, w1;
        w0.x = pk2(o[0] * il, o[1] * il); w0.y = pk2(o[2] * il, o[3] * il); w0.z = pk2(o[4] * il, o[5] * il); w0.w = pk2(o[6] * il, o[7] * il);
        w1.x = pk2(o[8] * il, o[9] * il); w1.y = pk2(o[10] * il, o[11] * il); w1.z = pk2(o[12] * il, o[13] * il); w1.w = pk2(o[14] * il, o[15] * il);
        GAS v4u* op = (GAS v4u*)(MIX + (size_t)qrow * DM + hd * FD + part * 16); op[0] = w0; op[1] = w1;
    }
    __syncthreads();
}
#endif

#if SIMPLE_GLA
__device__ __forceinline__ void gla_simple(Frame& F, const bf16* GQ, const bf16* GK, const bf16* GV, const float* FFGLR, const float* Wg, const float* bg, float* OGLA) {
    constexpr int TB = 16;
    LAS float* qs = (LAS float*)(F.lds + RING_OFF);
    LAS float* ks = qs + TB * 256;
    LAS float* vs = ks + TB * 256;
    LAS float* gs = vs + TB * 32;
    LAS float* red = gs + TB * 16;
    const int dk = F.tid & 255, half = F.tid >> 8;
    for (int item = F.vcu; item < GH * 16; item += F.G) {
        const int hd = item >> 4, sl = item & 15, col = hd * GDK + dk;
        float wg[16];
#pragma unroll
        for (int r = 0; r < 16; ++r) wg[r] = Wg[r * GKW + col];
        const float bgv = bg[col];
        float st[16];
#pragma unroll
        for (int j = 0; j < 16; ++j) st[j] = 0.f;
        for (int t0 = 0; t0 < S; t0 += TB) {
            __syncthreads();
            for (int e = F.tid; e < TB * 256; e += NWAVES * 64) { const int tt = e >> 8, d = e & 255;
                qs[e] = bf2f(GQ[(size_t)(t0 + tt) * GKW + hd * GDK + d]) * 0.0625f; ks[e] = bf2f(GK[(size_t)(t0 + tt) * GKW + hd * GDK + d]); }
            { const int tt = F.tid >> 5, c = F.tid & 31; vs[F.tid] = bf2f(GV[(size_t)(t0 + tt) * GVW + hd * GDV + sl * 32 + c]); }
            if (F.tid < TB * 16) { const int tt = F.tid >> 4, r = F.tid & 15; gs[F.tid] = FFGLR[(size_t)(t0 + tt) * 32 + 16 + r]; }
            __syncthreads();
#pragma unroll 1
            for (int tt = 0; tt < TB; ++tt) {
                float z = bgv;
#pragma unroll
                for (int r = 0; r < 16; ++r) z += gs[tt * 16 + r] * wg[r];
                const float a = expf(log_sigmoid_f(z) * 0.0625f), kv = ks[tt * 256 + dk], qv = qs[tt * 256 + dk];
                float part[16];
#pragma unroll
                for (int j = 0; j < 16; ++j) { st[j] = a * st[j] + kv * vs[tt * 32 + half * 16 + j]; part[j] = qv * st[j]; }
#pragma unroll
                for (int j = 0; j < 16; ++j) {
#pragma unroll
                    for (int o = 1; o < 64; o <<= 1) part[j] += __shfl_xor(part[j], o); }
                float mine = part[0];
#pragma unroll
                for (int j = 1; j < 16; ++j) mine = (F.lane == j) ? part[j] : mine;
                if (F.lane < 16) red[(tt * 8 + F.wave) * 16 + F.lane] = mine;
            }
            __syncthreads();
            { const int tt = F.tid >> 5, c = F.tid & 31, hw = c >> 4, j = c & 15; float s = 0.f;
#pragma unroll
              for (int w = 0; w < 4; ++w) s += red[(tt * 8 + hw * 4 + w) * 16 + j];
              OGLA[(size_t)(t0 + tt) * GVW + hd * GDV + sl * 32 + c] = s; }
        }
    }
    __syncthreads();
}
#endif

__device__ __forceinline__ void gla_post(Frame& F, const float* OGLA, const bf16* GR, const float* g, bf16* MIX) {
    const int gw = F.vcu * NWAVES + F.wave, NGW = F.G * NWAVES;
    const GAS f32x4* gp = (const GAS f32x4*)(g) + 2 * F.lane; const f32x4 g0 = gp[0], g1 = gp[1];
    for (int it = gw; it < S * GH; it += 4 * NGW) {
        f32x4 a[4], b[4]; v4u rw[4];
#pragma unroll
        for (int u = 0; u < 4; ++u) { const int iu = it + u * NGW; if (iu < S * GH) { const int row = iu >> 2, hd = iu & 3;
            const v4u ow = __builtin_nontemporal_load((const GAS v4u*)((const bf16*)OGLA + (size_t)row * GVW + hd * GDV + 8 * F.lane));
            a[u] = (f32x4){bflo(ow.x), bfhi(ow.x), bflo(ow.y), bfhi(ow.y)}; b[u] = (f32x4){bflo(ow.z), bfhi(ow.z), bflo(ow.w), bfhi(ow.w)};
            rw[u] = __builtin_nontemporal_load((const GAS v4u*)(GR + (size_t)row * GVW + hd * GDV + 8 * F.lane)); } }
#pragma unroll
        for (int u = 0; u < 4; ++u) { const int iu = it + u * NGW; if (iu < S * GH) { const int row = iu >> 2, hd = iu & 3;
            const float ss = (a[u].x * a[u].x + a[u].y * a[u].y) + (a[u].z * a[u].z + a[u].w * a[u].w) + (b[u].x * b[u].x + b[u].y * b[u].y) + (b[u].z * b[u].z + b[u].w * b[u].w);
            const float rstd = 1.f / sqrtf(wave_sum(ss) * (1.f / GDV) + EPS);
            v4u w;
            w.x = pk2(a[u].x * rstd * g0.x * pg8::silu_f(bflo(rw[u].x)), a[u].y * rstd * g0.y * pg8::silu_f(bfhi(rw[u].x)));
            w.y = pk2(a[u].z * rstd * g0.z * pg8::silu_f(bflo(rw[u].y)), a[u].w * rstd * g0.w * pg8::silu_f(bfhi(rw[u].y)));
            w.z = pk2(b[u].x * rstd * g1.x * pg8::silu_f(bflo(rw[u].z)), b[u].y * rstd * g1.y * pg8::silu_f(bfhi(rw[u].z)));
            w.w = pk2(b[u].z * rstd * g1.z * pg8::silu_f(bflo(rw[u].w)), b[u].w * rstd * g1.w * pg8::silu_f(bfhi(rw[u].w)));
            *(GAS v4u*)(MIX + (size_t)row * DM + FW + hd * GDV + 8 * F.lane) = w; } }
    }
}

#if !SIMPLE_ATTN
namespace fa {
constexpr int D = 128, NW = 8, QBLK = 32, KVBLK = 64, QB = NW * QBLK, LDO = 4096;
constexpr int SHM_V = KVBLK * D * 2, SHM_K = KVBLK * D * 2;
constexpr int OFF_Q = 2 * SHM_V + 2 * SHM_K, OFF_CK = 131072 + 1024, OFF_WS = OFF_CK + 512, ATT_LDS_END = OFF_WS + NW * 64 * 4;
constexpr float SCALE = 0.08838834764831845f, THR = 8.f;
typedef short s16x4 __attribute__((ext_vector_type(4)));
typedef unsigned u32x4 __attribute__((ext_vector_type(4)));
#define KSWZ(row, colB) ((row) * 256 + ((colB) ^ (((row) & 7) << 4)))
#define SBAR() __builtin_amdgcn_sched_barrier(0)
__device__ __forceinline__ int v_st(int k, int c) { const int kk = (k & ~0xC) | ((k & 4) << 1) | ((k & 8) >> 1); return ((kk >> 3) * 4 + (c >> 5)) * 512 + ((kk & 7) * 32 + (c & 31)) * 2; }
__device__ __forceinline__ int v_rd_base(int lane) { return ((lane & 3) << 3) | (((lane >> 2) & 3) << 6) | (((lane >> 4) & 1) << 5) | (((lane >> 5) & 1) << 8); }
constexpr int v_rd_off(int d0, int ks, int half) { return d0 * 512 + ks * 4096 + half * 2048; }
__device__ __forceinline__ int crow(int r, int hi) { return (r & 3) + 8 * (r >> 2) + 4 * hi; }
__device__ __forceinline__ unsigned cvtpk(float lo, float hi) { unsigned r; asm volatile("v_cvt_pk_bf16_f32 %0, %1, %2" : "=v"(r) : "v"(lo), "v"(hi)); return r; }
__device__ __forceinline__ bf16x8 ld8(const bf16* p) { return *reinterpret_cast<const bf16x8*>(p); }
__device__ __forceinline__ void mask_tile(f32x16& p0, f32x16& p1, int dq) {
    const float NEG = -__builtin_inff();
#pragma unroll
    for (int r = 0; r < 16; ++r) { const int c = (r & 3) + 8 * (r >> 2);
        if (dq - c < 0) p0[r] = NEG;
        if (dq - c - 32 < 0) p1[r] = NEG; }
}
__device__ __forceinline__ void partialSM(f32x16& p0, f32x16& p1, float& m_reg, float& mn, float& alpha) {
    float pmax = p0[0]; for (int r = 1; r < 16; ++r) pmax = fmaxf(pmax, p0[r]); for (int r = 0; r < 16; ++r) pmax = fmaxf(pmax, p1[r]);
    { auto rr = __builtin_amdgcn_permlane32_swap(__float_as_uint(pmax), __float_as_uint(pmax), false, false);
      pmax = fmaxf(__uint_as_float(rr[0]), __uint_as_float(rr[1])); }
    constexpr float C2 = 1.4426950408889634f * SCALE;
    if (__builtin_expect(__all((pmax - m_reg) * SCALE <= THR), 1)) { mn = m_reg; alpha = 1.f; }
    else { mn = fmaxf(m_reg, pmax); alpha = __builtin_amdgcn_exp2f((m_reg - mn) * C2); m_reg = mn; }
    const float mnL = -mn * C2;
    for (int r = 0; r < 16; ++r) p0[r] = fmaf(p0[r], C2, mnL); for (int r = 0; r < 16; ++r) p1[r] = fmaf(p1[r], C2, mnL);
    for (int r = 0; r < 16; ++r) p0[r] = __builtin_amdgcn_exp2f(p0[r]);
}
__device__ __forceinline__ void finishSM(f32x16& p0, f32x16& p1, float alpha, float& l_reg, bf16x8& pa0, bf16x8& pa1, bf16x8& pa2, bf16x8& pa3) {
    for (int r = 0; r < 16; ++r) p1[r] = __builtin_amdgcn_exp2f(p1[r]);
    float ps = 0; for (int r = 0; r < 16; ++r) ps += p0[r]; for (int r = 0; r < 16; ++r) ps += p1[r];
    { auto rr = __builtin_amdgcn_permlane32_swap(__float_as_uint(ps), __float_as_uint(ps), false, false);
      ps = __uint_as_float(rr[0]) + __uint_as_float(rr[1]); }
    l_reg = l_reg * alpha + ps;
#define PK4(P, B_, OUT) do { unsigned a0 = cvtpk(P[B_+0], P[B_+1]), a1 = cvtpk(P[B_+2], P[B_+3]);                          \
        unsigned b0 = cvtpk(P[B_+4], P[B_+5]), b1 = cvtpk(P[B_+6], P[B_+7]);                                             \
        auto r0 = __builtin_amdgcn_permlane32_swap(a0, b0, false, false); auto r1 = __builtin_amdgcn_permlane32_swap(a1, b1, false, false); \
        u32x4 w = {r0[0], r1[0], r0[1], r1[1]}; OUT = *reinterpret_cast<bf16x8*>(&w); } while (0)
    PK4(p0, 0, pa0); PK4(p0, 8, pa1); PK4(p1, 0, pa2); PK4(p1, 8, pa3);
#undef PK4
}
template <int KB>
__device__ __forceinline__ void qkt(f32x16& p0, f32x16& p1, const char* K_lds, const char* CK_lds, int r32, int hi, const char* Qw, float cq) {
#pragma unroll
    for (int g = 0; g < 4; ++g) { const f32x4 c0 = *(const f32x4*)(CK_lds + KB * 256 + (8 * g + 4 * hi) * 4), c1 = *(const f32x4*)(CK_lds + KB * 256 + (32 + 8 * g + 4 * hi) * 4);
#pragma unroll
        for (int i = 0; i < 4; ++i) { p0[4 * g + i] = cq - c0[i]; p1[4 * g + i] = cq - c1[i]; } }
    const char* kb[4];
#pragma unroll
    for (int dd = 0; dd < 4; ++dd) kb[dd] = K_lds + KB * SHM_K + KSWZ(r32, (dd * 16 + hi * 8) * 2);
#pragma unroll
    for (int d0 = 0; d0 < 8; ++d0) { const char* a = kb[d0 & 3] + (d0 >> 2) * 128;
        bf16x8 b0 = *reinterpret_cast<const bf16x8*>(a);
        bf16x8 b1 = *reinterpret_cast<const bf16x8*>(a + 32 * 256);
        bf16x8 qv = *reinterpret_cast<const bf16x8*>(Qw + KSWZ(r32, ((d0 & 3) * 16 + hi * 8) * 2) + (d0 >> 2) * 128);
        p0 = __builtin_amdgcn_mfma_f32_32x32x16_bf16(b0, qv, p0, 0, 0, 0);
        p1 = __builtin_amdgcn_mfma_f32_32x32x16_bf16(b1, qv, p1, 0, 0, 0); }
}
template <int VB>
__device__ __forceinline__ void pv_tile(f32x16* o, int vb0, bf16x8 pa0, bf16x8 pa1, bf16x8 pa2, bf16x8 pa3) {
#define TRRD(dst, off) asm volatile("ds_read_b64_tr_b16 %0, %1 offset:%2" : "=&v"(dst) : "v"(vb0), "i"(off) : "memory")
#define PV_D0(d0) do { s16x4 l0, l1, l2, l3, h0, h1, h2, h3; constexpr int b_ = VB * SHM_V + v_rd_off(d0, 0, 0); \
        TRRD(l0, b_); TRRD(h0, b_ + 2048); TRRD(l1, b_ + 4096); TRRD(h1, b_ + 6144); TRRD(l2, b_ + 8192); TRRD(h2, b_ + 10240); TRRD(l3, b_ + 12288); TRRD(h3, b_ + 14336); \
        asm volatile("s_waitcnt lgkmcnt(0)" ::: "memory"); SBAR();   \
        o[d0] = __builtin_amdgcn_mfma_f32_32x32x16_bf16(pa0, (bf16x8){l0[0], l0[1], l0[2], l0[3], h0[0], h0[1], h0[2], h0[3]}, o[d0], 0, 0, 0);   \
        o[d0] = __builtin_amdgcn_mfma_f32_32x32x16_bf16(pa1, (bf16x8){l1[0], l1[1], l1[2], l1[3], h1[0], h1[1], h1[2], h1[3]}, o[d0], 0, 0, 0);   \
        o[d0] = __builtin_amdgcn_mfma_f32_32x32x16_bf16(pa2, (bf16x8){l2[0], l2[1], l2[2], l2[3], h2[0], h2[1], h2[2], h2[3]}, o[d0], 0, 0, 0);   \
        o[d0] = __builtin_amdgcn_mfma_f32_32x32x16_bf16(pa3, (bf16x8){l3[0], l3[1], l3[2], l3[3], h3[0], h3[1], h3[2], h3[3]}, o[d0], 0, 0, 0); } while (0)
    PV_D0(0); PV_D0(1); PV_D0(2); PV_D0(3);
#undef PV_D0
#undef TRRD
}
struct Bases { const bf16* Q; const bf16* K; const bf16* V; const float* C; bf16* O; };
struct BlockRef { int hd, P0, jlo; };
constexpr int SEQ = 8192;
struct Seam { bf16x8 st_v0, st_v1, st_k0, st_k1; float cq; };
#define ROW(p, k0, rr) ((p) + (size_t)((k0) + (rr)) * D + sc)
#define VMW() asm volatile("s_waitcnt vmcnt(0)" ::: "memory")
#define VMWN(n) asm volatile("s_waitcnt vmcnt(%0)" :: "i"(n) : "memory")
#define SLOAD_H(Kp, Vp, Cp, k0) do { S.st_v0 = ld8(ROW(Vp, k0, sr)); S.st_v1 = ld8(ROW(Vp, k0, 32 + sr));              \
                         S.st_k0 = ld8(ROW(Kp, k0, sr)); S.st_k1 = ld8(ROW(Kp, k0, 32 + sr)); } while (0)
#define CLOAD(Cp, k0, bf) do { if (wid == 0) { int ln_ = lane; asm volatile("" : "+v"(ln_));   __builtin_amdgcn_global_load_lds((const unsigned*)((Cp) + (k0) + ln_), (LAS unsigned*)(CK_lds + (bf) * 256), 4, 0, 0); } } while (0)
#define SWRITE_HK(bf) do { *(bf16x8*)(K_lds + (bf) * SHM_K + kws) = S.st_k0; *(bf16x8*)(K_lds + (bf) * SHM_K + kws + 32 * 256) = S.st_k1; } while (0)
#define SWRITE_HV(bf) do { *(bf16x8*)(V_lds + (bf) * SHM_V + vst0) = S.st_v0; *(bf16x8*)(V_lds + (bf) * SHM_V + vst1) = S.st_v1; } while (0)
#define SWRITE_H(bf) do { SWRITE_HV(bf); SWRITE_HK(bf); } while (0)
__device__ __forceinline__ void fox_prime(const Bases& B, const BlockRef& cur, char* lds, Seam& S) {
    const int tid = threadIdx.x, wid = __builtin_amdgcn_readfirstlane(tid >> 6), lane = tid & 63, r32 = lane & 31, hi = lane >> 5;
    const int sr = tid >> 4, sc = (tid & 15) * 8, kws = KSWZ(sr, sc * 2); char* K_lds = lds + 2 * SHM_V; char* CK_lds = lds + OFF_CK;
    const int kb0 = cur.jlo * KVBLK;
    const bf16* curQ = B.Q + (size_t)cur.hd * SEQ * D; const bf16* curK = B.K + (size_t)cur.hd * SEQ * D; const bf16* curV = B.V + (size_t)cur.hd * SEQ * D; const float* curC = B.C + (size_t)cur.hd * SEQ;
    { char* Qw = lds + OFF_Q + wid * (QBLK * 256); bf16x8 qt[8];
#pragma unroll
      for (int d0 = 0; d0 < 8; ++d0) qt[d0] = ld8(curQ + (size_t)(cur.P0 + wid * QBLK + r32) * D + d0 * 16 + hi * 8);
#pragma unroll
      for (int d0 = 0; d0 < 8; ++d0) *(bf16x8*)(Qw + KSWZ(r32, ((d0 & 3) * 16 + hi * 8) * 2) + (d0 >> 2) * 128) = qt[d0]; }
    S.cq = curC[cur.P0 + wid * QBLK + r32];
    SLOAD_H(curK, curV, curC, kb0); CLOAD(curC, kb0, 0); VMW(); SWRITE_HK(0);
    __syncthreads();
}
__device__ __forceinline__ void fox_block(const Bases& B, const BlockRef& cur, const BlockRef& nxt, char* lds, Seam& S) {
    const int tid = threadIdx.x, wid = __builtin_amdgcn_readfirstlane(tid >> 6), lane = tid & 63, r32 = lane & 31, hi = lane >> 5;
    const int j_lo = cur.jlo, j_hi = (cur.P0 + QB - 1) / KVBLK + 1;
    const int NT = j_hi - j_lo;
    const int kbn = nxt.jlo * KVBLK;
    const int qlo = cur.P0 + wid * QBLK, qm = qlo + r32 - 4 * hi;
    char* V_lds = lds; char* K_lds = lds + 2 * SHM_V; char* CK_lds = lds + OFF_CK; char* Qw = lds + OFF_Q + wid * (QBLK * 256);
    float* ws = (float*)(lds + OFF_WS) + wid * 64; float* li_l = ws, * al_l = ws + 32;
    float m_reg = -1e30f, l_reg = 0; f32x16 o[4] = {};
    const float cq = S.cq;
    const int sr = tid >> 4, sc = (tid & 15) * 8, vst0 = v_st(sr, sc), vst1 = v_st(32 + sr, sc), kws = KSWZ(sr, sc * 2);
    const int vb0 = (int)(uintptr_t)V_lds + v_rd_base(lane);
    const bf16* Kh = B.K + (size_t)cur.hd * SEQ * D; const bf16* Vh = B.V + (size_t)cur.hd * SEQ * D; const float* Ch = B.C + (size_t)cur.hd * SEQ;
#define RESC(a) do { if (__any((a) < 1.f)) { if (hi == 0) al_l[r32] = (a); asm volatile("s_waitcnt lgkmcnt(0)" ::: "memory");              \
                     for (int d_ = 0; d_ < 4; ++d_) for (int r = 0; r < 16; ++r) o[d_][r] *= al_l[crow(r, hi)]; } } while (0)
#define KBASE(t) ((j_lo + (t)) * KVBLK)
#define MASKT(P0_, P1_, t) do { const int kb_ = KBASE(t); if (kb_ + KVBLK - 1 > qlo) mask_tile(P0_, P1_, qm - kb_); } while (0)
    constexpr int NQL = 9;
#define SEAM_K0() do { VMWN(NQL); SWRITE_HK(0); SBAR(); } while (0)
    f32x16 pA0, pA1, pB0, pB1; float mnA, mnB, alA, alB; bf16x8 pa0, pa1, pa2, pa3;
    SWRITE_HV(0); SBAR();
    if (NT > 1) { SLOAD_H(Kh, Vh, Ch, KBASE(1)); CLOAD(Ch, KBASE(1), 1); }
    SBAR(); qkt<0>(pA0, pA1, K_lds, CK_lds, r32, hi, Qw, cq);
    MASKT(pA0, pA1, 0); partialSM(pA0, pA1, m_reg, mnA, alA);
    if (NT > 1) { VMW(); SWRITE_H(1); }
    __syncthreads();
#define HALF_STEP(PX0, PX1, mnX, alX, PY0, PY1, alY, t, KB, VB, SB) do {                                                      \
        SBAR(); qkt<KB>(PX0, PX1, K_lds, CK_lds, r32, hi, Qw, cq);                                             \
        finishSM(PY0, PY1, alY, l_reg, pa0, pa1, pa2, pa3); SBAR();                                                           \
        if ((t) + 1 < NT) { SLOAD_H(Kh, Vh, Ch, KBASE((t) + 1)); CLOAD(Ch, KBASE((t) + 1), SB); SBAR(); }                                               \
        pv_tile<VB>(o, vb0, pa0, pa1, pa2, pa3); MASKT(PX0, PX1, (t)); partialSM(PX0, PX1, m_reg, mnX, alX);                                        \
        __syncthreads();                                                                                                      \
        if ((t) + 1 < NT) { VMW(); SWRITE_H(SB); }                                                                          \
        RESC(alX); __syncthreads(); } while (0)
    for (int t = 1; t + 1 < NT; t += 2) {
        HALF_STEP(pB0, pB1, mnB, alB, pA0, pA1, alA, t, 1, 0, 0);
        HALF_STEP(pA0, pA1, mnA, alA, pB0, pB1, alB, t + 1, 0, 1, 1);
    }
    const bool even = (NT & 1) == 0;
    if (even) { SBAR(); qkt<1>(pB0, pB1, K_lds, CK_lds, r32, hi, Qw, cq); SBAR(); }
    { const bf16* nK = B.K + (size_t)nxt.hd * SEQ * D; const bf16* nV = B.V + (size_t)nxt.hd * SEQ * D; const float* nC = B.C + (size_t)nxt.hd * SEQ;
      SLOAD_H(nK, nV, nC, kbn); CLOAD(nC, kbn, 0); } SBAR();
    finishSM(pA0, pA1, alA, l_reg, pa0, pa1, pa2, pa3); SBAR();
    pv_tile<0>(o, vb0, pa0, pa1, pa2, pa3);
    if (even) { MASKT(pB0, pB1, NT - 1); partialSM(pB0, pB1, m_reg, mnB, alB); __syncthreads(); RESC(alB);
        finishSM(pB0, pB1, alB, l_reg, pa0, pa1, pa2, pa3); SBAR(); pv_tile<1>(o, vb0, pa0, pa1, pa2, pa3); }
    SBAR();
    bf16x8 qt[8];
#pragma unroll
    for (int d0 = 0; d0 < 8; ++d0) qt[d0] = ld8(B.Q + (size_t)nxt.hd * SEQ * D + (size_t)(nxt.P0 + wid * QBLK + r32) * D + d0 * 16 + hi * 8);
    S.cq = (B.C + (size_t)nxt.hd * SEQ)[nxt.P0 + wid * QBLK + r32];
    SBAR(); SEAM_K0();
    if (hi == 0) li_l[r32] = l_reg; asm volatile("s_waitcnt lgkmcnt(0)" ::: "memory");
    float rli[16];
#pragma unroll
    for (int r = 0; r < 16; ++r) rli[r] = __builtin_amdgcn_rcpf(li_l[crow(r, hi)]);
    bf16* Ow = B.O + cur.hd * D + (size_t)(cur.P0 + wid * QBLK) * LDO;
#pragma unroll
    for (int r = 0; r < 16; ++r) { const int orow = crow(r, hi);
#pragma unroll
        for (int d0 = 0; d0 < 4; ++d0) { const float v = o[d0][r] * rli[r];
            const float vn = __shfl_xor(v, 1);
            if ((r32 & 1) == 0) *(unsigned*)(Ow + (size_t)orow * LDO + d0 * 32 + r32) = cvtpk(v, vn); } }
    SBAR();
#pragma unroll
    for (int d0 = 0; d0 < 8; ++d0) *(bf16x8*)(Qw + KSWZ(r32, ((d0 & 3) * 16 + hi * 8) * 2) + (d0 >> 2) * 128) = qt[d0];
    __syncthreads();
#undef RESC
#undef KBASE
#undef MASKT
#undef SEAM_K0
#undef HALF_STEP
}
#undef ROW
#undef VMW
#undef VMWN
#undef SLOAD_H
#undef CLOAD
#undef SWRITE_HK
#undef SWRITE_HV
#undef SWRITE_H
#undef KSWZ
#undef SBAR
}
#endif

#if !SIMPLE_ATTN
__device__ __forceinline__ int fox_jlo(const float* CS, const float* NRMP, int nwg, int hd, int P0, int lane) {
    float qm2 = 0.f, km2 = 0.f;
    for (int g = lane; g < nwg; g += 64) { qm2 = fmaxf(qm2, NRMP[(size_t)g * 32 + 2 * hd]); km2 = fmaxf(km2, NRMP[(size_t)g * 32 + 2 * hd + 1]); }
#pragma unroll
    for (int o = 1; o < 64; o <<= 1) { qm2 = fmaxf(qm2, __shfl_xor(qm2, o)); km2 = fmaxf(km2, __shfl_xor(km2, o)); }
    const float braw = 30.0f * 11.313708498984761f + 2.0f * sqrtf(qm2 * km2) * 1.0001f + 1.0f;
    const float* c = CS + (size_t)hd * S; const float c0 = c[P0]; const int jd = P0 >> 6;
    const int j0 = lane, j1 = lane + 64;
    const bool p0 = j0 <= jd && (c0 - c[64 * (j0 <= jd ? j0 : jd) + 63] > -braw), p1 = j1 <= jd && (c0 - c[64 * (j1 <= jd ? j1 : jd) + 63] > -braw);
    const unsigned long long b0 = __ballot(p0), b1 = __ballot(p1);
    int jl = b0 ? __builtin_ctzll(b0) : (b1 ? 64 + __builtin_ctzll(b1) : jd);
    return __builtin_amdgcn_readfirstlane(jl < jd ? jl : jd);
}
__device__ __forceinline__ fa::BlockRef fox_ref(int item, int pass, int jl0, int jl1) {
    const int y = item & 15, qb = pass ? 31 - y : y; fa::BlockRef r; r.hd = (item >> 4) & 15; r.P0 = qb * fa::QB; r.jlo = pass ? jl1 : jl0;
    return r;
}
__device__ __forceinline__ void fox_phase(Frame& F, char* lds, const bf16* Q, const bf16* K, const bf16* V, const float* CS, const float* NRM, bf16* MIX) {
    constexpr int NITEMS = FH * 16 * (PROBE_REPEAT == 61 ? 2 : 1);
    const int nw = F.G; int item = F.vcu; if (item >= NITEMS) return;
    int pass = 0;
    const fa::Bases B{Q, K, V, CS, MIX};
    int jl0 = fox_jlo(CS, NRM, F.G, (item >> 4) & 15, (item & 15) * fa::QB, F.lane), jl1 = fox_jlo(CS, NRM, F.G, (item >> 4) & 15, (31 - (item & 15)) * fa::QB, F.lane);
    fa::BlockRef cur = fox_ref(item, 0, jl0, jl1);
    fa::Seam Sm;
    fa::fox_prime(B, cur, lds, Sm);
    for (;;) {
        const bool more_pass = pass == 0, more_item = item + nw < NITEMS, last = !more_pass && !more_item;
        int itn = item, passn = pass + 1;
        if (!more_pass) { passn = 0; itn = more_item ? item + nw : item;
            if (more_item) { jl0 = fox_jlo(CS, NRM, F.G, (itn >> 4) & 15, (itn & 15) * fa::QB, F.lane); jl1 = fox_jlo(CS, NRM, F.G, (itn >> 4) & 15, (31 - (itn & 15)) * fa::QB, F.lane); } }
        const fa::BlockRef nxt = last ? cur : fox_ref(itn, passn, jl0, jl1);
        fa::fox_block(B, cur, nxt, lds, Sm);
        if (last) break;
        cur = nxt; item = itn; pass = passn;
    }
}
#endif

#if !SIMPLE_GLA
constexpr int GP_GLR = 0, GP_TOT = 4096, GP_QD = 6144, GP_KI = GP_QD + 64 * 528, GP_KET = GP_KI + 64 * 528, GP_AS = GP_KET + 256 * 144, GP_END = GP_AS + 64 * 144;
static_assert(GP_END <= 131072, "gla prep LDS");
__device__ __forceinline__ void gla_prep(Frame& F, const bf16* GQ, const bf16* GK, const bf16* GV, const float* FFGLR, const float* Wg, const float* bg,
                                         bf16* QDF, bf16* KEF, bf16* AMF, bf16* VTF, float* DL) {
    LAS float* glr = (LAS float*)(F.lds + GP_GLR); LAS float* tot = (LAS float*)(F.lds + GP_TOT);
    LAS unsigned char* QD = F.lds + GP_QD; LAS unsigned char* KI = F.lds + GP_KI; LAS unsigned char* KET = F.lds + GP_KET; LAS unsigned char* AS = F.lds + GP_AS;
    const int tid = F.tid, lane = F.lane, r = lane & 31, hh = lane >> 5;
    for (int job = F.vcu; job < NCH * GH; job += F.G) {
        const int n = job >> 2, h = job & 3, t0 = n * GC;
        __syncthreads();
        const int d = tid & 255, th = tid >> 8, col = h * GDK + d;
        unsigned short qraw[32], kraw[32]; float wg[16];
        {   const bf16* qp = GQ + (size_t)(t0 + th * 32) * GKW + col; const bf16* kp = GK + (size_t)(t0 + th * 32) * GKW + col;
#pragma unroll
            for (int i = 0; i < 32; ++i) { qraw[i] = qp[(size_t)i * GKW]; kraw[i] = kp[(size_t)i * GKW]; }
#pragma unroll
            for (int q = 0; q < 16; ++q) wg[q] = Wg[q * GKW + col]; }
        const float bgv = bg[col];
        for (int e = tid; e < 1024; e += NWAVES * 64) glr[e] = FFGLR[(size_t)(t0 + (e >> 4)) * 32 + 16 + (e & 15)];
        {
            const int c = tid, slice = c >> 5, cr = c & 31; const bf16* vp = GV + (size_t)t0 * GVW + h * GDV + c;
            bf16* vo = VTF + ((size_t)((n * 4 + h) * 16 + slice) * 4) * 512 + cr * 8;
#pragma unroll
            for (int ks = 0; ks < 4; ++ks)
#pragma unroll
                for (int half = 0; half < 2; ++half) { unsigned short e[8];
#pragma unroll
                    for (int j = 0; j < 8; ++j) e[j] = vp[(size_t)(16 * ks + 8 * half + j) * GVW];
                    v4u o; o.x = e[0] | ((unsigned)e[1] << 16); o.y = e[2] | ((unsigned)e[3] << 16); o.z = e[4] | ((unsigned)e[5] << 16); o.w = e[6] | ((unsigned)e[7] << 16);
                    *(GAS v4u*)(vo + ks * 512 + half * 256) = o; }
        }
        __syncthreads();
        float bcum[32];
        {   float run = 0.f;
#pragma unroll
            for (int i = 0; i < 32; ++i) { const int t = th * 32 + i; float z = bgv;
#pragma unroll
                for (int q = 0; q < 16; ++q) z += glr[t * 16 + q] * wg[q];
                run += log_sigmoid_f(z) * 0.0625f; bcum[i] = run; }
            tot[th * 256 + d] = run; }
        __syncthreads();
        const float tot0 = tot[d], blast = tot0 + tot[256 + d], boff = th ? tot0 : 0.f;
        if (th == 1) DL[(size_t)(n * 4 + h) * 256 + d] = __expf(blast);
        {   unsigned kew[4];
#pragma unroll
            for (int i = 0; i < 32; ++i) { const int t = th * 32 + i; const float bb = bcum[i] + boff, qv = bf2f(qraw[i]), kv = bf2f(kraw[i]);
                const float eb = __expf(bb), qd = qv * 0.0625f * eb, ki = kv * __expf(-bb), ke = kv * __expf(blast - bb);
                *(LAS unsigned short*)(QD + t * 528 + d * 2) = (unsigned short)f2bf(qd);
                *(LAS unsigned short*)(KI + t * 528 + d * 2) = (unsigned short)f2bf(ki);
                const unsigned kb = f2bf(ke);
                if (i & 1) kew[(i >> 1) & 3] |= kb << 16; else kew[(i >> 1) & 3] = kb;
                if ((i & 7) == 7) { v4u o; o.x = kew[0]; o.y = kew[1]; o.z = kew[2]; o.w = kew[3]; *(LAS v4u*)(KET + d * 144 + (t - 7) * 2) = o; } }
        }
        __syncthreads();
        {
            const int r16 = lane & 15, g = lane >> 4;
#pragma unroll
            for (int tt = 0; tt < 2; ++tt) { const int T = 2 * F.wave + tt, mti = T >> 2, nti = T & 3;
                f32x4 acc = {0.f, 0.f, 0.f, 0.f};
#pragma unroll
                for (int ks = 0; ks < 8; ++ks) { const bf16x8 a = *(const LAS bf16x8*)(QD + (mti * 16 + r16) * 528 + (ks * 32 + 8 * g) * 2), b = *(const LAS bf16x8*)(KI + (nti * 16 + r16) * 528 + (ks * 32 + 8 * g) * 2);
                    acc = __builtin_amdgcn_mfma_f32_16x16x32_bf16(a, b, acc, 0, 0, 0); }
#pragma unroll
                for (int i = 0; i < 4; ++i) { const int tq = mti * 16 + 4 * g + i, tk = nti * 16 + r16;
                    *(LAS unsigned short*)(AS + tq * 144 + tk * 2) = (unsigned short)f2bf(tk <= tq ? acc[i] : 0.f); } }
        }
        __syncthreads();
        {   const size_t jb = (size_t)(n * 4 + h);
            { const int f = tid >> 6, mt = f >> 2, ks = f & 3;
              *(GAS v4u*)(AMF + (jb * 8 + f) * 512 + lane * 8) = *(const LAS v4u*)(AS + (32 * mt + r) * 144 + (16 * ks + 8 * hh) * 2); }
#pragma unroll
            for (int i = 0; i < 4; ++i) { const int f = (tid >> 6) + 8 * i;
                { const int w = f >> 2, mt = (f >> 1) & 1, s = f & 1; const LAS unsigned char* src = QD + (32 * mt + r) * 528 + (32 * w + 16 * s + 4 * hh) * 2;
                  const v2u lo = *(const LAS v2u*)src, hi = *(const LAS v2u*)(src + 16); v4u o; o.x = lo.x; o.y = lo.y; o.z = hi.x; o.w = hi.y;
                  *(GAS v4u*)(QDF + (jb * 32 + f) * 512 + lane * 8) = o; }
                { const int w = f >> 2, ks = f & 3;
                  *(GAS v4u*)(KEF + (jb * 32 + f) * 512 + lane * 8) = *(const LAS v4u*)(KET + (32 * w + r) * 144 + (16 * ks + 8 * hh) * 2); } }
        }
    }
    __syncthreads();
}

struct GlaSet { bf16x8 qd[4], ke[4], vt[4], am, vx; f32x4 dl[4]; };
constexpr int GS_PW = 32 * 68, GS_PB = 8 * GS_PW;
__device__ __forceinline__ bf16x8 pack_bf8(const f32x16& x, int s) {
    v4u p; p.x = pk2(x[8 * s], x[8 * s + 1]); p.y = pk2(x[8 * s + 2], x[8 * s + 3]); p.z = pk2(x[8 * s + 4], x[8 * s + 5]); p.w = pk2(x[8 * s + 6], x[8 * s + 7]);
    return __builtin_bit_cast(bf16x8, p);
}

constexpr int GG = 4, GN = NCH / GG;
static_assert(GN == 32, "pass-1 unroll");
struct GlaSet1 { bf16x8 ke[4], vt[4]; f32x4 dl[4]; };
__device__ __forceinline__ void gla_pass1(Frame& F, const bf16* KEF, const bf16* VTF, const float* DL, float* UG, float* DG) {
    const int lane = F.lane, w = F.wave, hh = lane >> 5;
    for (int job = F.vcu; job < GH * 16 * (GG - 1); job += F.G) {
        const int h = (job >> 4) & 3, sl = job & 15, gq = job >> 6, n0 = gq * GN;
        const GAS char* kb = (const GAS char*)KEF + ((size_t)h * 32 + w * 4) * 1024;
        const GAS char* vb = (const GAS char*)VTF + (((size_t)h * 16 + sl) * 4) * 1024;
        const GAS char* db = (const GAS char*)DL + (h * 256 + 32 * w) * 4;
        unsigned lo16 = lane * 16, lod = hh * 16;
        asm volatile("" : "+v"(lo16), "+v"(lod));
        f32x16 St = {}; f32x4 dp[4];
#pragma unroll
        for (int g_ = 0; g_ < 4; ++g_) dp[g_] = (f32x4){1.f, 1.f, 1.f, 1.f};
        GlaSet1 A, B, C;
#define G1_LOAD(X, n_) do { const size_t n__ = (size_t)(n_); const GAS char* k__ = kb + n__ * 131072; const GAS char* v__ = vb + n__ * 262144; const GAS char* d__ = db + n__ * 4096; \
            _Pragma("unroll") for (int i_ = 0; i_ < 4; ++i_) { X.ke[i_] = *(const GAS bf16x8*)(k__ + i_ * 1024 + lo16); X.vt[i_] = *(const GAS bf16x8*)(v__ + i_ * 1024 + lo16); X.dl[i_] = *(const GAS f32x4*)(d__ + 32 * i_ + lod); } } while (0)
#define G1_STEP(X) do { _Pragma("unroll") for (int g_ = 0; g_ < 4; ++g_) { dp[g_] = dp[g_] * X.dl[g_]; _Pragma("unroll") for (int i_ = 0; i_ < 4; ++i_) St[4 * g_ + i_] *= X.dl[g_][i_]; } \
            _Pragma("unroll") for (int ks_ = 0; ks_ < 4; ++ks_) St = __builtin_amdgcn_mfma_f32_32x32x16_bf16(X.ke[ks_], X.vt[ks_], St, 0, 0, 0); } while (0)
        G1_LOAD(A, n0); G1_LOAD(B, n0 + 1);
        for (int n = n0; n < n0 + GN - 2; n += 3) {
            G1_LOAD(C, n + 2); G1_STEP(A);
            G1_LOAD(A, n + 3); G1_STEP(B);
            G1_LOAD(B, n + 4); G1_STEP(C);
        }
        G1_STEP(A); G1_STEP(B);
#undef G1_LOAD
#undef G1_STEP
        GAS char* ub = (GAS char*)UG + ((((size_t)h * 16 + sl) * (GG - 1) + gq) * 8 + w) * 4096;
#pragma unroll
        for (int g_ = 0; g_ < 4; ++g_) *(GAS f32x4*)(ub + g_ * 1024 + lo16) = (f32x4){St[4 * g_], St[4 * g_ + 1], St[4 * g_ + 2], St[4 * g_ + 3]};
        if (sl == 0 && (lane & 31) == 0) { GAS char* dgb = (GAS char*)DG + (((size_t)h * (GG - 1) + gq) * 256 + 32 * w) * 4;
#pragma unroll
            for (int g_ = 0; g_ < 4; ++g_) *(GAS f32x4*)(dgb + 32 * g_ + lod) = dp[g_]; }
    }
}
__device__ __forceinline__ void gla_scan(Frame& F, const bf16* QDF, const bf16* KEF, const bf16* AMF, const bf16* VTF, const float* DL, const float* UG, const float* DG, float* OGLA, int jfirst, int jstride) {
    LAS float* P = (LAS float*)(F.lds + RING_OFF);
    const int tid = F.tid, lane = F.lane, w = F.wave, r = lane & 31, hh = lane >> 5;
    for (int job = jfirst; job < GH * 16 * GG; job += jstride) {
        const int h = (job >> 4) & 3, sl = job & 15, gq = job >> 6, n0 = gq * GN;
        const GAS char* qb = (const GAS char*)QDF + ((size_t)h * 32 + w * 4) * 1024;
        const GAS char* kb = (const GAS char*)KEF + ((size_t)h * 32 + w * 4) * 1024;
        const GAS char* ab = (const GAS char*)AMF + ((size_t)h * 8 + (w & 1) * 4 + (w >> 1)) * 1024;
        const GAS char* vb = (const GAS char*)VTF + (((size_t)h * 16 + sl) * 4) * 1024;
        const GAS char* db = (const GAS char*)DL + (h * 256 + 32 * w) * 4;
        GAS char* ob = (GAS char*)OGLA + ((size_t)h * GDV + sl * 32) * 2;
        unsigned lo16 = lane * 16, lod = hh * 16, loo = ((tid >> 5) * 4 * GVW + (tid & 31)) * 2;
        asm volatile("" : "+v"(lo16), "+v"(lod), "+v"(loo));
        f32x16 St = {};
        for (int j = 0; j < gq; ++j) {
            const GAS char* ub = (const GAS char*)UG + ((((size_t)h * 16 + sl) * (GG - 1) + j) * 8 + w) * 4096; const GAS char* dgb = (const GAS char*)DG + (((size_t)h * (GG - 1) + j) * 256 + 32 * w) * 4;
#pragma unroll
            for (int g_ = 0; g_ < 4; ++g_) { const f32x4 u_ = *(const GAS f32x4*)(ub + g_ * 1024 + lo16), d_ = *(const GAS f32x4*)(dgb + 32 * g_ + lod);
#pragma unroll
                for (int i_ = 0; i_ < 4; ++i_) St[4 * g_ + i_] = St[4 * g_ + i_] * d_[i_] + u_[i_]; } }
        GlaSet A, B;
#define GLA_LOAD(X, n_) do { const size_t n__ = (size_t)(n_); \
            const GAS char* q__ = qb + n__ * 131072; const GAS char* k__ = kb + n__ * 131072; const GAS char* v__ = vb + n__ * 262144; const GAS char* d__ = db + n__ * 4096; \
            _Pragma("unroll") for (int i_ = 0; i_ < 4; ++i_) { X.qd[i_] = *(const GAS bf16x8*)(q__ + i_ * 1024 + lo16); X.ke[i_] = *(const GAS bf16x8*)(k__ + i_ * 1024 + lo16); \
                X.vt[i_] = *(const GAS bf16x8*)(v__ + i_ * 1024 + lo16); X.dl[i_] = *(const GAS f32x4*)(d__ + 32 * i_ + lod); } \
            X.am = *(const GAS bf16x8*)(ab + n__ * 32768 + lo16); X.vx = *(const GAS bf16x8*)(v__ + (w >> 1) * 1024 + lo16); } while (0)
#define GLA_COMPUTE(X) do { \
            const bf16x8 xs0 = pack_bf8(St, 0), xs1 = pack_bf8(St, 1); O0 = (f32x16){}; O1 = (f32x16){}; \
            O0 = __builtin_amdgcn_mfma_f32_32x32x16_bf16(X.qd[0], xs0, O0, 0, 0, 0); O1 = __builtin_amdgcn_mfma_f32_32x32x16_bf16(X.qd[2], xs0, O1, 0, 0, 0); \
            O0 = __builtin_amdgcn_mfma_f32_32x32x16_bf16(X.qd[1], xs1, O0, 0, 0, 0); O1 = __builtin_amdgcn_mfma_f32_32x32x16_bf16(X.qd[3], xs1, O1, 0, 0, 0); \
            if (w & 1) O1 = __builtin_amdgcn_mfma_f32_32x32x16_bf16(X.am, X.vx, O1, 0, 0, 0); else O0 = __builtin_amdgcn_mfma_f32_32x32x16_bf16(X.am, X.vx, O0, 0, 0, 0); \
            _Pragma("unroll") for (int g_ = 0; g_ < 4; ++g_) _Pragma("unroll") for (int i_ = 0; i_ < 4; ++i_) St[4 * g_ + i_] *= X.dl[g_][i_]; \
            _Pragma("unroll") for (int ks_ = 0; ks_ < 4; ++ks_) St = __builtin_amdgcn_mfma_f32_32x32x16_bf16(X.ke[ks_], X.vt[ks_], St, 0, 0, 0); } while (0)
#define GLA_WRITE(buf_) do { LAS float* Pw = P + (buf_) * GS_PB + w * GS_PW + r * 68 + 4 * hh; \
              _Pragma("unroll") for (int g_ = 0; g_ < 4; ++g_) { *(LAS f32x4*)(Pw + 8 * g_) = (f32x4){O0[4 * g_], O0[4 * g_ + 1], O0[4 * g_ + 2], O0[4 * g_ + 3]}; \
                  *(LAS f32x4*)(Pw + 32 + 8 * g_) = (f32x4){O1[4 * g_], O1[4 * g_ + 1], O1[4 * g_ + 2], O1[4 * g_ + 3]}; } } while (0)
#define GLA_REDUCE(n_) do { const LAS float* Pr = P + ((n_) & 1) * GS_PB + (tid & 31) * 68 + (tid >> 5) * 4; f32x4 s_ = *(const LAS f32x4*)Pr; \
              _Pragma("unroll") for (int w_ = 1; w_ < 8; ++w_) s_ += *(const LAS f32x4*)(Pr + w_ * GS_PW); \
              GAS char* o_ = ob + (size_t)(n_) * (GC * GVW * 2); const unsigned p01_ = pk2(s_[0], s_[1]), p23_ = pk2(s_[2], s_[3]); \
              *(GAS unsigned short*)(o_ + loo) = (unsigned short)p01_; *(GAS unsigned short*)(o_ + GVW * 2 + loo) = (unsigned short)(p01_ >> 16); \
              *(GAS unsigned short*)(o_ + 2 * GVW * 2 + loo) = (unsigned short)p23_; *(GAS unsigned short*)(o_ + 3 * GVW * 2 + loo) = (unsigned short)(p23_ >> 16); } while (0)
#define GLA_BAR() do { asm volatile("s_waitcnt lgkmcnt(0)" ::: "memory"); __builtin_amdgcn_s_barrier(); asm volatile("" ::: "memory"); } while (0)
        f32x16 O0, O1;
        __syncthreads();
        GLA_LOAD(A, n0); GLA_LOAD(B, n0 + 1);
        GLA_COMPUTE(A); GLA_WRITE(0);
        for (int n = n0; n < n0 + GN; n += 2) {
            if (n + 2 < n0 + GN) GLA_LOAD(A, n + 2);
            GLA_COMPUTE(B);
            GLA_BAR(); GLA_REDUCE(n); GLA_WRITE(1);
            if (n + 3 < n0 + GN) GLA_LOAD(B, n + 3);
            if (n + 2 < n0 + GN) GLA_COMPUTE(A);
            GLA_BAR(); GLA_REDUCE(n + 1); if (n + 2 < n0 + GN) GLA_WRITE(0);
        }
#undef GLA_COMPUTE
#undef GLA_BAR
#undef GLA_WRITE
#undef GLA_REDUCE
#undef GLA_LOAD
    }
    __syncthreads();
}
#endif

struct Args { const float* in[23]; float* out; unsigned char* ws; int ph_lo, ph_hi, li, pad; };
__global__ void __launch_bounds__(NWAVES * 64, 2) fwd(Args args) {
    extern __shared__ __attribute__((aligned(16))) unsigned char lds[];
    Frame F;
    F.lds = (LAS unsigned char*)lds;
    F.MISC = (volatile LAS unsigned*)(F.lds + MISC_OFF);
    F.tid = threadIdx.x; F.lane = F.tid & 63; F.wave = __builtin_amdgcn_readfirstlane(F.tid >> 6);
    F.G = gridDim.x; { const int bx = blockIdx.x; F.vcu = (F.G % 8 == 0) ? (bx % 8) * (F.G / 8) + bx / 8 : bx; }
    unsigned char* ws = args.ws;
    F.ctl = (gu32*)(ws + WS_CTL);
    for (int u = F.tid; u < (LDS_BYTES - LDSCTL_OFF) / 4; u += NWAVES * 64) ((LAS unsigned*)(F.lds + LDSCTL_OFF))[u] = 0u;
    __syncthreads();
    XcdBarrier bar; bar.bar = (unsigned*)(F.ctl + CW_BAR); bar.x = 0; bar.st = nullptr;
    if (ONE_LAUNCH) bar = xcd_barrier_post((unsigned*)(F.ctl + CW_BAR), F.MISC + 8);
#define GRID_BAR() do { if (ONE_LAUNCH) xcd_barrier(bar); } while (0)
    const int lo = args.ph_lo, hi = args.ph_hi; long long amp_t0 = 0; (void)amp_t0;
#define IN(k) (lo <= (k) && (k) < hi)
#define PHASE_BEGIN() do { int t_ = threadIdx.x; asm volatile("" : "+v"(t_)); F.tid = t_; F.lane = t_ & 63; F.wave = __builtin_amdgcn_readfirstlane(t_ >> 6); } while (0)
#define BOTH(k) (IN(k) && IN((k) + 1))
#define AMP_T0(k) do { if ((PROBE_AMP) == (k)) amp_t0 = wall_clock64(); } while (0)
#define AMP_SPIN(k) do { if ((PROBE_AMP) == (k) && blockIdx.x == 0) { if (threadIdx.x == 0) { const long long t1_ = wall_clock64(), d_ = 4 * (t1_ - amp_t0); while (wall_clock64() - t1_ < d_) __builtin_amdgcn_s_sleep(8); } __syncthreads(); } } while (0)
#define REP(k) for (int rep_ = 0; rep_ < ((PROBE_REPEAT) == (k) ? 2 : 1); ++rep_)
#define gw (F.vcu * NWAVES + F.wave)
#define NGW (F.G * NWAVES)
    const float* x = args.in[0];
    bf16* W1GU = (bf16*)(ws + WS_W1GU); bf16* W1D = (bf16*)(ws + WS_W1D); bf16* W2GU = (bf16*)(ws + WS_W2GU); bf16* W2D = (bf16*)(ws + WS_W2D);
    bf16* WIN = (bf16*)(ws + WS_WIN); bf16* WSK = (bf16*)(ws + WS_WSK); bf16* WO = (bf16*)(ws + WS_WO); bf16* WPG = (bf16*)(ws + WS_WPG); bf16* WPP = (bf16*)(ws + WS_WPP);
    bf16* Hb = (bf16*)(ws + WS_H); bf16* Fb = (bf16*)(ws + WS_F); bf16* XN = (bf16*)(ws + WS_XN); bf16* MIX = (bf16*)(ws + WS_MIX); bf16* ACT = (bf16*)(ws + WS_ACT);
    bf16* Qb = (bf16*)(ws + WS_Q); bf16* Kb = (bf16*)(ws + WS_K); bf16* Vb = (bf16*)(ws + WS_V);
    bf16* GQ = (bf16*)(ws + WS_GQ); bf16* GK = (bf16*)(ws + WS_GK); bf16* GV = (bf16*)(ws + WS_GV); bf16* GR = (bf16*)(ws + WS_GR);
    float* CF = (float*)(ws + WS_MISC); float* FFGLR = (float*)(ws + WS_MISC + 1 * MiB); float* RSTDE = (float*)(ws + WS_WSK + 512 * 1024);
    float* OGLA = (float*)(ws + WS_OGLA); bf16* ERAW = (bf16*)(ws + WS_ERAW); bf16* PBF = (bf16*)(ws + WS_PBF);

    if (IN(0)) { PHASE_BEGIN(); AMP_T0(0); REP(0) {
        convert_items(F, args.in, ws, 0, CV_B - CV_TAIL, gw, NGW);
        { f32x4 gq[16];
#pragma unroll
          for (int j = 0; j < 16; ++j) gq[j] = ((const GAS f32x4*)args.in[2])[F.lane + 64 * j];
          for (int m = gw; m < S; m += NGW) norm_row_to_bf16(x + (size_t)m * DM, gq, XN + (size_t)m * DM, F.lane); }
        { const float* p = args.in[1]; const int gt = F.vcu * NWAVES * 64 + F.tid, NT = F.G * NWAVES * 64;
          for (int i = gt; i < S * PLE / 4; i += 4 * NT) { f32x4 v[4];
#pragma unroll
              for (int u = 0; u < 4; ++u) if (i + u * NT < S * PLE / 4) v[u] = ((const GAS f32x4*)p)[i + u * NT];
#pragma unroll
              for (int u = 0; u < 4; ++u) if (i + u * NT < S * PLE / 4) { v2u w; w.x = pk2(v[u].x, v[u].y); w.y = pk2(v[u].z, v[u].w); ((GAS v2u*)PBF)[i + u * NT] = w; } } }
        }
        if (BOTH(0)) { GRID_BAR(); AMP_SPIN(0); }
    }
    if (IN(1)) { PHASE_BEGIN(); AMP_T0(1); REP(1) {
        pg8::Gemm g{XN, W1GU, S, 2 * DFF, DM}; pg8::StaticOrder So; So.init(S, 2 * DFF, F.G, (int)blockIdx.x);
        pg8::EpiSwiGLU E{ACT, DFF};
        pg8::gemm_phase<pg8::EpiSwiGLU, pg8::StaticOrder, PG_ALIGN, PG_SP2>(F.lds + RING_OFF, g, So, E);
        { constexpr int NFULL = ((S / 256) * (2 * DFF / 256)) % 256;
          if (F.G == 256 && (int)blockIdx.x >= NFULL) convert_items(F, args.in, ws, CV_B - CV_TAIL, CV_B, ((int)blockIdx.x - NFULL) * NWAVES + F.wave, (256 - NFULL) * NWAVES);
          else if (F.G != 256) convert_items(F, args.in, ws, CV_B - CV_TAIL, CV_B, gw, NGW); }
        }
        if (BOTH(1)) { GRID_BAR(); AMP_SPIN(1); }
    }
    if (IN(2)) { PHASE_BEGIN(); AMP_T0(2); REP(2) {
        pg8::Gemm g{ACT, W1D, S, DM, DFF}; pg8::StaticOrder So; So.init(S, DM, F.G, (int)blockIdx.x);
        pg8::EpiBf16 E{Fb, DM};
        pg8::gemm_phase<pg8::EpiBf16, pg8::StaticOrder, PG_ALIGN, PG_SP2>(F.lds + RING_OFF, g, So, E);
        }
        if (BOTH(2)) { GRID_BAR(); AMP_SPIN(2); }
    }
    if (IN(3)) { PHASE_BEGIN(); AMP_T0(3); REP(3) {
        stage_gains(F, args.in[6], args.in[7]);
        for (int m = gw; m < S; m += NGW) resid_row<true, false>(F, Fb + (size_t)m * DM, x + (size_t)m * DM, 0.5f, Hb + (size_t)m * DM, XN + (size_t)m * DM, F.lane);
        }
        if (BOTH(3)) { GRID_BAR(); AMP_SPIN(3); }
    }
    if (IN(4)) { PHASE_BEGIN(); AMP_T0(4); REP(4) {
        pg8::Gemm g{XN, WIN, S, NWIN, DM}; pg8::StaticOrder So; So.init(S, NWIN, F.G, (int)blockIdx.x);
        pg8::EpiWin E{Qb, S};
        pg8::gemm_phase<pg8::EpiWin, pg8::StaticOrder, PG_ALIGN, PG_SP2>(F.lds + RING_OFF, g, So, E);
        skinny_gemm(F, XN, WSK, FFGLR);
        }
        if (BOTH(4)) { GRID_BAR(); AMP_SPIN(4); }
    }
    if (IN(5)) { PHASE_BEGIN(); AMP_T0(5); REP(5) {
        fox_prep(F, FFGLR, args.in[9], CF);
#if !SIMPLE_ATTN
        fox_norms(F, Qb, Kb, (float*)(ws + WS_MISC + 3 * MiB));
#endif
#if !SIMPLE_GLA
        gla_prep(F, GQ, GK, GV, FFGLR, args.in[10], args.in[11], (bf16*)(ws + WS_QDEC), (bf16*)(ws + WS_KTE), (bf16*)(ws + WS_AM), (bf16*)(ws + WS_VT), (float*)(ws + WS_MISC + 2560 * 1024));
#endif
        }
        if (BOTH(5)) { GRID_BAR(); AMP_SPIN(5); }
    }
    if (IN(6)) { PHASE_BEGIN(); AMP_T0(6); REP(6) {
#if SIMPLE_GLA || SIMPLE_ATTN
#error "the two-level scan build needs the MFMA attention and GLA bodies"
#endif
        gla_pass1(F, (const bf16*)(ws + WS_KTE), (const bf16*)(ws + WS_VT), (const float*)(ws + WS_MISC + 2560 * 1024), (float*)(ws + WS_UG), (float*)(ws + WS_DG));
        __syncthreads();
        fox_phase(F, (char*)lds + RING_OFF, Qb, Kb, Vb, CF, (const float*)(ws + WS_MISC + 3 * MiB), MIX);
        GRID_BAR();
        __syncthreads();
        if ((F.vcu & 1) == 0) gla_scan(F, (const bf16*)(ws + WS_QDEC), (const bf16*)(ws + WS_KTE), (const bf16*)(ws + WS_AM), (const bf16*)(ws + WS_VT), (const float*)(ws + WS_MISC + 2560 * 1024), (const float*)(ws + WS_UG), (const float*)(ws + WS_DG), OGLA, F.vcu >> 1, (F.G + 1) >> 1);
        __syncthreads();
        convert_dynamic(F, args.in, ws, CV_B, CV_D2 - CV_TAIL);
        }
        if (BOTH(6)) { GRID_BAR(); AMP_SPIN(6); }
    }
    if (IN(7)) { PHASE_BEGIN(); AMP_T0(7); REP(7) {
        gla_post(F, OGLA, GR, args.in[12], MIX);
        __syncthreads();
        { pg8::Gemm g{PBF, WPP, S, DM, PLE}; pg8::StaticOrder So; So.init(S, DM, F.G, (int)blockIdx.x);
          pg8::EpiBf16Part E{ERAW, DM, (float*)(ws + WS_EPART)};
          pg8::gemm_phase<pg8::EpiBf16Part, pg8::StaticOrder, PG_ALIGN, PG_SP2>(F.lds + RING_OFF, g, So, E); }
        }
        if (BOTH(7)) { GRID_BAR(); AMP_SPIN(7); }
    }
    if (IN(8)) { PHASE_BEGIN(); AMP_T0(8); REP(8) {
        pg8::Gemm g{MIX, WO, S, DM, DM}; pg8::StaticOrder So; So.init(S, DM, F.G, (int)blockIdx.x);
        pg8::EpiBf16 E{Fb, DM};
        pg8::gemm_phase<pg8::EpiBf16, pg8::StaticOrder, PG_ALIGN, PG_SP2>(F.lds + RING_OFF, g, So, E);
        }
        if (BOTH(8)) { GRID_BAR(); AMP_SPIN(8); }
    }
    if (IN(9)) { PHASE_BEGIN(); AMP_T0(9); REP(9) {
        stage_gains(F, args.in[14], args.in[15]);
        for (int m = gw; m < S; m += NGW) resid_row<true, true>(F, Fb + (size_t)m * DM, Hb + (size_t)m * DM, 1.0f, Hb + (size_t)m * DM, XN + (size_t)m * DM, F.lane);
        }
        if (BOTH(9)) { GRID_BAR(); AMP_SPIN(9); }
    }
    if (IN(10)) { PHASE_BEGIN(); AMP_T0(10); REP(10) {
        pg8::Gemm g{XN, W2GU, S, 2 * DFF, DM}; pg8::StaticOrder So; So.init(S, 2 * DFF, F.G, (int)blockIdx.x);
        pg8::EpiSwiGLU E{ACT, DFF};
        pg8::gemm_phase<pg8::EpiSwiGLU, pg8::StaticOrder, PG_ALIGN, PG_SP2>(F.lds + RING_OFF, g, So, E);
        { constexpr int NFULL = ((S / 256) * (2 * DFF / 256)) % 256;
          if (F.G == 256 && (int)blockIdx.x >= NFULL) convert_items(F, args.in, ws, CV_D2 - CV_TAIL, CV_D2, ((int)blockIdx.x - NFULL) * NWAVES + F.wave, (256 - NFULL) * NWAVES);
          else if (F.G != 256) convert_items(F, args.in, ws, CV_D2 - CV_TAIL, CV_D2, gw, NGW); }
        }
        if (BOTH(10)) { GRID_BAR(); AMP_SPIN(10); }
    }
    if (IN(11)) { PHASE_BEGIN(); AMP_T0(11); REP(11) {
        { pg8::Gemm g{ACT, W2D, S, DM, DFF}; pg8::StaticOrder So; So.init(S, DM, F.G, (int)blockIdx.x);
          pg8::EpiBf16 E{Fb, DM};
          pg8::gemm_phase<pg8::EpiBf16, pg8::StaticOrder, PG_ALIGN, PG_SP2>(F.lds + RING_OFF, g, So, E); }
        }
        if (BOTH(11)) { GRID_BAR(); AMP_SPIN(11); }
    }
    if (IN(12)) { PHASE_BEGIN(); AMP_T0(12); REP(12) {
        stage_gains(F, args.in[19], args.in[19]);
        for (int m = gw; m < S; m += NGW) {
            const float ep = ((const GAS float*)(ws + WS_EPART))[(size_t)m * 64 + F.lane];
            resid_row<false, true>(F, Fb + (size_t)m * DM, Hb + (size_t)m * DM, 0.5f, Hb + (size_t)m * DM, XN + (size_t)m * DM, F.lane);
            float s = ep;
            s = wave_sum(s); if (F.lane == 0) RSTDE[m] = 1.f / sqrtf(s * (1.f / DM) + EPS);
        }
        }
        if (BOTH(12)) { GRID_BAR(); AMP_SPIN(12); }
    }
    if (IN(13)) { PHASE_BEGIN(); AMP_T0(13); REP(13) {
        pg8::Gemm g{XN, WPG, S, DM, DM}; pg8::StaticOrder So; So.init(S, DM, F.G, (int)blockIdx.x);
        pg8::EpiPleGate E{(const pg8::bf16_t*)XN, ERAW, RSTDE, args.in[21], args.out, DM};
        pg8::gemm_phase<pg8::EpiPleGate, pg8::StaticOrder, PG_ALIGN, PG_SP2>(F.lds + RING_OFF, g, So, E);
        }
        if ((PROBE_AMP) == 13) { GRID_BAR(); AMP_SPIN(13); }
    }
#undef IN
#undef gw
#undef NGW
#undef PHASE_BEGIN
#undef BOTH
#undef GRID_BAR
}

extern "C" void kernel_launch(void* const* d_in, const int* in_sizes, int n_in, void* d_out, int out_size, void* d_ws, size_t ws_size, hipStream_t stream) {
    static int grid = 0;
    if (grid == 0) {
        if (n_in != 23 || in_sizes[0] != S * DM || out_size != S * DM || ws_size < WS_END) {
            fprintf(stderr, "kernel_launch: built for 23 inputs, x/out of %d floats, >= %zu bytes of workspace; got n_in %d, in0 %d, out %d, ws %zu; nothing launched\n", S * DM, (size_t)WS_END, n_in, n_in > 0 ? in_sizes[0] : -1, out_size, ws_size);
            grid = -1; return; }
        int dev = 0, cus = 0, per_cu = 0;
        if (hipGetDevice(&dev) != hipSuccess || hipDeviceGetAttribute(&cus, hipDeviceAttributeMultiprocessorCount, dev) != hipSuccess) { fprintf(stderr, "kernel_launch: device query failed\n"); grid = -1; return; }
        if (hipFuncSetAttribute((const void*)fwd, hipFuncAttributeMaxDynamicSharedMemorySize, LDS_BYTES) != hipSuccess) { fprintf(stderr, "kernel_launch: hipFuncSetAttribute failed\n"); grid = -1; return; }
        if (hipOccupancyMaxActiveBlocksPerMultiprocessor(&per_cu, (const void*)fwd, NWAVES * 64, LDS_BYTES) != hipSuccess || per_cu < 1)
            fprintf(stderr, "kernel_launch: note: occupancy query reports %d workgroups per CU\n", per_cu);
        (void)hipGetLastError();
        grid = cus;
    }
    if (grid < 0) return;
    if (hipMemsetAsync((char*)d_ws + WS_CTL, 0, CTL_ZERO_BYTES, stream) != hipSuccess) { fprintf(stderr, "kernel_launch: hipMemsetAsync failed\n"); return; }
    Args a{};
    for (int i = 0; i < 23; ++i) a.in[i] = (const float*)d_in[i];
    a.out = (float*)d_out; a.ws = (unsigned char*)d_ws;
    if (ONE_LAUNCH) {
        a.ph_lo = 0; a.ph_hi = N_PHASES; a.li = 0;
        hipLaunchKernelGGL(fwd, dim3(grid), dim3(NWAVES * 64), LDS_BYTES, stream, a);
    } else {
        for (int li = 0; li < N_PHASES; ++li) { a.ph_lo = li; a.ph_hi = li + 1; a.li = li;
            hipLaunchKernelGGL(fwd, dim3(grid), dim3(NWAVES * 64), LDS_BYTES, stream, a); }
    }
    const hipError_t le = hipPeekAtLastError();
    if (le != hipSuccess) fprintf(stderr, "kernel_launch: launch failed: %s\n", hipGetErrorName(le));
}
```
